# Optimizing an MI355X kernel written in HIP

```python
import math
import jax
import jax.numpy as jnp
from jax import lax
import numpy as np

D_MODEL = 1024
BATCH = 16
SEQ = 256
DEPTH = 4
DEC_BATCH = 4
DEC_SEQ = 1024
PAST_LEN = 512

GRID_W = 64
HEAD_DIM = 64
Q_BLOCK = 128
ROPE_THETA = 10000.0
EPS = 1e-6
NEG_INF = -1e30
A_HEADS = 4
A_QK = 2 * HEAD_DIM
A_V = 2 * HEAD_DIM
B_HEADS = 8
B_KV = 2
C_HEADS = 8
C_KV = 2
WINDOW = 128
N_BRANCH = 3
A_WIDTH = A_HEADS * A_V
B_WIDTH = B_HEADS * HEAD_DIM
C_WIDTH = C_HEADS * HEAD_DIM
D_FF = -(-8 * D_MODEL // (3 * 256)) * 256
N_MOD = 6
IN_SIZES = (A_HEADS * A_QK, A_HEADS * A_QK, A_HEADS * A_V,
            B_HEADS * HEAD_DIM, B_KV * HEAD_DIM, B_KV * HEAD_DIM,
            C_HEADS * HEAD_DIM, C_KV * HEAD_DIM, C_KV * HEAD_DIM,
            N_BRANCH * D_MODEL)
D_IN = sum(IN_SIZES)

kernel_name = 'hybrid_diffusion_prefix_trunk_step'


def rmsnorm(x, g):
    xf = x.astype(jnp.float32)
    y = xf * lax.rsqrt(jnp.mean(xf * xf, axis=-1, keepdims=True) + EPS)
    return (y * g.astype(jnp.float32)).astype(x.dtype)


def axial_rope(L, head_dim):
    rows = L // GRID_W
    row = jnp.repeat(jnp.arange(rows), GRID_W).astype(jnp.float32)
    col = jnp.tile(jnp.arange(GRID_W), rows).astype(jnp.float32)
    n = head_dim // 4
    inv = ROPE_THETA ** (-jnp.arange(n, dtype=jnp.float32) / n)
    ang = jnp.concatenate([row[:, None] * inv, col[:, None] * inv], axis=-1)
    return jnp.cos(ang), jnp.sin(ang)


def apply_rope(x, cos, sin):
    x1, x2 = jnp.split(x, 2, axis=-1)
    c = cos[None, :, None, :].astype(x.dtype)
    s = sin[None, :, None, :].astype(x.dtype)
    return jnp.concatenate([x1 * c - x2 * s, x2 * c + x1 * s], axis=-1)


def rope_halves(x, cos, sin):
    x1, x2 = jnp.split(x, 2, axis=-1)
    return jnp.concatenate([apply_rope(x1, cos, sin), apply_rope(x2, cos, sin)], axis=-1)


def to_groups(q, n_kv):
    B, L, H, D = q.shape
    return q.reshape(B, L, n_kv, H // n_kv, D)


def attend(q, k, v, bias=None, sink=None):
    s = jnp.einsum('bqhgd,bkhd->bhgqk', q, k).astype(jnp.float32) * (q.shape[-1] ** -0.5)
    if bias is not None:
        s = s + bias
    if sink is not None:
        sk = jnp.broadcast_to(sink.astype(jnp.float32)[None, :, :, None, None], s.shape[:-1] + (1,))
        p = jax.nn.softmax(jnp.concatenate([s, sk], axis=-1), axis=-1)[..., :-1]
    else:
        p = jax.nn.softmax(s, axis=-1)
    return jnp.einsum('bhgqk,bkhd->bqhgd', p.astype(v.dtype), v)


def diff_attend(q, k, v, lam):
    q1, q2 = jnp.split(q, 2, axis=-1)
    k1, k2 = jnp.split(k, 2, axis=-1)
    return attend(q1, k1, v) - lam.astype(v.dtype) * attend(q2, k2, v)


def sweep_queries(fn, q):
    B, L = q.shape[:2]
    nb = L // Q_BLOCK
    qb = jnp.moveaxis(q.reshape((B, nb, Q_BLOCK) + q.shape[2:]), 1, 0)
    out = lax.map(lambda a: fn(a[0], a[1]), (jnp.arange(nb), qb))
    return jnp.moveaxis(out, 0, 1).reshape((B, L) + out.shape[3:])


def project_heads(h, w_in):
    B, L, _ = h.shape
    idx = np.cumsum(IN_SIZES)[:-1].tolist()
    qa, ka, va, qb, kb, vb, qc, kc, vc, gates = jnp.split(h @ w_in, idx, axis=-1)
    return (qa.reshape(B, L, A_HEADS, A_QK), ka.reshape(B, L, A_HEADS, A_QK), va.reshape(B, L, A_HEADS, A_V),
            qb.reshape(B, L, B_HEADS, HEAD_DIM), kb.reshape(B, L, B_KV, HEAD_DIM), vb.reshape(B, L, B_KV, HEAD_DIM),
            qc.reshape(B, L, C_HEADS, HEAD_DIM), kc.reshape(B, L, C_KV, HEAD_DIM), vc.reshape(B, L, C_KV, HEAD_DIM),
            gates)


def merge_branches(out_a, out_b, out_c, gates, lp, lam_init):
    B, L = gates.shape[:2]
    oa = rmsnorm(out_a.reshape(B, L, A_HEADS, A_V), lp['a_subln_g']) * (1.0 - lam_init)
    ya = oa.reshape(B, L, A_WIDTH) @ lp['w_br_a']
    yb = out_b.reshape(B, L, B_WIDTH) @ lp['w_br_b']
    yc = out_c.reshape(B, L, C_WIDTH) @ lp['w_br_c']
    ga, gb, gc = jnp.split(jax.nn.sigmoid(gates), N_BRANCH, axis=-1)
    return (ga * ya + gb * yb + gc * yc) @ lp['w_out']


def context_mixers(h, lp, lam, lam_init):
    qa, ka, va, qb, kb, vb, qc, kc, vc, gates = project_heads(h, lp['w_in'])
    qb = rmsnorm(qb, lp['b_qnorm_g'])
    kb = rmsnorm(kb, lp['b_knorm_g'])
    sink = lp['c_sink'].reshape(C_KV, C_HEADS // C_KV)
    out_a = sweep_queries(lambda i, q: diff_attend(q, ka, va, lam), to_groups(qa, A_HEADS))
    out_b = sweep_queries(lambda i, q: attend(q, kb, vb), to_groups(qb, B_KV))
    out_c = sweep_queries(lambda i, q: attend(q, kc, vc, sink=sink), to_groups(qc, C_KV))
    merged = merge_branches(out_a, out_b, out_c, gates, lp, lam_init)
    return merged, (ka, va, kb, vb, kc, vc)


def latent_mixers(h, lp, lam, lam_init, cache, cos, sin):
    ctx_ka, ctx_va, ctx_kb, ctx_vb, ctx_kc, ctx_vc = cache
    qa, ka, va, qb, kb, vb, qc, kc, vc, gates = project_heads(h, lp['w_in'])
    L = h.shape[1]
    P = ctx_kc.shape[1]
    qa = rope_halves(qa, cos, sin)
    ka = rope_halves(ka, cos, sin)
    qb = apply_rope(rmsnorm(qb, lp['b_qnorm_g']), cos, sin)
    kb = apply_rope(rmsnorm(kb, lp['b_knorm_g']), cos, sin)
    qc = apply_rope(qc, cos, sin)
    kc = apply_rope(kc, cos, sin)
    sink = lp['c_sink'].reshape(C_KV, C_HEADS // C_KV)
    ka_all = jnp.concatenate([ctx_ka, ka], axis=1)
    va_all = jnp.concatenate([ctx_va, va], axis=1)
    kb_all = jnp.concatenate([ctx_kb, kb], axis=1)
    vb_all = jnp.concatenate([ctx_vb, vb], axis=1)
    out_a = sweep_queries(lambda i, q: diff_attend(q, ka_all, va_all, lam), to_groups(qa, A_HEADS))
    out_b = sweep_queries(lambda i, q: attend(q, kb_all, vb_all), to_groups(qb, B_KV))
    pad = ((0, 0), (WINDOW, WINDOW), (0, 0), (0, 0))
    kc_pad = jnp.pad(kc, pad)
    vc_pad = jnp.pad(vc, pad)
    KW = Q_BLOCK + 2 * WINDOW
    qi = jnp.arange(Q_BLOCK)[:, None]
    kj = jnp.arange(KW)[None, :]
    ctx_bias = jnp.zeros((Q_BLOCK, P), jnp.float32)

    def c_block(i, q):
        start = i * Q_BLOCK
        kw = lax.dynamic_slice_in_dim(kc_pad, start, KW, axis=1)
        vw = lax.dynamic_slice_in_dim(vc_pad, start, KW, axis=1)
        kpos = start - WINDOW + kj
        valid = (kj - qi >= 0) & (kj - qi <= 2 * WINDOW) & (kpos >= 0) & (kpos < L)
        bias = jnp.concatenate([ctx_bias, jnp.where(valid, 0.0, NEG_INF).astype(jnp.float32)], axis=-1)
        return attend(q, jnp.concatenate([ctx_kc, kw], axis=1), jnp.concatenate([ctx_vc, vw], axis=1),
                      bias=bias, sink=sink)

    out_c = sweep_queries(c_block, to_groups(qc, C_KV))
    merged = merge_branches(out_a, out_b, out_c, gates, lp, lam_init)
    return merged, ()


def modulation(cvec, w_mod, b_mod):
    m = jax.nn.silu(cvec) @ w_mod + b_mod
    return [t[:, None, :] for t in jnp.split(m, N_MOD, axis=-1)]


def swiglu(h, w_ffn_in, w_ffn_out):
    a, b = jnp.split(h @ w_ffn_in, 2, axis=-1)
    return (jax.nn.silu(a) * b) @ w_ffn_out


def trunk_layer(x, cvec, lp, mix_fn):
    sh1, sc1, g1, sh2, sc2, g2 = modulation(cvec, lp['w_mod'], lp['b_mod'])
    mixed, kv = mix_fn(rmsnorm(x, lp['norm1_g']) * (1.0 + sc1) + sh1)
    x = x + g1 * mixed
    x = x + g2 * swiglu(rmsnorm(x, lp['norm2_g']) * (1.0 + sc2) + sh2, lp['w_ffn_in'], lp['w_ffn_out'])
    return x, kv


def setup_inputs(seed: int = 0) -> dict:
    key = jax.random.key(seed)
    ks = iter(jax.random.split(key, 40))

    def nrm(shape, scale=1.0):
        return jax.random.normal(next(ks), shape, jnp.float32) * scale

    fd = D_MODEL ** -0.5
    return {
        'x_prompt': nrm((BATCH, SEQ, D_MODEL)),
        'x_sample': nrm((DEC_BATCH, DEC_SEQ, D_MODEL)),
        'cache_a_k': nrm((DEC_BATCH, DEPTH, PAST_LEN, A_HEADS, A_QK)),
        'cache_a_v': nrm((DEC_BATCH, DEPTH, PAST_LEN, A_HEADS, A_V)),
        'cache_b_k': nrm((DEC_BATCH, DEPTH, PAST_LEN, B_KV, HEAD_DIM)),
        'cache_b_v': nrm((DEC_BATCH, DEPTH, PAST_LEN, B_KV, HEAD_DIM)),
        'cache_c_k': nrm((DEC_BATCH, DEPTH, PAST_LEN, C_KV, HEAD_DIM)),
        'cache_c_v': nrm((DEC_BATCH, DEPTH, PAST_LEN, C_KV, HEAD_DIM)),
        'c': nrm((DEC_BATCH, D_MODEL)),
        'c_ctx': nrm((D_MODEL,)),
        'w_mod': nrm((DEPTH, D_MODEL, N_MOD * D_MODEL), fd),
        'b_mod': nrm((DEPTH, N_MOD * D_MODEL), 0.02),
        'norm1_g': 1.0 + nrm((DEPTH, D_MODEL), 0.02),
        'norm2_g': 1.0 + nrm((DEPTH, D_MODEL), 0.02),
        'w_in': nrm((DEPTH, D_MODEL, D_IN), fd),
        'a_lam_q1': nrm((DEPTH, HEAD_DIM), 0.1),
        'a_lam_k1': nrm((DEPTH, HEAD_DIM), 0.1),
        'a_lam_q2': nrm((DEPTH, HEAD_DIM), 0.1),
        'a_lam_k2': nrm((DEPTH, HEAD_DIM), 0.1),
        'a_subln_g': 1.0 + nrm((DEPTH, A_V), 0.02),
        'b_qnorm_g': 1.0 + nrm((DEPTH, HEAD_DIM), 0.02),
        'b_knorm_g': 1.0 + nrm((DEPTH, HEAD_DIM), 0.02),
        'c_sink': nrm((DEPTH, C_HEADS), 0.5),
        'w_br_a': nrm((DEPTH, A_WIDTH, D_MODEL), A_WIDTH ** -0.5),
        'w_br_b': nrm((DEPTH, B_WIDTH, D_MODEL), B_WIDTH ** -0.5),
        'w_br_c': nrm((DEPTH, C_WIDTH, D_MODEL), C_WIDTH ** -0.5),
        'w_out': nrm((DEPTH, D_MODEL, D_MODEL), fd),
        'w_ffn_in': nrm((DEPTH, D_MODEL, 2 * D_FF), fd),
        'w_ffn_out': nrm((DEPTH, D_FF, D_MODEL), D_FF ** -0.5),
        'final_g': 1.0 + nrm((D_MODEL,), 0.02),
    }


def reference(x_prompt, x_sample, cache_a_k, cache_a_v, cache_b_k, cache_b_v, cache_c_k, cache_c_v,
              c, c_ctx, w_mod, b_mod, norm1_g, norm2_g, w_in, a_lam_q1, a_lam_k1, a_lam_q2, a_lam_k2,
              a_subln_g, b_qnorm_g, b_knorm_g, c_sink, w_br_a, w_br_b, w_br_c, w_out, w_ffn_in,
              w_ffn_out, final_g):
    cos, sin = axial_rope(x_sample.shape[1], HEAD_DIM)
    xp = x_prompt
    xs = x_sample
    ctx_cvec = c_ctx[None, :]
    st_ak, st_av, st_bk, st_bv, st_ck, st_cv = [], [], [], [], [], []
    for l in range(DEPTH):
        lp = {'w_mod': w_mod[l], 'b_mod': b_mod[l], 'norm1_g': norm1_g[l], 'norm2_g': norm2_g[l],
              'w_in': w_in[l], 'a_subln_g': a_subln_g[l], 'b_qnorm_g': b_qnorm_g[l],
              'b_knorm_g': b_knorm_g[l], 'c_sink': c_sink[l], 'w_br_a': w_br_a[l], 'w_br_b': w_br_b[l],
              'w_br_c': w_br_c[l], 'w_out': w_out[l], 'w_ffn_in': w_ffn_in[l], 'w_ffn_out': w_ffn_out[l]}
        lam_init = 0.8 - 0.6 * math.exp(-0.3 * l)
        lam = (jnp.exp(jnp.sum(a_lam_q1[l].astype(jnp.float32) * a_lam_k1[l].astype(jnp.float32)))
               - jnp.exp(jnp.sum(a_lam_q2[l].astype(jnp.float32) * a_lam_k2[l].astype(jnp.float32)))
               + lam_init)
        xp, kv = trunk_layer(xp, ctx_cvec, lp, lambda h: context_mixers(h, lp, lam, lam_init))
        st_ak.append(kv[0]); st_av.append(kv[1]); st_bk.append(kv[2])
        st_bv.append(kv[3]); st_ck.append(kv[4]); st_cv.append(kv[5])
        cache = (cache_a_k[:, l], cache_a_v[:, l], cache_b_k[:, l], cache_b_v[:, l],
                 cache_c_k[:, l], cache_c_v[:, l])
        xs, _ = trunk_layer(xs, c, lp, lambda h: latent_mixers(h, lp, lam, lam_init, cache, cos, sin))
    y_prompt = rmsnorm(xp, final_g)
    y_sample = rmsnorm(xs, final_g)
    new_a_k = jnp.stack(st_ak, axis=1)
    new_a_v = jnp.stack(st_av, axis=1)
    new_b_k = jnp.stack(st_bk, axis=1)
    new_b_v = jnp.stack(st_bv, axis=1)
    new_c_k = jnp.stack(st_ck, axis=1)
    new_c_v = jnp.stack(st_cv, axis=1)
    return (y_prompt, y_sample, new_a_k, new_a_v, new_b_k, new_b_v, new_c_k, new_c_v)
```

```cpp
#include <hip/hip_runtime.h>
#include <hip/hip_cooperative_groups.h>
#include <cstdio>
#include <cstdint>
#include <cmath>
namespace cg = cooperative_groups;

#ifndef ONE_LAUNCH
#define ONE_LAUNCH 1
#endif

typedef unsigned short u16;
typedef __attribute__((ext_vector_type(8))) short bf16x8;
typedef __attribute__((ext_vector_type(4))) short s16x4;
typedef __attribute__((ext_vector_type(16))) float f32x16;
typedef __attribute__((ext_vector_type(4))) float f32x4;
typedef __attribute__((ext_vector_type(2))) unsigned u32x2;
typedef __attribute__((ext_vector_type(4))) unsigned u32x4;
typedef __attribute__((ext_vector_type(2))) __bf16 bf2_t;
typedef __attribute__((ext_vector_type(2))) float f2_t;
#define DI __device__ __forceinline__
#define LAS __attribute__((address_space(3)))
#define MFMA32(a, b, c) __builtin_amdgcn_mfma_f32_32x32x16_bf16((a), (b), (c), 0, 0, 0)

constexpr int DM = 1024, NTOK = 8192, NCTX = 4096;
constexpr int DIN = 6144, DFF = 2816, DEPTH = 4;
#ifndef SEQ_PACK
#define SEQ_PACK 0x76543210ull
#define SEQ_N 8
#endif
constexpr int NPH = 2 + SEQ_N * DEPTH;

constexpr size_t SZ_WIN = (size_t)DIN * DM * 2, SZ_WBR = (size_t)DM * 1536 * 2, SZ_WOUT = (size_t)DM * DM * 2;
constexpr size_t SZ_WF1 = (size_t)2 * DFF * DM * 2, SZ_WF2 = (size_t)DM * DFF * 2;
constexpr size_t SZ_WL = SZ_WIN + SZ_WBR + SZ_WOUT + SZ_WF1 + SZ_WF2;
constexpr size_t OFF_W = 0;
constexpr size_t OFF_MOD = OFF_W + SZ_WL * DEPTH;
constexpr size_t OFF_ROPE = OFF_MOD + (size_t)4 * 5 * 6144 * 4;
constexpr size_t OFF_X = OFF_ROPE + (size_t)2 * 1024 * 32 * 4;
constexpr size_t OFF_HM = OFF_X + (size_t)NTOK * DM * 4;
constexpr size_t OFF_Q = OFF_HM + (size_t)NTOK * DM * 2;
constexpr size_t OFF_GH = OFF_Q + (size_t)NTOK * 1536 * 2;
constexpr size_t OFF_ATT = OFF_GH + (size_t)NTOK * 3072 * 2;
constexpr size_t EL_KA = (size_t)4 * 4 * 1536 * 128, EL_KB = (size_t)4 * 2 * 1536 * 64;
constexpr size_t SZ_KVL = (2 * EL_KA + 4 * EL_KB) * 2;
constexpr size_t OFF_KVL = OFF_ATT + (size_t)NTOK * 1536 * 2;
constexpr size_t EL_KAC = (size_t)16 * 4 * 256 * 128, EL_KBC = (size_t)16 * 2 * 256 * 64;
constexpr size_t OFF_KVC = OFF_KVL + SZ_KVL * DEPTH;
constexpr size_t OFF_BAR = OFF_KVC + (2 * EL_KAC + 4 * EL_KBC) * 2;
constexpr size_t WS_END = OFF_BAR + 16384;

constexpr size_t O_YP = 0, O_YS = 4194304, O_AK = 8388608, O_AV = 16777216, O_BK = 25165824, O_BV = 27262976, O_CK = 29360128, O_CV = 31457280;

struct Params {
  const float* in[30];
  float* out;
  unsigned char* ws;
  float lam_init[4];
  int ph_lo, ph_hi;
};

DI unsigned pack2(float a, float b) { f2_t v = {a, b}; bf2_t r = __builtin_convertvector(v, bf2_t); return __builtin_bit_cast(unsigned, r); }
DI int tid_() { int t = threadIdx.x; asm volatile("" : "+v"(t)); return t; }
DI float4 ld_nt4(const float* p) { f32x4 t = __builtin_nontemporal_load((const f32x4*)p); return make_float4(t[0], t[1], t[2], t[3]); }
DI void st_nt4(float* p, float4 v) { f32x4 t = {v.x, v.y, v.z, v.w}; __builtin_nontemporal_store(t, (f32x4*)p); }
DI void st_nt2(float* p, float2 v) { f2_t t = {v.x, v.y}; __builtin_nontemporal_store(t, (f2_t*)p); }
DI float bf2f(u16 x) { return __uint_as_float(((unsigned)x) << 16); }
DI int crow(int reg, int h) { return (reg & 3) + 8 * (reg >> 2) + 4 * h; }
DI float wave_sum(float v) {
#pragma unroll
  for (int o = 32; o > 0; o >>= 1) v += __shfl_xor(v, o);
  return v;
}
DI float sigmoidf_(float x) { return __builtin_amdgcn_rcpf(1.f + __expf(-x)); }
DI float siluf_(float x) { return x * __builtin_amdgcn_rcpf(1.f + __expf(-x)); }
DI u16 bf16_1(float x) { return (u16)(pack2(x, 0.f) & 0xffffu); }

DI u16* Wt_in(unsigned char* ws, int l) { return (u16*)(ws + OFF_W + SZ_WL * l); }
DI u16* Wt_br(unsigned char* ws, int l) { return (u16*)(ws + OFF_W + SZ_WL * l + SZ_WIN); }
DI u16* Wt_out(unsigned char* ws, int l) { return (u16*)(ws + OFF_W + SZ_WL * l + SZ_WIN + SZ_WBR); }
DI u16* Wt_f1(unsigned char* ws, int l) { return (u16*)(ws + OFF_W + SZ_WL * l + SZ_WIN + SZ_WBR + SZ_WOUT); }
DI u16* Wt_f2(unsigned char* ws, int l) { return (u16*)(ws + OFF_W + SZ_WL * l + SZ_WIN + SZ_WBR + SZ_WOUT + SZ_WF1); }
DI u16* KVL(unsigned char* ws, int l, int which) {
  size_t off = 0;
  if (which >= 1) off += EL_KA;
  if (which >= 2) off += EL_KB;
  if (which >= 3) off += EL_KB;
  if (which >= 4) off += EL_KA;
  if (which >= 5) off += EL_KB;
  return (u16*)(ws + OFF_KVL + SZ_KVL * l) + off;
}
DI u16* KVC(unsigned char* ws, int which) {
  size_t off = 0;
  if (which >= 1) off += EL_KAC;
  if (which >= 2) off += EL_KBC;
  if (which >= 3) off += EL_KBC;
  if (which >= 4) off += EL_KAC;
  if (which >= 5) off += EL_KBC;
  return (u16*)(ws + OFF_KVC) + off;
}
DI const float* x_src(const Params& p, int l, int row) {
  if (l == 0) return row < NCTX ? p.in[0] + (size_t)row * DM : p.in[1] + (size_t)(row - NCTX) * DM;
  return (const float*)(p.ws + OFF_X) + (size_t)row * DM;
}
DI const float* mod_vec(const Params& p, int l, int row, int chunk) {
  int v = row < NCTX ? 4 : ((row - NCTX) >> 10);
  return (const float*)(p.ws + OFF_MOD) + ((size_t)(l * 5 + v) * 6144 + chunk * 1024);
}

template <int NT64>
DI void transpose_tile(const float* __restrict__ src, int ldsrc, int k0, int n0, u16* __restrict__ dst, int ldd, int mode, float* tile) {
  const int t = tid_() & 255;
  __syncthreads();
  {
    const int kk = t >> 4, c4 = (t & 15) * 4;
    float4 v[NT64 * 4];
#pragma unroll
    for (int q = 0; q < NT64; ++q)
#pragma unroll
      for (int i = 0; i < 4; ++i) { f32x4 t_ = __builtin_nontemporal_load((const f32x4*)(src + (size_t)(k0 + kk + 16 * i) * ldsrc + n0 + 64 * q + c4)); v[q * 4 + i] = make_float4(t_[0], t_[1], t_[2], t_[3]); }
#pragma unroll
    for (int q = 0; q < NT64; ++q)
#pragma unroll
      for (int i = 0; i < 4; ++i) {
        float* tp = tile + q * 4160 + (kk + 16 * i) * 65 + c4;
        tp[0] = v[q * 4 + i].x; tp[1] = v[q * 4 + i].y; tp[2] = v[q * 4 + i].z; tp[3] = v[q * 4 + i].w;
      }
  }
  __syncthreads();
  const int n = t >> 2, kc = (t & 3) * 16;
#pragma unroll
  for (int q = 0; q < NT64; ++q) {
    const float* tq = tile + q * 4160;
    const int n0q = n0 + 64 * q;
    unsigned w[8];
#pragma unroll
    for (int j = 0; j < 8; ++j) w[j] = pack2(tq[(kc + 2 * j) * 65 + n], tq[(kc + 2 * j + 1) * 65 + n]);
    int drow;
    if (mode != 1) drow = n0q + n;
    else {
      int isb = n0q >= DFF;
      int c0 = n0q - (isb ? DFF : 0);
      drow = (c0 >> 7) * 256 + ((c0 >> 6) & 1) * 128 + isb * 64 + n;
    }
    uint4* dp = (uint4*)(dst + (size_t)drow * ldd + k0 + kc);
    if (mode == 2) {
      dp[0] = make_uint4(w[0], w[1], w[4], w[5]);
      dp[1] = make_uint4(w[2], w[3], w[6], w[7]);
    } else {
      dp[0] = make_uint4(w[0], w[1], w[2], w[3]);
      dp[1] = make_uint4(w[4], w[5], w[6], w[7]);
    }
  }
}

DI void mod_task(const Params& p, int l, int cgp, float* sm) {
  float* sv = sm;
  float* red = sm + 5 * 1024;
  const int t = tid_() & 255;
  __syncthreads();
  for (int e = t; e < 5 * 1024; e += 256) {
    int v = e >> 10, k = e & 1023;
    float x = v < 4 ? p.in[8][v * 1024 + k] : p.in[9][k];
    sv[e] = siluf_(x);
  }
  __syncthreads();
  const int c4 = t & 31, ks = t >> 5;
  const float* w = p.in[10] + (size_t)l * 1024 * 6144 + cgp * 128 + c4 * 4;
  float acc[5][4];
#pragma unroll
  for (int v = 0; v < 5; ++v) { acc[v][0] = acc[v][1] = acc[v][2] = acc[v][3] = 0.f; }
#pragma unroll 8
  for (int k = ks * 128; k < ks * 128 + 128; ++k) {
    f32x4 wt_ = __builtin_nontemporal_load((const f32x4*)(w + (size_t)k * 6144));
    float4 wv = make_float4(wt_[0], wt_[1], wt_[2], wt_[3]);
#pragma unroll
    for (int v = 0; v < 5; ++v) {
      float s = sv[v * 1024 + k];
      acc[v][0] += s * wv.x; acc[v][1] += s * wv.y; acc[v][2] += s * wv.z; acc[v][3] += s * wv.w;
    }
  }
#pragma unroll
  for (int v = 0; v < 5; ++v)
#pragma unroll
    for (int j = 0; j < 4; ++j) red[(ks * 32 + c4) * 20 + v * 4 + j] = acc[v][j];
  __syncthreads();
  for (int o = t; o < 640; o += 256) {
    int cc = o / 20, r = o % 20, v = r >> 2, j = r & 3;
    float s = 0.f;
#pragma unroll
    for (int q = 0; q < 8; ++q) s += red[(q * 32 + cc) * 20 + r];
    int col = cgp * 128 + cc * 4 + j;
    s += p.in[11][l * 6144 + col];
    ((float*)(p.ws + OFF_MOD))[(size_t)(l * 5 + v) * 6144 + col] = s;
  }
}

constexpr int T_MOD = 192, T_ROPE = 32, T_WTL = 1072, T_WT = T_WTL * 4, T_CVA = 256, T_CVB = 128, T_CKA = 2048, T_CKB = 512;
constexpr int T_PRE = T_MOD + T_ROPE + T_WT + T_CVA + 2 * T_CVB + T_CKA + 2 * T_CKB;

DI void pre_phase(const Params& p, float* sm0) {
  const int t = tid_() & 255, half = tid_() >> 8;
  float* sm = sm0 + half * 16640;
  for (int pair = blockIdx.x; pair < T_PRE / 2; pair += gridDim.x) {
    int i = pair * 2 + half;
    if (i < T_MOD) { mod_task(p, i / 48, i % 48, sm); continue; }
    i -= T_MOD;
    if (i < T_ROPE) {
      float* cosT = (float*)(p.ws + OFF_ROPE);
      float* sinT = cosT + 1024 * 32;
#pragma unroll
      for (int q = 0; q < 4; ++q) {
        int e = i * 1024 + q * 256 + t;
        int pos = e >> 5, j = e & 31;
        int rr = pos >> 6, cc = pos & 63;
        float inv = exp2f(-(float)(j & 15) * (13.287712379549449f / 16.f));
        float ang = (float)(j < 16 ? rr : cc) * inv;
        cosT[e] = __cosf(ang);
        sinT[e] = __sinf(ang);
      }
      continue;
    }
    i -= T_ROPE;
    if (i < T_WT) {
      int l = i / T_WTL, j = i % T_WTL;
      if (j < 384) { transpose_tile<4>(p.in[14] + (size_t)l * 1024 * 6144, 6144, (j / 24) * 64, (j % 24) * 256, Wt_in(p.ws, l), 1024, 0, sm); continue; }
      j -= 384;
      if (j < 96) {
        int seg = j / 32, jj = j % 32;
        transpose_tile<4>((seg == 0 ? p.in[23] : (seg == 1 ? p.in[24] : p.in[25])) + (size_t)l * 512 * 1024, 1024, (jj / 4) * 64, (jj % 4) * 256, Wt_br(p.ws, l) + seg * 512, 1536, 0, sm);
        continue;
      }
      j -= 96;
      if (j < 64) { transpose_tile<4>(p.in[26] + (size_t)l * 1024 * 1024, 1024, (j / 4) * 64, (j % 4) * 256, Wt_out(p.ws, l), 1024, 0, sm); continue; }
      j -= 64;
      if (j < 352) { transpose_tile<4>(p.in[27] + (size_t)l * 1024 * 5632, 5632, (j / 22) * 64, (j % 22) * 256, Wt_f1(p.ws, l), 1024, 1, sm); continue; }
      j -= 352;
      transpose_tile<4>(p.in[28] + (size_t)l * 2816 * 1024, 1024, (j / 4) * 64, (j % 4) * 256, Wt_f2(p.ws, l), 2816, 0, sm);
      continue;
    }
    i -= T_WT;
    if (i < T_CVA) {
      int bl = i / 16, jj = i % 16, b = bl >> 2, l = bl & 3;
      transpose_tile<4>(p.in[3] + (size_t)bl * 512 * 512, 512, (jj / 2) * 64, (jj % 2) * 256, KVL(p.ws, l, 3) + (size_t)b * 512 * 1536, 1536, 2, sm);
      continue;
    }
    i -= T_CVA;
    if (i < 2 * T_CVB) {
      int wh = i / T_CVB, ii = i % T_CVB;
      int bl = ii / 8, jj = ii % 8, b = bl >> 2, l = bl & 3;
      transpose_tile<2>((wh ? p.in[7] : p.in[5]) + (size_t)bl * 512 * 128, 128, jj * 64, 0, KVL(p.ws, l, wh ? 5 : 4) + (size_t)b * 128 * 1536, 1536, 2, sm);
      continue;
    }
    i -= 2 * T_CVB;
    if (i < T_CKA) {
      size_t e = ((size_t)i * 256 + t) * 8;
      int d = e & 127, h = (e >> 7) & 3, pp = (e >> 9) & 511, l = (e >> 18) & 3, b = (int)(e >> 20);
      const float* sp = p.in[2] + e;
      float4 a = ld_nt4(sp), c = ld_nt4(sp + 4);
      u16* dp = KVL(p.ws, l, 0) + (((size_t)(b * 4 + h) * 1536 + pp) * 128 + d);
      *(uint4*)dp = make_uint4(pack2(a.x, a.y), pack2(a.z, a.w), pack2(c.x, c.y), pack2(c.z, c.w));
      continue;
    }
    i -= T_CKA;
    {
      int wh = i / T_CKB, ii = i % T_CKB;
      size_t e = ((size_t)ii * 256 + t) * 8;
      int d = e & 63, h = (e >> 6) & 1, pp = (e >> 7) & 511, l = (e >> 16) & 3, b = (int)(e >> 18);
      const float* sp = (wh ? p.in[6] : p.in[4]) + e;
      float4 a = ld_nt4(sp), c = ld_nt4(sp + 4);
      u16* dp = KVL(p.ws, l, wh ? 2 : 1) + (((size_t)(b * 2 + h) * 1536 + pp) * 64 + d);
      *(uint4*)dp = make_uint4(pack2(a.x, a.y), pack2(a.z, a.w), pack2(c.x, c.y), pack2(c.z, c.w));
    }
  }
}

DI void norm_phase(const Params& p, int l, int which) {
  const int lane = tid_() & 63;
  const int gw = blockIdx.x * 8 + (tid_() >> 6), nw = gridDim.x * 8;
  for (int row = gw; row < NTOK; row += nw) {
    float v[2][8];
    const bool from_input = (which == 0 && l == 0);
    if (from_input) {
      const float* x = row < NCTX ? p.in[0] + (size_t)row * DM : p.in[1] + (size_t)(row - NCTX) * DM;
#pragma unroll
      for (int c = 0; c < 2; ++c) {
        float4 a = *(const float4*)(x + 8 * lane + 512 * c), b = *(const float4*)(x + 8 * lane + 512 * c + 4);
        v[c][0] = a.x; v[c][1] = a.y; v[c][2] = a.z; v[c][3] = a.w; v[c][4] = b.x; v[c][5] = b.y; v[c][6] = b.z; v[c][7] = b.w;
      }
    } else {
      const u16* x = (const u16*)(p.ws + OFF_X) + (size_t)row * DM;
#pragma unroll
      for (int c = 0; c < 2; ++c) {
        uint4 a = *(const uint4*)(x + 8 * lane + 512 * c);
        v[c][0] = __uint_as_float(a.x << 16); v[c][1] = __uint_as_float(a.x & 0xffff0000u);
        v[c][2] = __uint_as_float(a.y << 16); v[c][3] = __uint_as_float(a.y & 0xffff0000u);
        v[c][4] = __uint_as_float(a.z << 16); v[c][5] = __uint_as_float(a.z & 0xffff0000u);
        v[c][6] = __uint_as_float(a.w << 16); v[c][7] = __uint_as_float(a.w & 0xffff0000u);
      }
    }
    float ss = 0.f;
#pragma unroll
    for (int c = 0; c < 2; ++c)
#pragma unroll
      for (int i = 0; i < 8; ++i) ss += v[c][i] * v[c][i];
    ss = wave_sum(ss);
    const float rs = rsqrtf(ss * (1.f / 1024.f) + 1e-6f);
    if (which == 2) {
      float* o = p.out + (row < NCTX ? O_YP + (size_t)row * DM : O_YS + (size_t)(row - NCTX) * DM);
#pragma unroll
      for (int c = 0; c < 2; ++c) {
        const int col = 8 * lane + 512 * c;
        float4 g0 = *(const float4*)(p.in[29] + col), g1 = *(const float4*)(p.in[29] + col + 4);
        st_nt4(o + col, make_float4(v[c][0] * rs * g0.x, v[c][1] * rs * g0.y, v[c][2] * rs * g0.z, v[c][3] * rs * g0.w));
        st_nt4(o + col + 4, make_float4(v[c][4] * rs * g1.x, v[c][5] * rs * g1.y, v[c][6] * rs * g1.z, v[c][7] * rs * g1.w));
      }
    } else {
      const float* gp = (which == 0 ? p.in[12] : p.in[13]) + l * 1024;
      const float* sh = mod_vec(p, l, row, which == 0 ? 0 : 3);
      const float* sc = mod_vec(p, l, row, which == 0 ? 1 : 4);
      u16* o = (u16*)(p.ws + OFF_HM) + (size_t)row * DM;
#pragma unroll
      for (int c = 0; c < 2; ++c) {
        const int col = 8 * lane + 512 * c;
        float gg[8], s1[8], s0[8];
        *(float4*)&gg[0] = *(const float4*)(gp + col); *(float4*)&gg[4] = *(const float4*)(gp + col + 4);
        *(float4*)&s1[0] = *(const float4*)(sc + col); *(float4*)&s1[4] = *(const float4*)(sc + col + 4);
        *(float4*)&s0[0] = *(const float4*)(sh + col); *(float4*)&s0[4] = *(const float4*)(sh + col + 4);
        float r[8];
#pragma unroll
        for (int i = 0; i < 8; ++i) r[i] = v[c][i] * rs * gg[i] * (1.f + s1[i]) + s0[i];
        *(uint4*)(o + col) = make_uint4(pack2(r[0], r[1]), pack2(r[2], r[3]), pack2(r[4], r[5]), pack2(r[6], r[7]));
      }
    }
  }
}

constexpr int SMEM_BYTES = 8 * 64 * 68 * 4;
enum { EPI_G1 = 0, EPI_G2 = 1, EPI_RES = 2, EPI_SWIGLU = 3 };

struct GemmArgs {
  const u16* A; int lda;
  const u16* Bt; int ldb;
  int K;
  int l;
  int res_chunk;
};

DI void g1_epilogue_wave(const Params& p, int l, int mrow0, int ncol0, const float* ct, int lane);

#define RAW_BARRIER() do { asm volatile("s_waitcnt lgkmcnt(0)" ::: "memory"); __builtin_amdgcn_s_barrier(); } while (0)

template <int EPI, int BN>
DI void gemm_tile(const Params& p, const GemmArgs& g, int m0, int n0, unsigned char* smem) {
  constexpr int NT = BN / 32;
  constexpr int NH = NT / 2;
  constexpr int NI = (256 + BN) / 128;
  constexpr int STAGE = (256 + BN) * 64;
  const int t = tid_(), lane = t & 63, w = t >> 6, wm = w >> 1, wn = w & 1, lc = lane & 15, lq = lane >> 4;
  f32x4 acc[4][NT];
  f32x4 tot[4][NT];
#pragma unroll
  for (int a = 0; a < 4; ++a)
#pragma unroll
    for (int b = 0; b < NT; ++b)
#pragma unroll
      for (int i = 0; i < 4; ++i) { acc[a][b][i] = 0.f; if (EPI == EPI_G2) tot[a][b][i] = 0.f; }

  const int nk = g.K >> 5;
  const int dl_rr = lane >> 2, dl_p = lane & 3;
  const u16* gsrc[NI];
#pragma unroll
  for (int i = 0; i < NI; ++i) {
    const int blk = i * 8 + w, kc = dl_p ^ (dl_rr >> 2);
    if (blk < 16) gsrc[i] = g.A + (size_t)(m0 + blk * 16 + dl_rr) * g.lda + kc * 8;
    else gsrc[i] = g.Bt + (size_t)(n0 + (blk - 16) * 16 + dl_rr) * g.ldb + kc * 8;
  }
  const int dma_off = w * 1024 + lane * 16;
  const unsigned smem_lds = (unsigned)(size_t)smem;
#define DMA_SLICE(J)                                                                                                   \
  {                                                                                                                    \
    unsigned char* bufp_ = smem + ((J) & 3) * STAGE + dma_off;                                                         \
    const size_t koff_ = (size_t)(J) * 32;                                                                             \
    _Pragma("unroll") for (int i_ = 0; i_ < NI; ++i_)                                                                  \
        __builtin_amdgcn_global_load_lds((const unsigned*)(gsrc[i_] + koff_), (LAS unsigned*)(bufp_ + i_ * 8192), 16, 0, 0); \
  }
  __syncthreads();
  DMA_SLICE(0) DMA_SLICE(1) DMA_SLICE(2)
  const unsigned frag_off = lc * 64 + (((lq ^ (lc >> 2)) & 3) << 4);
  const unsigned a_base = smem_lds + (wm * 4) * 1024 + frag_off;
  const unsigned b_base = smem_lds + 16384 + (wn * NT) * 1024 + frag_off;
  bf16x8 a0, a1, a2, a3, c0, c1, c2, c3, bl0, bl1, bl2, bl3, bh0, bh1, bh2, bh3;
#define RD4(ADDR, F0, F1, F2, F3)                                                                                      \
  asm volatile("ds_read_b128 %0, %4\n\tds_read_b128 %1, %4 offset:1024\n\tds_read_b128 %2, %4 offset:2048\n\t"         \
               "ds_read_b128 %3, %4 offset:3072"                                                                       \
               : "=&v"(F0), "=&v"(F1), "=&v"(F2), "=&v"(F3) : "v"(ADDR) : "memory");
#define RD2(ADDR, F0, F1)                                                                                              \
  asm volatile("ds_read_b128 %0, %2\n\tds_read_b128 %1, %2 offset:1024" : "=&v"(F0), "=&v"(F1) : "v"(ADDR) : "memory");
#define RD_B(ADDR, F0, F1, F2, F3) if (NH == 4) { RD4(ADDR, F0, F1, F2, F3) } else { RD2(ADDR, F0, F1) }
#define WT4(F0, F1, F2, F3) asm volatile("s_waitcnt lgkmcnt(0)" : "+v"(F0), "+v"(F1), "+v"(F2), "+v"(F3) :: "memory");
#define WT8(F0, F1, F2, F3, F4, F5, F6, F7)                                                                            \
  asm volatile("s_waitcnt lgkmcnt(0)" : "+v"(F0), "+v"(F1), "+v"(F2), "+v"(F3), "+v"(F4), "+v"(F5), "+v"(F6), "+v"(F7) :: "memory");
#define MF16(A, B, C) __builtin_amdgcn_mfma_f32_16x16x32_bf16((A), (B), (C), 0, 0, 0)
#define MM_HALF(A0, A1, A2, A3, B0, B1, B2, B3, NB)                                                                    \
  acc[0][(NB)] = MF16(A0, B0, acc[0][(NB)]); acc[1][(NB)] = MF16(A1, B0, acc[1][(NB)]);                                \
  acc[2][(NB)] = MF16(A2, B0, acc[2][(NB)]); acc[3][(NB)] = MF16(A3, B0, acc[3][(NB)]);                                \
  acc[0][(NB) + 1] = MF16(A0, B1, acc[0][(NB) + 1]); acc[1][(NB) + 1] = MF16(A1, B1, acc[1][(NB) + 1]);                \
  acc[2][(NB) + 1] = MF16(A2, B1, acc[2][(NB) + 1]); acc[3][(NB) + 1] = MF16(A3, B1, acc[3][(NB) + 1]);                \
  if (NH == 4) {                                                                                                       \
    acc[0][((NB) + 2) % NT] = MF16(A0, B2, acc[0][((NB) + 2) % NT]); acc[1][((NB) + 2) % NT] = MF16(A1, B2, acc[1][((NB) + 2) % NT]); \
    acc[2][((NB) + 2) % NT] = MF16(A2, B2, acc[2][((NB) + 2) % NT]); acc[3][((NB) + 2) % NT] = MF16(A3, B2, acc[3][((NB) + 2) % NT]); \
    acc[0][((NB) + 3) % NT] = MF16(A0, B3, acc[0][((NB) + 3) % NT]); acc[1][((NB) + 3) % NT] = MF16(A1, B3, acc[1][((NB) + 3) % NT]); \
    acc[2][((NB) + 3) % NT] = MF16(A2, B3, acc[2][((NB) + 3) % NT]); acc[3][((NB) + 3) % NT] = MF16(A3, B3, acc[3][((NB) + 3) % NT]); \
  }
#define SLICE_STEP(KT, A0, A1, A2, A3, N0, N1, N2, N3)                                                                 \
  {                                                                                                                    \
    if ((KT) + 2 < nk) { if (NI == 4) asm volatile("s_waitcnt vmcnt(4)" ::: "memory"); else asm volatile("s_waitcnt vmcnt(3)" ::: "memory"); } \
    else asm volatile("s_waitcnt vmcnt(0)" ::: "memory");                                                              \
    WT8(A0, A1, A2, A3, bl0, bl1, bl2, bl3)                                                                            \
    __builtin_amdgcn_s_barrier();                      \
    if ((KT) + 3 < nk) DMA_SLICE((KT) + 3)                                                                             \
    const unsigned so_ = ((KT) & 3) * STAGE;                                                                           \
    RD_B(b_base + so_ + NH * 1024, bh0, bh1, bh2, bh3)                                                                 \
    __builtin_amdgcn_sched_barrier(0);                                           \
    MM_HALF(A0, A1, A2, A3, bl0, bl1, bl2, bl3, 0)                                                                     \
    __builtin_amdgcn_sched_barrier(0);                                                                                 \
    WT4(bh0, bh1, bh2, bh3)                                                                                            \
    __builtin_amdgcn_s_barrier();     \
                                      \
      \
                                                                        \
    MM_PART(A0, A1, A2, A3, bh0, bh1, NH)                                                                              \
    __builtin_amdgcn_sched_barrier(0);                                                                                 \
    if ((KT) + 1 < nk) {                                                                                               \
      const unsigned sn_ = (((KT) + 1) & 3) * STAGE;                                                                   \
      RD4(a_base + sn_, N0, N1, N2, N3)                                                                                \
      RD_B(b_base + sn_, bl0, bl1, bl2, bl3)                                                                           \
    }                                                                                                                  \
    __builtin_amdgcn_sched_barrier(0);                                                                                 \
    MM_REST(A0, A1, A2, A3, bh0, bh1, bh2, bh3, NH)                                                                    \
    __builtin_amdgcn_sched_barrier(0);                                                                                 \
  }
#define MM_PART(A0, A1, A2, A3, B0, B1, NB)                                                                            \
  acc[0][(NB)] = MF16(A0, B0, acc[0][(NB)]); acc[1][(NB)] = MF16(A1, B0, acc[1][(NB)]);                                \
  acc[2][(NB)] = MF16(A2, B0, acc[2][(NB)]); acc[3][(NB)] = MF16(A3, B0, acc[3][(NB)]);                                \
  if (NH == 4) {                                                                                                       \
    acc[0][(NB) + 1] = MF16(A0, B1, acc[0][(NB) + 1]); acc[1][(NB) + 1] = MF16(A1, B1, acc[1][(NB) + 1]);              \
    acc[2][(NB) + 1] = MF16(A2, B1, acc[2][(NB) + 1]); acc[3][(NB) + 1] = MF16(A3, B1, acc[3][(NB) + 1]);              \
  }
#define MM_REST(A0, A1, A2, A3, B0, B1, B2, B3, NB)                                                                    \
  if (NH == 4) {                                                                                                       \
    acc[0][((NB) + 2) % NT] = MF16(A0, B2, acc[0][((NB) + 2) % NT]); acc[1][((NB) + 2) % NT] = MF16(A1, B2, acc[1][((NB) + 2) % NT]); \
    acc[2][((NB) + 2) % NT] = MF16(A2, B2, acc[2][((NB) + 2) % NT]); acc[3][((NB) + 2) % NT] = MF16(A3, B2, acc[3][((NB) + 2) % NT]); \
    acc[0][((NB) + 3) % NT] = MF16(A0, B3, acc[0][((NB) + 3) % NT]); acc[1][((NB) + 3) % NT] = MF16(A1, B3, acc[1][((NB) + 3) % NT]); \
    acc[2][((NB) + 3) % NT] = MF16(A2, B3, acc[2][((NB) + 3) % NT]); acc[3][((NB) + 3) % NT] = MF16(A3, B3, acc[3][((NB) + 3) % NT]); \
  } else {                                                                                                             \
    acc[0][(NB) + 1] = MF16(A0, B1, acc[0][(NB) + 1]); acc[1][(NB) + 1] = MF16(A1, B1, acc[1][(NB) + 1]);              \
    acc[2][(NB) + 1] = MF16(A2, B1, acc[2][(NB) + 1]); acc[3][(NB) + 1] = MF16(A3, B1, acc[3][(NB) + 1]);              \
  }
#ifndef PIPE_BN
#define PIPE_BN 256
#endif
#define SIMPLE_STEP(KT)                                                                                                \
  {                                                                                                                    \
    if ((KT) + 2 < nk) { if (NI == 4) asm volatile("s_waitcnt vmcnt(8)" ::: "memory"); else asm volatile("s_waitcnt vmcnt(6)" ::: "memory"); } \
    else if ((KT) + 1 < nk) { if (NI == 4) asm volatile("s_waitcnt vmcnt(4)" ::: "memory"); else asm volatile("s_waitcnt vmcnt(3)" ::: "memory"); } \
    else asm volatile("s_waitcnt vmcnt(0)" ::: "memory");                                                              \
    RAW_BARRIER();                                                                                                     \
    G2_PREFETCH(KT)                                                                                                    \
    if ((KT) + 3 < nk) DMA_SLICE((KT) + 3)                                                                             \
    const unsigned so_ = ((KT) & 3) * STAGE;                                                                           \
    RD4(a_base + so_, a0, a1, a2, a3)                                                                                  \
    RD_B(b_base + so_, bl0, bl1, bl2, bl3)                                                                             \
    RD_B(b_base + so_ + NH * 1024, bh0, bh1, bh2, bh3)                                                                 \
    WT8(a0, a1, a2, a3, bl0, bl1, bl2, bl3)                                                                            \
    WT4(bh0, bh1, bh2, bh3)                                                                                            \
    MM_HALF(a0, a1, a2, a3, bl0, bl1, bl2, bl3, 0)                                                                     \
    MM_HALF(a0, a1, a2, a3, bh0, bh1, bh2, bh3, NH)                                                                    \
  }
  u32x2 gqr[4][NT];
#pragma unroll
  for (int a = 0; a < 4; ++a)
#pragma unroll
    for (int b = 0; b < NT; ++b) gqr[a][b] = (u32x2){0u, 0u};
#define G2_PREFETCH(KT)                                                                                                \
  if (EPI == EPI_G2 && (((KT) & 15) == 15)) {                                                                          \
    const int seg_ = (KT) >> 4;                                                                                        \
    _Pragma("unroll") for (int a = 0; a < 4; ++a) _Pragma("unroll") for (int b = 0; b < NT; ++b) {                     \
      const int r16 = (m0 + wm * 64 + a * 16) >> 4, c16 = (seg_ * 1024 + n0 + wn * (BN / 2) + b * 16) >> 4;           \
      gqr[a][b] = __builtin_nontemporal_load((const u32x2*)((const u16*)(p.ws + OFF_GH) + ((size_t)(r16 * 192 + c16) * 64 + lane) * 4)); \
    }                                                                                                                  \
  }
  constexpr bool PIPE = (BN == PIPE_BN) || (PIPE_BN == 0) || (EPI == EPI_RES);
  c0 = c1 = c2 = c3 = a0 = a1 = a2 = a3 = bl0 = bl1 = bl2 = bl3 = bh0 = bh1 = bh2 = bh3 = (bf16x8)(0);
  if (PIPE) {
    if (NI == 4) asm volatile("s_waitcnt vmcnt(8)" ::: "memory"); else asm volatile("s_waitcnt vmcnt(6)" ::: "memory");
    RAW_BARRIER();
    RD4(a_base, a0, a1, a2, a3)
    RD_B(b_base, bl0, bl1, bl2, bl3)
    if (w >= 4) __builtin_amdgcn_s_barrier();
  }
  for (int kt = 0; kt < nk; kt += 2) {
    if (PIPE) {
      SLICE_STEP(kt, a0, a1, a2, a3, c0, c1, c2, c3)
      SLICE_STEP(kt + 1, c0, c1, c2, c3, a0, a1, a2, a3)
    } else {
      SIMPLE_STEP(kt)
      SIMPLE_STEP(kt + 1)
    }
    if (EPI == EPI_G2) {
      if (((kt + 1) & 15) == 15) {
        if (PIPE) { WT8(a0, a1, a2, a3, bl0, bl1, bl2, bl3) }
        const int seg = (kt + 1) >> 4;
#pragma unroll
        for (int a = 0; a < 4; ++a)
#pragma unroll
          for (int b = 0; b < NT; ++b) {
            const int r16 = (m0 + wm * 64 + a * 16) >> 4, c16 = (seg * 1024 + n0 + wn * (BN / 2) + b * 16) >> 4;
            u32x2 gq_ = gqr[a][b];
            if (PIPE) gq_ = __builtin_nontemporal_load((const u32x2*)((const u16*)(p.ws + OFF_GH) + ((size_t)(r16 * 192 + c16) * 64 + lane) * 4));
            const uint2 gq = make_uint2(gq_[0], gq_[1]);
            tot[a][b][0] += __uint_as_float(gq.x << 16) * acc[a][b][0];
            tot[a][b][1] += __uint_as_float(gq.x & 0xffff0000u) * acc[a][b][1];
            tot[a][b][2] += __uint_as_float(gq.y << 16) * acc[a][b][2];
            tot[a][b][3] += __uint_as_float(gq.y & 0xffff0000u) * acc[a][b][3];
            acc[a][b][0] = 0.f; acc[a][b][1] = 0.f; acc[a][b][2] = 0.f; acc[a][b][3] = 0.f;
          }
      }
    }
  }
  if (PIPE && w < 4) __builtin_amdgcn_s_barrier();
  __syncthreads();

  const int rbase = m0 + wm * 64, cbase = n0 + wn * (BN / 2);
  if (EPI == EPI_G1) {
    if (n0 >= 3072) {
#pragma unroll
      for (int a = 0; a < 4; ++a)
#pragma unroll
        for (int b = 0; b < NT; ++b) {
          const int r16 = (rbase + a * 16) >> 4, c16 = (cbase - 3072 + b * 16) >> 4;
          u16* gp = (u16*)(p.ws + OFF_GH) + ((size_t)(r16 * 192 + c16) * 64 + lane) * 4;
          *(uint2*)gp = make_uint2(pack2(sigmoidf_(acc[a][b][0]), sigmoidf_(acc[a][b][1])), pack2(sigmoidf_(acc[a][b][2]), sigmoidf_(acc[a][b][3])));
        }
    } else {
      float* ct = (float*)smem + w * (64 * 68);
#pragma unroll
      for (int hf = 0; hf < NT / 4; ++hf) {
#pragma unroll
        for (int a = 0; a < 4; ++a)
#pragma unroll
          for (int b = 0; b < 4; ++b)
#pragma unroll
            for (int i = 0; i < 4; ++i)
              ct[(a * 16 + 4 * lq + i) * 68 + b * 16 + lc] = acc[a][(hf * 4 + b) % NT][i];
        g1_epilogue_wave(p, g.l, rbase, cbase + hf * 64, ct, lane);
      }
    }
  } else if (EPI == EPI_G2) {
    u16* o = (u16*)(p.ws + OFF_HM);
    float* ct = (float*)smem + w * (64 * 68);
#pragma unroll
    for (int a = 0; a < 4; ++a)
#pragma unroll
      for (int b = 0; b < NT; ++b)
#pragma unroll
        for (int i = 0; i < 4; ++i) ct[(a * 16 + 4 * lq + i) * 68 + b * 16 + lc] = tot[a][b][i];
#pragma unroll 8
    for (int it = lane; it < 512; it += 64) {
      const int rl = it >> 3, c8 = (it & 7) * 8;
      float4 v0 = *(const float4*)(ct + rl * 68 + c8), v1 = *(const float4*)(ct + rl * 68 + c8 + 4);
      *(uint4*)(o + (size_t)(rbase + rl) * DM + cbase + c8) = make_uint4(pack2(v0.x, v0.y), pack2(v0.z, v0.w), pack2(v1.x, v1.y), pack2(v1.z, v1.w));
    }
  } else if (EPI == EPI_RES) {
    u16* xo = (u16*)(p.ws + OFF_X);
    const bool from_input = (g.res_chunk == 2) && g.l == 0;
    float* ct = (float*)smem + w * (64 * 68);
#pragma unroll
    for (int a = 0; a < 4; ++a)
#pragma unroll
      for (int b = 0; b < NT; ++b)
#pragma unroll
        for (int i = 0; i < 4; ++i) ct[(a * 16 + 4 * lq + i) * 68 + b * 16 + lc] = acc[a][b][i];
#pragma unroll 8
    for (int it = lane; it < 512; it += 64) {
      const int rl = it >> 3, c8 = (it & 7) * 8;
      const int row = rbase + rl, col = cbase + c8;
      float4 v0 = *(const float4*)(ct + rl * 68 + c8), v1 = *(const float4*)(ct + rl * 68 + c8 + 4);
      const float* gate = mod_vec(p, g.l, row, g.res_chunk) + col;
      float4 g0 = *(const float4*)gate, g1 = *(const float4*)(gate + 4);
      float x[8];
      if (from_input) {
        const float* xin = (row < NCTX ? p.in[0] + (size_t)row * DM : p.in[1] + (size_t)(row - NCTX) * DM) + col;
        float4 a0 = *(const float4*)xin, a1 = *(const float4*)(xin + 4);
        x[0] = a0.x; x[1] = a0.y; x[2] = a0.z; x[3] = a0.w; x[4] = a1.x; x[5] = a1.y; x[6] = a1.z; x[7] = a1.w;
      } else {
        uint4 xb = *(const uint4*)(xo + (size_t)row * DM + col);
        x[0] = __uint_as_float(xb.x << 16); x[1] = __uint_as_float(xb.x & 0xffff0000u);
        x[2] = __uint_as_float(xb.y << 16); x[3] = __uint_as_float(xb.y & 0xffff0000u);
        x[4] = __uint_as_float(xb.z << 16); x[5] = __uint_as_float(xb.z & 0xffff0000u);
        x[6] = __uint_as_float(xb.w << 16); x[7] = __uint_as_float(xb.w & 0xffff0000u);
      }
      x[0] += g0.x * v0.x; x[1] += g0.y * v0.y; x[2] += g0.z * v0.z; x[3] += g0.w * v0.w;
      x[4] += g1.x * v1.x; x[5] += g1.y * v1.y; x[6] += g1.z * v1.z; x[7] += g1.w * v1.w;
      *(uint4*)(xo + (size_t)row * DM + col) = make_uint4(pack2(x[0], x[1]), pack2(x[2], x[3]), pack2(x[4], x[5]), pack2(x[6], x[7]));
    }
  } else if (EPI == EPI_SWIGLU) {
    u16* o = (u16*)(p.ws + OFF_GH);
    float* ct = (float*)smem + w * (64 * 68);
#pragma unroll
    for (int a = 0; a < 4; ++a)
#pragma unroll
      for (int b = 0; b < NT / 2; ++b)
#pragma unroll
        for (int i = 0; i < 4; ++i) ct[(a * 16 + 4 * lq + i) * 68 + b * 16 + lc] = siluf_(acc[a][b][i]) * acc[a][(b + NT / 2) % NT][i];
    const int colb0 = (n0 >> 8) * 128 + wn * 64;
#pragma unroll 8
    for (int it = lane; it < 512; it += 64) {
      const int rl = it >> 3, c8 = (it & 7) * 8;
      float4 v0 = *(const float4*)(ct + rl * 68 + c8), v1 = *(const float4*)(ct + rl * 68 + c8 + 4);
      *(uint4*)(o + (size_t)(rbase + rl) * DFF + colb0 + c8) = make_uint4(pack2(v0.x, v0.y), pack2(v0.z, v0.w), pack2(v1.x, v1.y), pack2(v1.z, v1.w));
    }
  }
}

DI void g1_epilogue_wave(const Params& p, int l, int mrow0, int ncol0, const float* ct, int lane) {
  const bool ctx = mrow0 < NCTX;
  int kind;
  int br;
  int nrel;
  const int n0 = ncol0;
  if (n0 < 512) { kind = 0; br = 0; nrel = n0; }
  else if (n0 < 1024) { kind = 1; br = 0; nrel = n0 - 512; }
  else if (n0 < 1536) { kind = 2; br = 0; nrel = n0 - 1024; }
  else if (n0 < 2048) { kind = 0; br = 1; nrel = n0 - 1536; }
  else if (n0 < 2176) { kind = 1; br = 1; nrel = n0 - 2048; }
  else if (n0 < 2304) { kind = 2; br = 1; nrel = n0 - 2176; }
  else if (n0 < 2816) { kind = 0; br = 2; nrel = n0 - 2304; }
  else if (n0 < 2944) { kind = 1; br = 2; nrel = n0 - 2816; }
  else { kind = 2; br = 2; nrel = n0 - 2944; }

  if (kind < 2) {
    const int j = lane & 7, grp = lane >> 3;
    const float* cosT = (const float*)(p.ws + OFF_ROPE);
    const float* sinT = cosT + 1024 * 32;
    const float* gn = (kind == 0 ? p.in[20] : p.in[21]) + l * 64;
    for (int rl = grp; rl < 64; rl += 8) {
      const int row = mrow0 + rl;
      const float* cp = ct + rl * 68;
      float4 lo = *(const float4*)(cp + 4 * j), hi = *(const float4*)(cp + 32 + 4 * j);
      if (br == 1) {
        float ss = lo.x * lo.x + lo.y * lo.y + lo.z * lo.z + lo.w * lo.w + hi.x * hi.x + hi.y * hi.y + hi.z * hi.z + hi.w * hi.w;
        ss += __shfl_xor(ss, 1); ss += __shfl_xor(ss, 2); ss += __shfl_xor(ss, 4);
        float rs = rsqrtf(ss * (1.f / 64.f) + 1e-6f);
        float4 g0 = *(const float4*)(gn + 4 * j), g1 = *(const float4*)(gn + 32 + 4 * j);
        lo.x *= rs * g0.x; lo.y *= rs * g0.y; lo.z *= rs * g0.z; lo.w *= rs * g0.w;
        hi.x *= rs * g1.x; hi.y *= rs * g1.y; hi.z *= rs * g1.z; hi.w *= rs * g1.w;
      }
      if (!ctx) {
        const int pos = (row - NCTX) & 1023;
        float4 c = *(const float4*)(cosT + pos * 32 + 4 * j), sn = *(const float4*)(sinT + pos * 32 + 4 * j);
        float4 nlo = make_float4(lo.x * c.x - hi.x * sn.x, lo.y * c.y - hi.y * sn.y, lo.z * c.z - hi.z * sn.z, lo.w * c.w - hi.w * sn.w);
        float4 nhi = make_float4(hi.x * c.x + lo.x * sn.x, hi.y * c.y + lo.y * sn.y, hi.z * c.z + lo.z * sn.z, hi.w * c.w + lo.w * sn.w);
        lo = nlo; hi = nhi;
      }
      const int nc = nrel;
      if (kind == 0) {
        u16* q = (u16*)(p.ws + OFF_Q) + (size_t)row * 1536 + br * 512 + nc;
        *(uint2*)(q + 4 * j) = make_uint2(pack2(lo.x * 0.125f, lo.y * 0.125f), pack2(lo.z * 0.125f, lo.w * 0.125f));
        *(uint2*)(q + 32 + 4 * j) = make_uint2(pack2(hi.x * 0.125f, hi.y * 0.125f), pack2(hi.z * 0.125f, hi.w * 0.125f));
      } else {
        const int hd = (br == 0) ? 128 : 64, nh = (br == 0) ? 4 : 2;
        const int head = nc / hd, d = nc % hd;
        u16* kd;
        if (ctx) {
          const int b = row >> 8, key = row & 255;
          kd = KVC(p.ws, br) + ((size_t)(b * nh + head) * 256 + key) * hd + d;
          float* od = p.out + (br == 0 ? O_AK : (br == 1 ? O_BK : O_CK)) + ((size_t)((b * 4 + l) * 256 + key) * nh + head) * hd + d;
          st_nt4(od + 4 * j, lo);
          st_nt4(od + 32 + 4 * j, hi);
        } else {
          const int b = (row - NCTX) >> 10, pos = (row - NCTX) & 1023;
          kd = KVL(p.ws, l, br) + ((size_t)(b * nh + head) * 1536 + 512 + pos) * hd + d;
        }
        *(uint2*)(kd + 4 * j) = make_uint2(pack2(lo.x, lo.y), pack2(lo.z, lo.w));
        *(uint2*)(kd + 32 + 4 * j) = make_uint2(pack2(hi.x, hi.y), pack2(hi.z, hi.w));
      }
    }
  } else {
    const int nrows = (br == 0) ? 512 : 128;
    for (int it = lane; it < 256; it += 64) {
      const int gq = it & 3, c = it >> 2;
      const int row0 = mrow0 + gq * 16;
      float v[16];
#pragma unroll
      for (int i = 0; i < 16; ++i) v[i] = ct[(gq * 16 + i) * 68 + c];
      u16* vd;
      if (ctx) {
        const int b = row0 >> 8, key = row0 & 255;
        vd = KVC(p.ws, 3 + br) + ((size_t)b * nrows + nrel + c) * 256 + key;
      } else {
        const int b = (row0 - NCTX) >> 10, pos = (row0 - NCTX) & 1023;
        vd = KVL(p.ws, l, 3 + br) + ((size_t)b * nrows + nrel + c) * 1536 + 512 + pos;
      }
      *(uint4*)vd = make_uint4(pack2(v[0], v[1]), pack2(v[2], v[3]), pack2(v[8], v[9]), pack2(v[10], v[11]));
      *(uint4*)(vd + 8) = make_uint4(pack2(v[4], v[5]), pack2(v[6], v[7]), pack2(v[12], v[13]), pack2(v[14], v[15]));
    }
    if (ctx) {
      float* ob = p.out + (br == 0 ? O_AV : (br == 1 ? O_BV : O_CV));
      for (int it = lane; it < 1024; it += 64) {
        const int rl = it >> 4, c4 = (it & 15) * 4;
        const int row = mrow0 + rl, b = row >> 8, key = row & 255;
        float4 v = *(const float4*)(ct + rl * 68 + c4);
        st_nt4(ob + (size_t)((b * 4 + l) * 256 + key) * nrows + nrel + c4, v);
      }
    }
  }
}

template <int EPI, int BN>
DI void gemm_phase(const Params& p, const GemmArgs& g, int ntn, unsigned char* smem) {
  if (gridDim.x == 256) {
    const int xcd = blockIdx.x & 7, j = blockIdx.x >> 3;
    for (int il = j; il < 4 * ntn; il += 32) {
      const int mt = 4 * xcd + (il & 3), nt = il >> 2;
      gemm_tile<EPI, BN>(p, g, mt * 256, nt * BN, smem);
    }
  } else {
    const int ntiles = 32 * ntn;
    for (int tile = blockIdx.x; tile < ntiles; tile += gridDim.x) {
      const int mt = tile / ntn, nt = tile % ntn;
      gemm_tile<EPI, BN>(p, g, mt * 256, nt * BN, smem);
    }
  }
}

constexpr float LOG2E = 1.4426950408889634f;
constexpr int N_ATT_ITEMS = 768;
constexpr int VT_PITCH = 144;

DI void load_q(bf16x8 (&qf)[4], const u16* Q, int row, int coloff, int h) {
  const u16* qp = Q + (size_t)row * 1536 + coloff + 8 * h;
#pragma unroll
  for (int s = 0; s < 4; ++s) qf[s] = __builtin_nontemporal_load((const bf16x8*)(qp + 16 * s));
}

template <int DV, int KD>
DI void attn_item(f32x16 (&o)[DV / 32], unsigned char* smem, const u16* __restrict__ Kg, const u16* __restrict__ Vg, int nkeys,
                  int n_tiles, int band_t0, const bf16x8 (&qf)[4], int koff, bool has_band, int qpos, float m_init, float l_init) {
  constexpr int KPITCH = KD * 2 + 16;
  constexpr int KBYTES = 64 * KPITCH;
  constexpr int VBYTES = DV * VT_PITCH;
  constexpr int BUF = KBYTES + VBYTES;
  constexpr int KCH = KD / 8;
  constexpr int NK = KD / 64;
  constexpr int NV = DV / 64;
  const int t = tid_(), lane = t & 63, r = lane & 31, h = lane >> 5;
  const int krow = t / KCH, kkc = t % KCH;
  const int vrow = t >> 3, vkc = t & 7;
  const u16* kgp = Kg + (size_t)krow * KD + kkc * 8;
  const u16* vgp = Vg + (size_t)vrow * nkeys + vkc * 8;
  const int klds = krow * KPITCH + kkc * 16;
  const int vlds = KBYTES + vrow * VT_PITCH + vkc * 16;
  uint4 k0, k1, v0, v1;
  k1 = v1 = make_uint4(0, 0, 0, 0);
#define ATT_TILE(i) ((i) < 8 || !has_band ? (i) : 8 + band_t0 + (i) - 8)
#define ATT_GLOAD(TI)                                                                   \
  {                                                                                     \
    const size_t key0_ = (size_t)(TI) * 64;                                             \
    k0 = *(const uint4*)(kgp + key0_ * KD);                                             \
    if (NK == 2) k1 = *(const uint4*)(kgp + (key0_ + 32) * KD);                         \
    v0 = *(const uint4*)(vgp + key0_);                                                  \
    if (NV == 2) v1 = *(const uint4*)(vgp + key0_ + (size_t)64 * nkeys);                \
  }
#define ATT_LSTORE(DST)                                                                 \
  {                                                                                     \
    *(uint4*)((DST) + klds) = k0;                                                       \
    if (NK == 2) *(uint4*)((DST) + klds + 32 * KPITCH) = k1;                            \
    *(uint4*)((DST) + vlds) = v0;                                                       \
    if (NV == 2) *(uint4*)((DST) + vlds + 64 * VT_PITCH) = v1;                          \
  }
  float m = m_init, l = l_init;
#pragma unroll
  for (int dt = 0; dt < DV / 32; ++dt)
#pragma unroll
    for (int i = 0; i < 16; ++i) o[dt][i] = 0.f;

  ATT_GLOAD(ATT_TILE(0))
  __syncthreads();
  ATT_LSTORE(smem)
  __syncthreads();
  for (int it = 0; it < n_tiles; ++it) {
    const int cur = it & 1;
    const int tile = ATT_TILE(it);
    if (it + 1 < n_tiles) ATT_GLOAD(ATT_TILE(it + 1))
    const unsigned char* kb = smem + cur * BUF + r * KPITCH + (koff + 8 * h) * 2;
    const unsigned char* vb = smem + cur * BUF + KBYTES + r * VT_PITCH + 16 * h;
    f32x16 S0, S1;
#pragma unroll
    for (int i = 0; i < 16; ++i) { S0[i] = 0.f; S1[i] = 0.f; }
#pragma unroll
    for (int s = 0; s < 4; ++s) {
      bf16x8 ka = *(const bf16x8*)(kb + 32 * s);
      bf16x8 kc = *(const bf16x8*)(kb + 32 * KPITCH + 32 * s);
      S0 = MFMA32(ka, qf[s], S0);
      S1 = MFMA32(kc, qf[s], S1);
    }
    if (has_band && it >= 8) {
      const int kbase = (tile - 8) * 64 - qpos;
#pragma unroll
      for (int i = 0; i < 16; ++i) {
        int d0 = kbase + crow(i, h), d1 = d0 + 32;
        if (d0 < -128 || d0 > 128) S0[i] = -1e30f;
        if (d1 < -128 || d1 > 128) S1[i] = -1e30f;
      }
    }
    float mx = fmaxf(S0[0], S1[0]);
#pragma unroll
    for (int i = 1; i < 16; ++i) mx = __builtin_fmaxf(__builtin_fmaxf(mx, S0[i]), S1[i]);
    mx = fmaxf(mx, __shfl_xor(mx, 32));
    const float mn = fmaxf(m, mx);
    const float mb = mn * LOG2E;
    float ps;
    {
      const f2_t sc2 = {LOG2E, LOG2E}, nb2 = {-mb, -mb};
      f2_t ps2 = {0.f, 0.f};
#pragma unroll
      for (int i = 0; i < 8; ++i) {
        f2_t a = {S0[2 * i], S0[2 * i + 1]}, b = {S1[2 * i], S1[2 * i + 1]};
        a = __builtin_elementwise_fma(a, sc2, nb2);
        b = __builtin_elementwise_fma(b, sc2, nb2);
        a.x = __builtin_amdgcn_exp2f(a.x); a.y = __builtin_amdgcn_exp2f(a.y);
        b.x = __builtin_amdgcn_exp2f(b.x); b.y = __builtin_amdgcn_exp2f(b.y);
        S0[2 * i] = a.x; S0[2 * i + 1] = a.y; S1[2 * i] = b.x; S1[2 * i + 1] = b.y;
        ps2 += a; ps2 += b;
      }
      ps = ps2.x + ps2.y;
    }
    if (__any(mn != m)) {
      const float alpha = __builtin_amdgcn_exp2f((m - mn) * LOG2E);
      l *= alpha;
#pragma unroll
      for (int dt = 0; dt < DV / 32; ++dt)
#pragma unroll
        for (int i = 0; i < 16; ++i) o[dt][i] *= alpha;
      m = mn;
    }
    l += ps;
    bf16x8 pf0, pf1, pf2, pf3;
    {
      uint4 u;
      u = make_uint4(pack2(S0[0], S0[1]), pack2(S0[2], S0[3]), pack2(S0[4], S0[5]), pack2(S0[6], S0[7])); pf0 = __builtin_bit_cast(bf16x8, u);
      u = make_uint4(pack2(S0[8], S0[9]), pack2(S0[10], S0[11]), pack2(S0[12], S0[13]), pack2(S0[14], S0[15])); pf1 = __builtin_bit_cast(bf16x8, u);
      u = make_uint4(pack2(S1[0], S1[1]), pack2(S1[2], S1[3]), pack2(S1[4], S1[5]), pack2(S1[6], S1[7])); pf2 = __builtin_bit_cast(bf16x8, u);
      u = make_uint4(pack2(S1[8], S1[9]), pack2(S1[10], S1[11]), pack2(S1[12], S1[13]), pack2(S1[14], S1[15])); pf3 = __builtin_bit_cast(bf16x8, u);
    }
#pragma unroll
    for (int dt = 0; dt < DV / 32; ++dt) {
      const unsigned char* vp = vb + dt * 32 * VT_PITCH;
      o[dt] = MFMA32(*(const bf16x8*)(vp), pf0, o[dt]);
      o[dt] = MFMA32(*(const bf16x8*)(vp + 32), pf1, o[dt]);
      o[dt] = MFMA32(*(const bf16x8*)(vp + 64), pf2, o[dt]);
      o[dt] = MFMA32(*(const bf16x8*)(vp + 96), pf3, o[dt]);
    }
    if (it + 1 < n_tiles) {
      unsigned char* dst = smem + (cur ^ 1) * BUF;
      ATT_LSTORE(dst)
    }
    __syncthreads();
  }
  const float lt = l + __shfl_xor(l, 32);
  const float inv = 1.f / lt;
#pragma unroll
  for (int dt = 0; dt < DV / 32; ++dt)
#pragma unroll
    for (int i = 0; i < 16; ++i) o[dt][i] *= inv;
}

DI void attn_phase(const Params& p, int l, int ph, unsigned char* smem) {
  __shared__ int s_item;
  const int t = tid_(), lane = t & 63, wv = t >> 6, r = lane & 31, h = lane >> 5;
  const u16* Q = (const u16*)(p.ws + OFF_Q);
  u16* AO = (u16*)(p.ws + OFF_ATT);
  unsigned* ctr = (unsigned*)(p.ws + OFF_BAR + 14336) + ph;
  float lam;
  {
    float a = p.in[15][l * 64 + lane] * p.in[16][l * 64 + lane];
    float b = p.in[17][l * 64 + lane] * p.in[18][l * 64 + lane];
    a = wave_sum(a); b = wave_sum(b);
    lam = __expf(a) - __expf(b) + p.lam_init[l];
  }
  const float one_m_li = 1.f - p.lam_init[l];
  const bool static_first = gridDim.x == 256;
  bool first = true;
  for (;;) {
    __syncthreads();
    if (t == 0) {
      if (first && static_first) {
        const int xcd = blockIdx.x & 7, j = blockIdx.x >> 3;
        if (j < 16) { const int g = 2 * xcd + (j >> 3); s_item = (g >> 2) * 32 + (g & 3) * 8 + (j & 7); }
        else s_item = 128 + (xcd >> 1) * 32 + (xcd & 1) * 16 + (j - 16);
      } else {
        s_item = (static_first ? 256 : 0) + (int)atomicAdd(ctr, 1u);
      }
    }
    first = false;
    __syncthreads();
    const int it = s_item;
    if (it >= N_ATT_ITEMS) break;
    const int cls = it >> 7, i = it & 127;
    const int lat = cls < 3, br = cls % 3;
    const int nkeys = lat ? 1536 : 256;
    if (br == 0) {
      int b, hd, qb;
      if (lat) { b = i >> 5; hd = (i >> 3) & 3; qb = i & 7; } else { b = i >> 3; hd = (i >> 1) & 3; qb = i & 1; }
      const int pass = wv >> 2;
      const int row = (lat ? NCTX + b * 1024 : b * 256) + qb * 128 + (wv & 3) * 32 + r;
      const u16* Kb = (lat ? KVL(p.ws, l, 0) : KVC(p.ws, 0)) + (size_t)(b * 4 + hd) * nkeys * 128;
      const u16* Vb = (lat ? KVL(p.ws, l, 3) : KVC(p.ws, 3)) + (size_t)(b * 4 + hd) * 128 * nkeys;
      bf16x8 qf[4];
      load_q(qf, Q, row, hd * 128 + pass * 64, h);
      f32x16 o[4];
      attn_item<128, 128>(o, smem, Kb, Vb, nkeys, nkeys / 64, 0, qf, pass * 64, false, 0, -1e30f, 0.f);
      float* stash = (float*)smem + (wv & 3) * 4096;
      if (pass == 1) {
#pragma unroll
        for (int dt = 0; dt < 4; ++dt)
#pragma unroll
          for (int q = 0; q < 16; ++q) stash[(dt * 16 + q) * 64 + lane] = o[dt][q];
      }
      __syncthreads();
      if (pass == 0) {
        float ss = 0.f;
#pragma unroll
        for (int dt = 0; dt < 4; ++dt)
#pragma unroll
          for (int q = 0; q < 16; ++q) {
            float v = o[dt][q] - lam * stash[(dt * 16 + q) * 64 + lane];
            o[dt][q] = v;
            ss += v * v;
          }
        ss += __shfl_xor(ss, 32);
        const float rs = rsqrtf(ss * (1.f / 128.f) + 1e-6f) * one_m_li;
        const float* sg = p.in[19] + l * 128;
        u16* tl = (u16*)(smem + 65536 + wv * 8704);
#pragma unroll
        for (int dt = 0; dt < 4; ++dt)
#pragma unroll
          for (int g4 = 0; g4 < 4; ++g4) {
            const int d = dt * 32 + 8 * g4 + 4 * h;
            float4 gg = *(const float4*)(sg + d);
            unsigned w0 = pack2(o[dt][4 * g4] * rs * gg.x, o[dt][4 * g4 + 1] * rs * gg.y);
            unsigned w1 = pack2(o[dt][4 * g4 + 2] * rs * gg.z, o[dt][4 * g4 + 3] * rs * gg.w);
            *(uint2*)(tl + r * 136 + d) = make_uint2(w0, w1);
          }
        u16* ob = AO + (size_t)(row - r) * 1536 + hd * 128;
#pragma unroll
        for (int q = 0; q < 8; ++q) {
          const int itx = lane + 64 * q, rr = itx >> 4, c8 = (itx & 15) * 8;
          *(uint4*)(ob + (size_t)rr * 1536 + c8) = *(const uint4*)(tl + rr * 136 + c8);
        }
      }
    } else {
      int b, kvh, qg;
      if (lat) { b = i >> 5; kvh = (i >> 4) & 1; qg = i & 15; } else { b = i >> 3; kvh = (i >> 2) & 1; qg = i & 3; }
      const int hd = kvh * 4 + (wv & 3), qsub = wv >> 2;
      const int row = (lat ? NCTX + b * 1024 : b * 256) + qg * 64 + qsub * 32 + r;
      const u16* Kb = (lat ? KVL(p.ws, l, br) : KVC(p.ws, br)) + (size_t)(b * 2 + kvh) * nkeys * 64;
      const u16* Vb = (lat ? KVL(p.ws, l, 3 + br) : KVC(p.ws, 3 + br)) + (size_t)(b * 2 + kvh) * 64 * nkeys;
      bf16x8 qf[4];
      load_q(qf, Q, row, br * 512 + hd * 64, h);
      f32x16 o[2];
      const bool band = (br == 2) && lat;
      int n_tiles = nkeys / 64, t0 = 0;
      if (band) {
        const int q0 = qg * 64;
        t0 = (q0 - 128) < 0 ? 0 : (q0 - 128) >> 6;
        int t1 = (q0 + 191) >> 6; if (t1 > 15) t1 = 15;
        n_tiles = 8 + (t1 - t0 + 1);
      }
      const float m0 = (br == 2) ? p.in[22][l * 8 + hd] : -1e30f;
      const float l0 = (br == 2 && h == 0) ? 1.f : 0.f;
      attn_item<64, 64>(o, smem, Kb, Vb, nkeys, n_tiles, t0, qf, 0, band, qg * 64 + qsub * 32 + r, m0, l0);
      u16* tl = (u16*)(smem + 65536 + wv * 8704);
#pragma unroll
      for (int dt = 0; dt < 2; ++dt)
#pragma unroll
        for (int g4 = 0; g4 < 4; ++g4) {
          const int d = dt * 32 + 8 * g4 + 4 * h;
          unsigned w0 = pack2(o[dt][4 * g4], o[dt][4 * g4 + 1]);
          unsigned w1 = pack2(o[dt][4 * g4 + 2], o[dt][4 * g4 + 3]);
          *(uint2*)(tl + r * 72 + d) = make_uint2(w0, w1);
        }
      u16* ob = AO + (size_t)(row - r) * 1536 + br * 512 + hd * 64;
#pragma unroll
      for (int q = 0; q < 4; ++q) {
        const int itx = lane + 64 * q, rr = itx >> 3, c8 = (itx & 7) * 8;
        *(uint4*)(ob + (size_t)rr * 1536 + c8) = *(const uint4*)(tl + rr * 72 + c8);
      }
    }
  }
}

#define XB_TMO      128
#define XB_XCNT(j)  (256  + 64 * (j))
#define XB_XSUB(j)  (1280 + 64 * (j))
#define XB_XGEN(j)  (2304 + 64 * (j))
#define XB_TOP      3328
#define XB_TOPGEN   3392
#define XCD_BAR_WORDS 3456
#define XB_SPIN_CAP (1u << 22)
DI unsigned xb_ld(unsigned* p) { return __hip_atomic_load(p, __ATOMIC_RELAXED, __HIP_MEMORY_SCOPE_AGENT); }
DI unsigned xb_add(unsigned* p, unsigned v) { return __hip_atomic_fetch_add(p, v, __ATOMIC_RELAXED, __HIP_MEMORY_SCOPE_AGENT); }
DI unsigned xb_xcc_id() { return (unsigned)__builtin_amdgcn_s_getreg((3 << 11) | 20) & 0xFu; }
#define XB_SPIN(cond, bar) do { unsigned _sp = 0; while (cond) { __builtin_amdgcn_s_sleep(1); \
    if ((++_sp & 255u) == 0u) { if (xb_ld(&(bar)[XB_TMO])) break; if (_sp > XB_SPIN_CAP) { atomicAdd(&(bar)[XB_TMO], 1u); break; } } } } while (0)
struct XcdBarrier { unsigned* bar; unsigned x; volatile LAS unsigned* st; };
DI XcdBarrier xcd_barrier_post(unsigned* bar, volatile LAS unsigned* st) {
  XcdBarrier b; b.bar = bar; b.x = xb_xcc_id(); b.st = st;
  if (threadIdx.x == 0) (void)xb_add(&bar[XB_XCNT(b.x)], 1u);
  return b;
}
DI void xcd_barrier_complete(unsigned* bar, unsigned x, unsigned& nloc, unsigned& nx) {
  const unsigned G = gridDim.x * gridDim.y * gridDim.z;
  unsigned sum, cnt, mine, sp = 0u;
  for (;;) {
    sum = 0u; cnt = 0u; mine = 0u;
#pragma unroll
    for (unsigned j = 0; j < 16; ++j) { const unsigned c = xb_ld(&bar[XB_XCNT(j)]); sum += c; cnt += (c > 0u) ? 1u : 0u; mine = (j == x) ? c : mine; }
    if (sum == G) break;
    __builtin_amdgcn_s_sleep(1);
    if ((++sp & 255u) == 0u) { if (xb_ld(&bar[XB_TMO])) break; if (sp > XB_SPIN_CAP) { atomicAdd(&bar[XB_TMO], 1u); break; } }
  }
  nloc = mine > 0u ? mine : 1u; nx = cnt > 0u ? cnt : 1u;
}
DI void xcd_barrier(const XcdBarrier& b) {
  asm volatile("s_waitcnt vmcnt(0)" ::: "memory");
  __syncthreads();
  if (threadIdx.x == 0) {
    unsigned* bar = b.bar;
    __builtin_amdgcn_s_waitcnt(0);
    unsigned nloc = b.st[0], nx = b.st[1];
    if (nloc == 0u) { xcd_barrier_complete(bar, b.x, nloc, nx); b.st[0] = nloc; b.st[1] = nx; }
    const unsigned old = xb_add(&bar[XB_XSUB(b.x)], 1u);
    const unsigned gen = old / nloc;
    if (old + 1u == (gen + 1u) * nloc) {
      __builtin_amdgcn_fence(__ATOMIC_RELEASE, "agent");
      asm volatile("s_waitcnt vmcnt(0)" ::: "memory");
      const unsigned og = xb_add(&bar[XB_TOP], 1u);
      const unsigned tg = og / nx;
      if (og + 1u == (tg + 1u) * nx) xb_add(&bar[XB_TOPGEN], 1u);
      else XB_SPIN(xb_ld(&bar[XB_TOPGEN]) == tg, bar);
      __builtin_amdgcn_fence(__ATOMIC_ACQUIRE, "agent");
      xb_add(&bar[XB_XGEN(b.x)], 1u);
      asm volatile("s_waitcnt vmcnt(0)" ::: "memory");
    } else {
      XB_SPIN(xb_ld(&bar[XB_XGEN(b.x)]) == gen, bar);
      __builtin_amdgcn_fence(__ATOMIC_ACQUIRE, "agent");
      asm volatile("s_waitcnt vmcnt(0)" ::: "memory");
    }
  }
  __syncthreads();
}

__global__ void __launch_bounds__(512, 2) fwd_megakernel(Params p) {
  __shared__ __attribute__((aligned(16))) unsigned char smem[SMEM_BYTES];
  __shared__ uint4 xb_words;
  cg::grid_group grid = cg::this_grid();
  if (threadIdx.x == 0) xb_words = make_uint4(0u, 0u, 0u, 0u);
  __syncthreads();
  XcdBarrier xb = xcd_barrier_post((unsigned*)(p.ws + OFF_BAR), (volatile LAS unsigned*)&xb_words);
  for (int ph = p.ph_lo; ph < p.ph_hi; ++ph) {
    if (ph > p.ph_lo) {
      if (p.ph_hi > 4096) grid.sync();
      xcd_barrier(xb);
    }
    if (ph == 0) { pre_phase(p, (float*)smem); continue; }
    if (ph == NPH - 1) { norm_phase(p, 0, 2); continue; }
    const int l = (ph - 1) / SEQ_N, sub = (int)((SEQ_PACK >> (4 * ((ph - 1) % SEQ_N))) & 15ull);
    GemmArgs g;
    g.l = l; g.res_chunk = 0;
    switch (sub) {
      case 0: norm_phase(p, l, 0); break;
#ifndef DIS1
      case 1:
        g.A = (const u16*)(p.ws + OFF_HM); g.lda = DM; g.Bt = Wt_in(p.ws, l); g.ldb = DM; g.K = DM;
        gemm_phase<EPI_G1, 256>(p, g, DIN / 256, smem);
        break;
#endif
#ifndef DIS2
      case 2: attn_phase(p, l, ph, smem); break;
#endif
#ifndef DIS3
      case 3:
        g.A = (const u16*)(p.ws + OFF_ATT); g.lda = 1536; g.Bt = Wt_br(p.ws, l); g.ldb = 1536; g.K = 1536;
        gemm_phase<EPI_G2, 128>(p, g, DM / 128, smem);
        break;
#endif
      case 4:
        g.A = (const u16*)(p.ws + OFF_HM); g.lda = DM; g.Bt = Wt_out(p.ws, l); g.ldb = DM; g.K = DM; g.res_chunk = 2;
        gemm_phase<EPI_RES, 128>(p, g, DM / 128, smem);
        break;
      case 5: norm_phase(p, l, 1); break;
      case 6:
        g.A = (const u16*)(p.ws + OFF_HM); g.lda = DM; g.Bt = Wt_f1(p.ws, l); g.ldb = DM; g.K = DM;
        gemm_phase<EPI_SWIGLU, 256>(p, g, 2 * DFF / 256, smem);
        break;
      default:
        g.A = (const u16*)(p.ws + OFF_GH); g.lda = DFF; g.Bt = Wt_f2(p.ws, l); g.ldb = DFF; g.K = DFF; g.res_chunk = 5;
        gemm_phase<EPI_RES, 128>(p, g, DM / 128, smem);
        break;
    }
  }
}

extern "C" void kernel_launch(void* const* d_in, const int* in_sizes, int n_in, void* d_out, int out_size, void* d_ws, size_t ws_size,
                              hipStream_t stream) {
  static int grid_blocks = 0;
  if (!grid_blocks) {
    int dev = 0, cus = 0, per_cu = 0;
    hipGetDevice(&dev);
    hipDeviceGetAttribute(&cus, hipDeviceAttributeMultiprocessorCount, dev);
    hipOccupancyMaxActiveBlocksPerMultiprocessor(&per_cu, fwd_megakernel, 512, 0);
    if (per_cu < 1) per_cu = 1;
    if (per_cu > 1) per_cu = 1;
    grid_blocks = cus * per_cu;
    if (ws_size < WS_END) fprintf(stderr, "kernel_launch: workspace too small: %zu < %zu\n", ws_size, (size_t)WS_END);
  }
  Params p{};
  for (int i = 0; i < 30; ++i) p.in[i] = (const float*)d_in[i];
  p.out = (float*)d_out;
  p.ws = (unsigned char*)d_ws;
  for (int l = 0; l < 4; ++l) p.lam_init[l] = (float)(0.8 - 0.6 * exp(-0.3 * l));
  hipMemsetAsync((unsigned char*)d_ws + OFF_BAR, 0, 16384, stream);
#if ONE_LAUNCH
  p.ph_lo = 0; p.ph_hi = NPH;
  void* args[] = {&p};
  hipError_t e = hipLaunchCooperativeKernel((void*)fwd_megakernel, dim3(grid_blocks), dim3(512), args, 0, stream);
  if (e != hipSuccess) fprintf(stderr, "cooperative launch failed: %s (grid %d)\n", hipGetErrorString(e), grid_blocks);
#else
  for (int ph = 0; ph < NPH; ++ph) {
    p.ph_lo = ph; p.ph_hi = ph + 1;
    hipLaunchKernelGGL(fwd_megakernel, dim3(grid_blocks), dim3(512), 0, stream, p);
  }
#endif
}
```

```cpp
#include <hip/hip_runtime.h>
#include <hip/hip_cooperative_groups.h>
#include <cstdio>
#include <cstdint>
#include <cmath>
namespace cg = cooperative_groups;

#ifndef ONE_LAUNCH
#define ONE_LAUNCH 1
#endif

typedef unsigned short u16;
typedef __attribute__((ext_vector_type(8))) short bf16x8;
typedef __attribute__((ext_vector_type(4))) short s16x4;
typedef __attribute__((ext_vector_type(16))) float f32x16;
typedef __attribute__((ext_vector_type(4))) float f32x4;
typedef __attribute__((ext_vector_type(2))) unsigned u32x2;
typedef __attribute__((ext_vector_type(4))) unsigned u32x4;
typedef __attribute__((ext_vector_type(2))) __bf16 bf2_t;
typedef __attribute__((ext_vector_type(2))) float f2_t;
#define DI __device__ __forceinline__
#define LAS __attribute__((address_space(3)))
#define MFMA32(a, b, c) __builtin_amdgcn_mfma_f32_32x32x16_bf16((a), (b), (c), 0, 0, 0)

constexpr int DM = 1024, NTOK = 8192, NCTX = 4096;
constexpr int DIN = 6144, DFF = 2816, DEPTH = 4;
#ifndef SEQ_PACK
#define SEQ_PACK 0x76543210ull
#define SEQ_N 8
#endif
constexpr int NPH = 2 + SEQ_N * DEPTH;

constexpr size_t SZ_WIN = (size_t)DIN * DM * 2, SZ_WBR = (size_t)DM * 1536 * 2, SZ_WOUT = (size_t)DM * DM * 2;
constexpr size_t SZ_WF1 = (size_t)2 * DFF * DM * 2, SZ_WF2 = (size_t)DM * DFF * 2;
constexpr size_t SZ_WL = SZ_WIN + SZ_WBR + SZ_WOUT + SZ_WF1 + SZ_WF2;
constexpr size_t OFF_W = 0;
constexpr size_t OFF_MOD = OFF_W + SZ_WL * DEPTH;
constexpr size_t OFF_ROPE = OFF_MOD + (size_t)4 * 5 * 6144 * 4;
constexpr size_t OFF_X = OFF_ROPE + (size_t)2 * 1024 * 32 * 4;
constexpr size_t OFF_HM = OFF_X + (size_t)NTOK * DM * 4;
constexpr size_t OFF_Q = OFF_HM + (size_t)NTOK * DM * 2;
constexpr size_t OFF_GH = OFF_Q + (size_t)NTOK * 1536 * 2;
constexpr size_t OFF_ATT = OFF_GH + (size_t)NTOK * 3072 * 2;
constexpr size_t EL_KA = (size_t)4 * 4 * 1536 * 128, EL_KB = (size_t)4 * 2 * 1536 * 64;
constexpr size_t SZ_KVL = (2 * EL_KA + 4 * EL_KB) * 2;
constexpr size_t OFF_KVL = OFF_ATT + (size_t)NTOK * 1536 * 2;
constexpr size_t EL_KAC = (size_t)16 * 4 * 256 * 128, EL_KBC = (size_t)16 * 2 * 256 * 64;
constexpr size_t OFF_KVC = OFF_KVL + SZ_KVL * DEPTH;
constexpr size_t OFF_BAR = OFF_KVC + (2 * EL_KAC + 4 * EL_KBC) * 2;
constexpr size_t WS_END = OFF_BAR + 16384;

constexpr size_t O_YP = 0, O_YS = 4194304, O_AK = 8388608, O_AV = 16777216, O_BK = 25165824, O_BV = 27262976, O_CK = 29360128, O_CV = 31457280;

struct Params {
  const float* in[30];
  float* out;
  unsigned char* ws;
  float lam_init[4];
  int ph_lo, ph_hi;
};

DI unsigned pack2(float a, float b) { f2_t v = {a, b}; bf2_t r = __builtin_convertvector(v, bf2_t); return __builtin_bit_cast(unsigned, r); }
DI int tid_() { int t = threadIdx.x; asm volatile("" : "+v"(t)); return t; }
DI float4 ld_nt4(const float* p) { f32x4 t = __builtin_nontemporal_load((const f32x4*)p); return make_float4(t[0], t[1], t[2], t[3]); }
DI void st_nt4(float* p, float4 v) { f32x4 t = {v.x, v.y, v.z, v.w}; __builtin_nontemporal_store(t, (f32x4*)p); }
DI void st_nt2(float* p, float2 v) { f2_t t = {v.x, v.y}; __builtin_nontemporal_store(t, (f2_t*)p); }
DI float bf2f(u16 x) { return __uint_as_float(((unsigned)x) << 16); }
DI int crow(int reg, int h) { return (reg & 3) + 8 * (reg >> 2) + 4 * h; }
DI float wave_sum(float v) {
#pragma unroll
  for (int o = 32; o > 0; o >>= 1) v += __shfl_xor(v, o);
  return v;
}
DI float sigmoidf_(float x) { return __builtin_amdgcn_rcpf(1.f + __expf(-x)); }
DI float siluf_(float x) { return x * __builtin_amdgcn_rcpf(1.f + __expf(-x)); }
DI u16 bf16_1(float x) { return (u16)(pack2(x, 0.f) & 0xffffu); }

DI u16* Wt_in(unsigned char* ws, int l) { return (u16*)(ws + OFF_W + SZ_WL * l); }
DI u16* Wt_br(unsigned char* ws, int l) { return (u16*)(ws + OFF_W + SZ_WL * l + SZ_WIN); }
DI u16* Wt_out(unsigned char* ws, int l) { return (u16*)(ws + OFF_W + SZ_WL * l + SZ_WIN + SZ_WBR); }
DI u16* Wt_f1(unsigned char* ws, int l) { return (u16*)(ws + OFF_W + SZ_WL * l + SZ_WIN + SZ_WBR + SZ_WOUT); }
DI u16* Wt_f2(unsigned char* ws, int l) { return (u16*)(ws + OFF_W + SZ_WL * l + SZ_WIN + SZ_WBR + SZ_WOUT + SZ_WF1); }
DI u16* KVL(unsigned char* ws, int l, int which) {
  size_t off = 0;
  if (which >= 1) off += EL_KA;
  if (which >= 2) off += EL_KB;
  if (which >= 3) off += EL_KB;
  if (which >= 4) off += EL_KA;
  if (which >= 5) off += EL_KB;
  return (u16*)(ws + OFF_KVL + SZ_KVL * l) + off;
}
DI u16* KVC(unsigned char* ws, int which) {
  size_t off = 0;
  if (which >= 1) off += EL_KAC;
  if (which >= 2) off += EL_KBC;
  if (which >= 3) off += EL_KBC;
  if (which >= 4) off += EL_KAC;
  if (which >= 5) off += EL_KBC;
  return (u16*)(ws + OFF_KVC) + off;
}
DI const float* x_src(const Params& p, int l, int row) {
  if (l == 0) return row < NCTX ? p.in[0] + (size_t)row * DM : p.in[1] + (size_t)(row - NCTX) * DM;
  return (const float*)(p.ws + OFF_X) + (size_t)row * DM;
}
DI const float* mod_vec(const Params& p, int l, int row, int chunk) {
  int v = row < NCTX ? 4 : ((row - NCTX) >> 10);
  return (const float*)(p.ws + OFF_MOD) + ((size_t)(l * 5 + v) * 6144 + chunk * 1024);
}

template <int NT64>
DI void transpose_tile(const float* __restrict__ src, int ldsrc, int k0, int n0, u16* __restrict__ dst, int ldd, int mode, float* tile) {
  const int t = tid_() & 255;
  __syncthreads();
  {
    const int kk = t >> 4, c4 = (t & 15) * 4;
    float4 v[NT64 * 4];
#pragma unroll
    for (int q = 0; q < NT64; ++q)
#pragma unroll
      for (int i = 0; i < 4; ++i) { f32x4 t_ = __builtin_nontemporal_load((const f32x4*)(src + (size_t)(k0 + kk + 16 * i) * ldsrc + n0 + 64 * q + c4)); v[q * 4 + i] = make_float4(t_[0], t_[1], t_[2], t_[3]); }
#pragma unroll
    for (int q = 0; q < NT64; ++q)
#pragma unroll
      for (int i = 0; i < 4; ++i) {
        float* tp = tile + q * 4160 + (kk + 16 * i) * 65 + c4;
        tp[0] = v[q * 4 + i].x; tp[1] = v[q * 4 + i].y; tp[2] = v[q * 4 + i].z; tp[3] = v[q * 4 + i].w;
      }
  }
  __syncthreads();
  const int n = t >> 2, kc = (t & 3) * 16;
#pragma unroll
  for (int q = 0; q < NT64; ++q) {
    const float* tq = tile + q * 4160;
    const int n0q = n0 + 64 * q;
    unsigned w[8];
#pragma unroll
    for (int j = 0; j < 8; ++j) w[j] = pack2(tq[(kc + 2 * j) * 65 + n], tq[(kc + 2 * j + 1) * 65 + n]);
    int drow;
    if (mode != 1) drow = n0q + n;
    else {
      int isb = n0q >= DFF;
      int c0 = n0q - (isb ? DFF : 0);
      drow = (c0 >> 7) * 256 + ((c0 >> 6) & 1) * 128 + isb * 64 + n;
    }
    uint4* dp = (uint4*)(dst + (size_t)drow * ldd + k0 + kc);
    if (mode == 2) {
      dp[0] = make_uint4(w[0], w[1], w[4], w[5]);
      dp[1] = make_uint4(w[2], w[3], w[6], w[7]);
    } else {
      dp[0] = make_uint4(w[0], w[1], w[2], w[3]);
      dp[1] = make_uint4(w[4], w[5], w[6], w[7]);
    }
  }
}

DI void mod_task(const Params& p, int l, int cgp, float* sm) {
  float* sv = sm;
  float* red = sm + 5 * 1024;
  const int t = tid_() & 255;
  __syncthreads();
  for (int e = t; e < 5 * 1024; e += 256) {
    int v = e >> 10, k = e & 1023;
    float x = v < 4 ? p.in[8][v * 1024 + k] : p.in[9][k];
    sv[e] = siluf_(x);
  }
  __syncthreads();
  const int c4 = t & 31, ks = t >> 5;
  const float* w = p.in[10] + (size_t)l * 1024 * 6144 + cgp * 128 + c4 * 4;
  float acc[5][4];
#pragma unroll
  for (int v = 0; v < 5; ++v) { acc[v][0] = acc[v][1] = acc[v][2] = acc[v][3] = 0.f; }
#pragma unroll 8
  for (int k = ks * 128; k < ks * 128 + 128; ++k) {
    f32x4 wt_ = __builtin_nontemporal_load((const f32x4*)(w + (size_t)k * 6144));
    float4 wv = make_float4(wt_[0], wt_[1], wt_[2], wt_[3]);
#pragma unroll
    for (int v = 0; v < 5; ++v) {
      float s = sv[v * 1024 + k];
      acc[v][0] += s * wv.x; acc[v][1] += s * wv.y; acc[v][2] += s * wv.z; acc[v][3] += s * wv.w;
    }
  }
#pragma unroll
  for (int v = 0; v < 5; ++v)
#pragma unroll
    for (int j = 0; j < 4; ++j) red[(ks * 32 + c4) * 20 + v * 4 + j] = acc[v][j];
  __syncthreads();
  for (int o = t; o < 640; o += 256) {
    int cc = o / 20, r = o % 20, v = r >> 2, j = r & 3;
    float s = 0.f;
#pragma unroll
    for (int q = 0; q < 8; ++q) s += red[(q * 32 + cc) * 20 + r];
    int col = cgp * 128 + cc * 4 + j;
    s += p.in[11][l * 6144 + col];
    ((float*)(p.ws + OFF_MOD))[(size_t)(l * 5 + v) * 6144 + col] = s;
  }
}

constexpr int T_MOD = 192, T_ROPE = 32, T_WTL = 1072, T_WT = T_WTL * 4, T_CVA = 256, T_CVB = 128, T_CKA = 2048, T_CKB = 512;
constexpr int T_PRE = T_MOD + T_ROPE + T_WT + T_CVA + 2 * T_CVB + T_CKA + 2 * T_CKB;

DI void pre_phase(const Params& p, float* sm0) {
  const int t = tid_() & 255, half = tid_() >> 8;
  float* sm = sm0 + half * 16640;
  for (int pair = blockIdx.x; pair < T_PRE / 2; pair += gridDim.x) {
    int i = pair * 2 + half;
    if (i < T_MOD) { mod_task(p, i / 48, i % 48, sm); continue; }
    i -= T_MOD;
    if (i < T_ROPE) {
      float* cosT = (float*)(p.ws + OFF_ROPE);
      float* sinT = cosT + 1024 * 32;
#pragma unroll
      for (int q = 0; q < 4; ++q) {
        int e = i * 1024 + q * 256 + t;
        int pos = e >> 5, j = e & 31;
        int rr = pos >> 6, cc = pos & 63;
        float inv = exp2f(-(float)(j & 15) * (13.287712379549449f / 16.f));
        float ang = (float)(j < 16 ? rr : cc) * inv;
        cosT[e] = __cosf(ang);
        sinT[e] = __sinf(ang);
      }
      continue;
    }
    i -= T_ROPE;
    if (i < T_WT) {
      int l = i / T_WTL, j = i % T_WTL;
      if (j < 384) { transpose_tile<4>(p.in[14] + (size_t)l * 1024 * 6144, 6144, (j / 24) * 64, (j % 24) * 256, Wt_in(p.ws, l), 1024, 0, sm); continue; }
      j -= 384;
      if (j < 96) {
        int seg = j / 32, jj = j % 32;
        transpose_tile<4>((seg == 0 ? p.in[23] : (seg == 1 ? p.in[24] : p.in[25])) + (size_t)l * 512 * 1024, 1024, (jj / 4) * 64, (jj % 4) * 256, Wt_br(p.ws, l) + seg * 512, 1536, 0, sm);
        continue;
      }
      j -= 96;
      if (j < 64) { transpose_tile<4>(p.in[26] + (size_t)l * 1024 * 1024, 1024, (j / 4) * 64, (j % 4) * 256, Wt_out(p.ws, l), 1024, 0, sm); continue; }
      j -= 64;
      if (j < 352) { transpose_tile<4>(p.in[27] + (size_t)l * 1024 * 5632, 5632, (j / 22) * 64, (j % 22) * 256, Wt_f1(p.ws, l), 1024, 1, sm); continue; }
      j -= 352;
      transpose_tile<4>(p.in[28] + (size_t)l * 2816 * 1024, 1024, (j / 4) * 64, (j % 4) * 256, Wt_f2(p.ws, l), 2816, 0, sm);
      continue;
    }
    i -= T_WT;
    if (i < T_CVA) {
      int bl = i / 16, jj = i % 16, b = bl >> 2, l = bl & 3;
      transpose_tile<4>(p.in[3] + (size_t)bl * 512 * 512, 512, (jj / 2) * 64, (jj % 2) * 256, KVL(p.ws, l, 3) + (size_t)b * 512 * 1536, 1536, 2, sm);
      continue;
    }
    i -= T_CVA;
    if (i < 2 * T_CVB) {
      int wh = i / T_CVB, ii = i % T_CVB;
      int bl = ii / 8, jj = ii % 8, b = bl >> 2, l = bl & 3;
      transpose_tile<2>((wh ? p.in[7] : p.in[5]) + (size_t)bl * 512 * 128, 128, jj * 64, 0, KVL(p.ws, l, wh ? 5 : 4) + (size_t)b * 128 * 1536, 1536, 2, sm);
      continue;
    }
    i -= 2 * T_CVB;
    if (i < T_CKA) {
      size_t e = ((size_t)i * 256 + t) * 8;
      int d = e & 127, h = (e >> 7) & 3, pp = (e >> 9) & 511, l = (e >> 18) & 3, b = (int)(e >> 20);
      const float* sp = p.in[2] + e;
      float4 a = ld_nt4(sp), c = ld_nt4(sp + 4);
      u16* dp = KVL(p.ws, l, 0) + (((size_t)(b * 4 + h) * 1536 + pp) * 128 + d);
      *(uint4*)dp = make_uint4(pack2(a.x, a.y), pack2(a.z, a.w), pack2(c.x, c.y), pack2(c.z, c.w));
      continue;
    }
    i -= T_CKA;
    {
      int wh = i / T_CKB, ii = i % T_CKB;
      size_t e = ((size_t)ii * 256 + t) * 8;
      int d = e & 63, h = (e >> 6) & 1, pp = (e >> 7) & 511, l = (e >> 16) & 3, b = (int)(e >> 18);
      const float* sp = (wh ? p.in[6] : p.in[4]) + e;
      float4 a = ld_nt4(sp), c = ld_nt4(sp + 4);
      u16* dp = KVL(p.ws, l, wh ? 2 : 1) + (((size_t)(b * 2 + h) * 1536 + pp) * 64 + d);
      *(uint4*)dp = make_uint4(pack2(a.x, a.y), pack2(a.z, a.w), pack2(c.x, c.y), pack2(c.z, c.w));
    }
  }
}

DI void norm_phase(const Params& p, int l, int which) {
  const int lane = tid_() & 63;
  const int gw = blockIdx.x * 8 + (tid_() >> 6), nw = gridDim.x * 8;
  for (int row = gw; row < NTOK; row += nw) {
    float v[2][8];
    const bool from_input = (which == 0 && l == 0);
    if (from_input) {
      const float* x = row < NCTX ? p.in[0] + (size_t)row * DM : p.in[1] + (size_t)(row - NCTX) * DM;
#pragma unroll
      for (int c = 0; c < 2; ++c) {
        float4 a = *(const float4*)(x + 8 * lane + 512 * c), b = *(const float4*)(x + 8 * lane + 512 * c + 4);
        v[c][0] = a.x; v[c][1] = a.y; v[c][2] = a.z; v[c][3] = a.w; v[c][4] = b.x; v[c][5] = b.y; v[c][6] = b.z; v[c][7] = b.w;
      }
    } else {
      const u16* x = (const u16*)(p.ws + OFF_X) + (size_t)row * DM;
#pragma unroll
      for (int c = 0; c < 2; ++c) {
        uint4 a = *(const uint4*)(x + 8 * lane + 512 * c);
        v[c][0] = __uint_as_float(a.x << 16); v[c][1] = __uint_as_float(a.x & 0xffff0000u);
        v[c][2] = __uint_as_float(a.y << 16); v[c][3] = __uint_as_float(a.y & 0xffff0000u);
        v[c][4] = __uint_as_float(a.z << 16); v[c][5] = __uint_as_float(a.z & 0xffff0000u);
        v[c][6] = __uint_as_float(a.w << 16); v[c][7] = __uint_as_float(a.w & 0xffff0000u);
      }
    }
    float ss = 0.f;
#pragma unroll
    for (int c = 0; c < 2; ++c)
#pragma unroll
      for (int i = 0; i < 8; ++i) ss += v[c][i] * v[c][i];
    ss = wave_sum(ss);
    const float rs = rsqrtf(ss * (1.f / 1024.f) + 1e-6f);
    if (which == 2) {
      float* o = p.out + (row < NCTX ? O_YP + (size_t)row * DM : O_YS + (size_t)(row - NCTX) * DM);
#pragma unroll
      for (int c = 0; c < 2; ++c) {
        const int col = 8 * lane + 512 * c;
        float4 g0 = *(const float4*)(p.in[29] + col), g1 = *(const float4*)(p.in[29] + col + 4);
        st_nt4(o + col, make_float4(v[c][0] * rs * g0.x, v[c][1] * rs * g0.y, v[c][2] * rs * g0.z, v[c][3] * rs * g0.w));
        st_nt4(o + col + 4, make_float4(v[c][4] * rs * g1.x, v[c][5] * rs * g1.y, v[c][6] * rs * g1.z, v[c][7] * rs * g1.w));
      }
    } else {
      const float* gp = (which == 0 ? p.in[12] : p.in[13]) + l * 1024;
      const float* sh = mod_vec(p, l, row, which == 0 ? 0 : 3);
      const float* sc = mod_vec(p, l, row, which == 0 ? 1 : 4);
      u16* o = (u16*)(p.ws + OFF_HM) + (size_t)row * DM;
#pragma unroll
      for (int c = 0; c < 2; ++c) {
        const int col = 8 * lane + 512 * c;
        float gg[8], s1[8], s0[8];
        *(float4*)&gg[0] = *(const float4*)(gp + col); *(float4*)&gg[4] = *(const float4*)(gp + col + 4);
        *(float4*)&s1[0] = *(const float4*)(sc + col); *(float4*)&s1[4] = *(const float4*)(sc + col + 4);
        *(float4*)&s0[0] = *(const float4*)(sh + col); *(float4*)&s0[4] = *(const float4*)(sh + col + 4);
        float r[8];
#pragma unroll
        for (int i = 0; i < 8; ++i) r[i] = v[c][i] * rs * gg[i] * (1.f + s1[i]) + s0[i];
        *(uint4*)(o + col) = make_uint4(pack2(r[0], r[1]), pack2(r[2], r[3]), pack2(r[4], r[5]), pack2(r[6], r[7]));
      }
    }
  }
}

constexpr int SMEM_BYTES = 8 * 64 * 68 * 4;
enum { EPI_G1 = 0, EPI_G2 = 1, EPI_RES = 2, EPI_SWIGLU = 3 };

struct GemmArgs {
  const u16* A; int lda;
  const u16* Bt; int ldb;
  int K;
  int l;
  int res_chunk;
};

DI void g1_epilogue_wave(const Params& p, int l, int mrow0, int ncol0, const float* ct, int lane);

#define RAW_BARRIER() do { asm volatile("s_waitcnt lgkmcnt(0)" ::: "memory"); __builtin_amdgcn_s_barrier(); } while (0)

template <int EPI, int BN>
DI void gemm_tile(const Params& p, const GemmArgs& g, int m0, int n0, unsigned char* smem) {
  constexpr int NT = BN / 32;
  constexpr int NH = NT / 2;
  constexpr int NI = (256 + BN) / 128;
  constexpr int STAGE = (256 + BN) * 64;
  const int t = tid_(), lane = t & 63, w = t >> 6, wm = w >> 1, wn = w & 1, lc = lane & 15, lq = lane >> 4;
  f32x4 acc[4][NT];
  f32x4 tot[4][NT];
#pragma unroll
  for (int a = 0; a < 4; ++a)
#pragma unroll
    for (int b = 0; b < NT; ++b)
#pragma unroll
      for (int i = 0; i < 4; ++i) { acc[a][b][i] = 0.f; if (EPI == EPI_G2) tot[a][b][i] = 0.f; }

  const int nk = g.K >> 5;
  const int dl_rr = lane >> 2, dl_p = lane & 3;
  const u16* gsrc[NI];
#pragma unroll
  for (int i = 0; i < NI; ++i) {
    const int blk = i * 8 + w, kc = dl_p ^ (dl_rr >> 2);
    if (blk < 16) gsrc[i] = g.A + (size_t)(m0 + blk * 16 + dl_rr) * g.lda + kc * 8;
    else gsrc[i] = g.Bt + (size_t)(n0 + (blk - 16) * 16 + dl_rr) * g.ldb + kc * 8;
  }
  const int dma_off = w * 1024 + lane * 16;
  const unsigned smem_lds = (unsigned)(size_t)smem;
#define DMA_SLICE(J)                                                                                                   \
  {                                                                                                                    \
    unsigned char* bufp_ = smem + ((J) & 3) * STAGE + dma_off;                                                         \
    const size_t koff_ = (size_t)(J) * 32;                                                                             \
    _Pragma("unroll") for (int i_ = 0; i_ < NI; ++i_)                                                                  \
        __builtin_amdgcn_global_load_lds((const unsigned*)(gsrc[i_] + koff_), (LAS unsigned*)(bufp_ + i_ * 8192), 16, 0, 0); \
  }
  __syncthreads();
  DMA_SLICE(0) DMA_SLICE(1) DMA_SLICE(2)
  const unsigned frag_off = lc * 64 + (((lq ^ (lc >> 2)) & 3) << 4);
  const unsigned a_base = smem_lds + (wm * 4) * 1024 + frag_off;
  const unsigned b_base = smem_lds + 16384 + (wn * NT) * 1024 + frag_off;
  bf16x8 a0, a1, a2, a3, c0, c1, c2, c3, bl0, bl1, bl2, bl3, bh0, bh1, bh2, bh3;
#define RD4(ADDR, F0, F1, F2, F3)                                                                                      \
  asm volatile("ds_read_b128 %0, %4\n\tds_read_b128 %1, %4 offset:1024\n\tds_read_b128 %2, %4 offset:2048\n\t"         \
               "ds_read_b128 %3, %4 offset:3072"                                                                       \
               : "=&v"(F0), "=&v"(F1), "=&v"(F2), "=&v"(F3) : "v"(ADDR) : "memory");
#define RD2(ADDR, F0, F1)                                                                                              \
  asm volatile("ds_read_b128 %0, %2\n\tds_read_b128 %1, %2 offset:1024" : "=&v"(F0), "=&v"(F1) : "v"(ADDR) : "memory");
#define RD_B(ADDR, F0, F1, F2, F3) if (NH == 4) { RD4(ADDR, F0, F1, F2, F3) } else { RD2(ADDR, F0, F1) }
#define WT4(F0, F1, F2, F3) asm volatile("s_waitcnt lgkmcnt(0)" : "+v"(F0), "+v"(F1), "+v"(F2), "+v"(F3) :: "memory");
#define WT8(F0, F1, F2, F3, F4, F5, F6, F7)                                                                            \
  asm volatile("s_waitcnt lgkmcnt(0)" : "+v"(F0), "+v"(F1), "+v"(F2), "+v"(F3), "+v"(F4), "+v"(F5), "+v"(F6), "+v"(F7) :: "memory");
#define MF16(A, B, C) __builtin_amdgcn_mfma_f32_16x16x32_bf16((A), (B), (C), 0, 0, 0)
#define MM_HALF(A0, A1, A2, A3, B0, B1, B2, B3, NB)                                                                    \
  acc[0][(NB)] = MF16(A0, B0, acc[0][(NB)]); acc[1][(NB)] = MF16(A1, B0, acc[1][(NB)]);                                \
  acc[2][(NB)] = MF16(A2, B0, acc[2][(NB)]); acc[3][(NB)] = MF16(A3, B0, acc[3][(NB)]);                                \
  acc[0][(NB) + 1] = MF16(A0, B1, acc[0][(NB) + 1]); acc[1][(NB) + 1] = MF16(A1, B1, acc[1][(NB) + 1]);                \
  acc[2][(NB) + 1] = MF16(A2, B1, acc[2][(NB) + 1]); acc[3][(NB) + 1] = MF16(A3, B1, acc[3][(NB) + 1]);                \
  if (NH == 4) {                                                                                                       \
    acc[0][((NB) + 2) % NT] = MF16(A0, B2, acc[0][((NB) + 2) % NT]); acc[1][((NB) + 2) % NT] = MF16(A1, B2, acc[1][((NB) + 2) % NT]); \
    acc[2][((NB) + 2) % NT] = MF16(A2, B2, acc[2][((NB) + 2) % NT]); acc[3][((NB) + 2) % NT] = MF16(A3, B2, acc[3][((NB) + 2) % NT]); \
    acc[0][((NB) + 3) % NT] = MF16(A0, B3, acc[0][((NB) + 3) % NT]); acc[1][((NB) + 3) % NT] = MF16(A1, B3, acc[1][((NB) + 3) % NT]); \
    acc[2][((NB) + 3) % NT] = MF16(A2, B3, acc[2][((NB) + 3) % NT]); acc[3][((NB) + 3) % NT] = MF16(A3, B3, acc[3][((NB) + 3) % NT]); \
  }
#define SLICE_STEP(KT, A0, A1, A2, A3, N0, N1, N2, N3)                                                                 \
  {                                                                                                                    \
    if ((KT) + 2 < nk) { if (NI == 4) asm volatile("s_waitcnt vmcnt(4)" ::: "memory"); else asm volatile("s_waitcnt vmcnt(3)" ::: "memory"); } \
    else asm volatile("s_waitcnt vmcnt(0)" ::: "memory");                                                              \
    WT8(A0, A1, A2, A3, bl0, bl1, bl2, bl3)                                                                            \
    __builtin_amdgcn_s_barrier();                      \
    if ((KT) + 3 < nk) DMA_SLICE((KT) + 3)                                                                             \
    const unsigned so_ = ((KT) & 3) * STAGE;                                                                           \
    RD_B(b_base + so_ + NH * 1024, bh0, bh1, bh2, bh3)                                                                 \
    __builtin_amdgcn_sched_barrier(0);                                           \
    MM_HALF(A0, A1, A2, A3, bl0, bl1, bl2, bl3, 0)                                                                     \
    __builtin_amdgcn_sched_barrier(0);                                                                                 \
    WT4(bh0, bh1, bh2, bh3)                                                                                            \
    __builtin_amdgcn_s_barrier();     \
                                      \
      \
                                                                        \
    MM_PART(A0, A1, A2, A3, bh0, bh1, NH)                                                                              \
    __builtin_amdgcn_sched_barrier(0);                                                                                 \
    if ((KT) + 1 < nk) {                                                                                               \
      const unsigned sn_ = (((KT) + 1) & 3) * STAGE;                                                                   \
      RD4(a_base + sn_, N0, N1, N2, N3)                                                                                \
      RD_B(b_base + sn_, bl0, bl1, bl2, bl3)                                                                           \
    }                                                                                                                  \
    __builtin_amdgcn_sched_barrier(0);                                                                                 \
    MM_REST(A0, A1, A2, A3, bh0, bh1, bh2, bh3, NH)                                                                    \
    __builtin_amdgcn_sched_barrier(0);                                                                                 \
  }
#define MM_PART(A0, A1, A2, A3, B0, B1, NB)                                                                            \
  acc[0][(NB)] = MF16(A0, B0, acc[0][(NB)]); acc[1][(NB)] = MF16(A1, B0, acc[1][(NB)]);                                \
  acc[2][(NB)] = MF16(A2, B0, acc[2][(NB)]); acc[3][(NB)] = MF16(A3, B0, acc[3][(NB)]);                                \
  if (NH == 4) {                                                                                                       \
    acc[0][(NB) + 1] = MF16(A0, B1, acc[0][(NB) + 1]); acc[1][(NB) + 1] = MF16(A1, B1, acc[1][(NB) + 1]);              \
    acc[2][(NB) + 1] = MF16(A2, B1, acc[2][(NB) + 1]); acc[3][(NB) + 1] = MF16(A3, B1, acc[3][(NB) + 1]);              \
  }
#define MM_REST(A0, A1, A2, A3, B0, B1, B2, B3, NB)                                                                    \
  if (NH == 4) {                                                                                                       \
    acc[0][((NB) + 2) % NT] = MF16(A0, B2, acc[0][((NB) + 2) % NT]); acc[1][((NB) + 2) % NT] = MF16(A1, B2, acc[1][((NB) + 2) % NT]); \
    acc[2][((NB) + 2) % NT] = MF16(A2, B2, acc[2][((NB) + 2) % NT]); acc[3][((NB) + 2) % NT] = MF16(A3, B2, acc[3][((NB) + 2) % NT]); \
    acc[0][((NB) + 3) % NT] = MF16(A0, B3, acc[0][((NB) + 3) % NT]); acc[1][((NB) + 3) % NT] = MF16(A1, B3, acc[1][((NB) + 3) % NT]); \
    acc[2][((NB) + 3) % NT] = MF16(A2, B3, acc[2][((NB) + 3) % NT]); acc[3][((NB) + 3) % NT] = MF16(A3, B3, acc[3][((NB) + 3) % NT]); \
  } else {                                                                                                             \
    acc[0][(NB) + 1] = MF16(A0, B1, acc[0][(NB) + 1]); acc[1][(NB) + 1] = MF16(A1, B1, acc[1][(NB) + 1]);              \
    acc[2][(NB) + 1] = MF16(A2, B1, acc[2][(NB) + 1]); acc[3][(NB) + 1] = MF16(A3, B1, acc[3][(NB) + 1]);              \
  }
#ifndef PIPE_BN
#define PIPE_BN 256
#endif
#define SIMPLE_STEP(KT)                                                                                                \
  {                                                                                                                    \
    if ((KT) + 2 < nk) { if (NI == 4) asm volatile("s_waitcnt vmcnt(8)" ::: "memory"); else asm volatile("s_waitcnt vmcnt(6)" ::: "memory"); } \
    else if ((KT) + 1 < nk) { if (NI == 4) asm volatile("s_waitcnt vmcnt(4)" ::: "memory"); else asm volatile("s_waitcnt vmcnt(3)" ::: "memory"); } \
    else asm volatile("s_waitcnt vmcnt(0)" ::: "memory");                                                              \
    RAW_BARRIER();                                                                                                     \
    G2_PREFETCH(KT)                                                                                                    \
    if ((KT) + 3 < nk) DMA_SLICE((KT) + 3)                                                                             \
    const unsigned so_ = ((KT) & 3) * STAGE;                                                                           \
    RD4(a_base + so_, a0, a1, a2, a3)                                                                                  \
    RD_B(b_base + so_, bl0, bl1, bl2, bl3)                                                                             \
    RD_B(b_base + so_ + NH * 1024, bh0, bh1, bh2, bh3)                                                                 \
    WT8(a0, a1, a2, a3, bl0, bl1, bl2, bl3)                                                                            \
    WT4(bh0, bh1, bh2, bh3)                                                                                            \
    MM_HALF(a0, a1, a2, a3, bl0, bl1, bl2, bl3, 0)                                                                     \
    MM_HALF(a0, a1, a2, a3, bh0, bh1, bh2, bh3, NH)                                                                    \
  }
  u32x2 gqr[4][NT];
#pragma unroll
  for (int a = 0; a < 4; ++a)
#pragma unroll
    for (int b = 0; b < NT; ++b) gqr[a][b] = (u32x2){0u, 0u};
#define G2_PREFETCH(KT)                                                                                                \
  if (EPI == EPI_G2 && (((KT) & 15) == 15)) {                                                                          \
    const int seg_ = (KT) >> 4;                                                                                        \
    _Pragma("unroll") for (int a = 0; a < 4; ++a) _Pragma("unroll") for (int b = 0; b < NT; ++b) {                     \
      const int r16 = (m0 + wm * 64 + a * 16) >> 4, c16 = (seg_ * 1024 + n0 + wn * (BN / 2) + b * 16) >> 4;           \
      gqr[a][b] = __builtin_nontemporal_load((const u32x2*)((const u16*)(p.ws + OFF_GH) + ((size_t)(r16 * 192 + c16) * 64 + lane) * 4)); \
    }                                                                                                                  \
  }
  constexpr bool PIPE = true;
  c0 = c1 = c2 = c3 = a0 = a1 = a2 = a3 = bl0 = bl1 = bl2 = bl3 = bh0 = bh1 = bh2 = bh3 = (bf16x8)(0);
  if (PIPE) {
    if (NI == 4) asm volatile("s_waitcnt vmcnt(8)" ::: "memory"); else asm volatile("s_waitcnt vmcnt(6)" ::: "memory");
    RAW_BARRIER();
    RD4(a_base, a0, a1, a2, a3)
    RD_B(b_base, bl0, bl1, bl2, bl3)
    if (w >= 4) __builtin_amdgcn_s_barrier();
  }
  for (int kt = 0; kt < nk; kt += 2) {
    if (PIPE) {
      SLICE_STEP(kt, a0, a1, a2, a3, c0, c1, c2, c3)
      SLICE_STEP(kt + 1, c0, c1, c2, c3, a0, a1, a2, a3)
    } else {
      SIMPLE_STEP(kt)
      SIMPLE_STEP(kt + 1)
    }
    if (EPI == EPI_G2) {
      if (((kt + 1) & 15) == 15) {
        const int seg = (kt + 1) >> 4;
        if (PIPE) {
#pragma unroll
          for (int a = 0; a < 4; ++a)
#pragma unroll
            for (int b = 0; b < NT; ++b) {
              const int r16 = (m0 + wm * 64 + a * 16) >> 4, c16 = (seg * 1024 + n0 + wn * (BN / 2) + b * 16) >> 4;
              gqr[a][b] = __builtin_nontemporal_load((const u32x2*)((const u16*)(p.ws + OFF_GH) + ((size_t)(r16 * 192 + c16) * 64 + lane) * 4));
            }
          WT8(a0, a1, a2, a3, bl0, bl1, bl2, bl3)
        }
#pragma unroll
        for (int a = 0; a < 4; ++a)
#pragma unroll
          for (int b = 0; b < NT; ++b) {
            const int r16 = (m0 + wm * 64 + a * 16) >> 4, c16 = (seg * 1024 + n0 + wn * (BN / 2) + b * 16) >> 4;
            const u32x2 gq_ = gqr[a][b];
            const uint2 gq = make_uint2(gq_[0], gq_[1]);
            tot[a][b][0] += __uint_as_float(gq.x << 16) * acc[a][b][0];
            tot[a][b][1] += __uint_as_float(gq.x & 0xffff0000u) * acc[a][b][1];
            tot[a][b][2] += __uint_as_float(gq.y << 16) * acc[a][b][2];
            tot[a][b][3] += __uint_as_float(gq.y & 0xffff0000u) * acc[a][b][3];
            acc[a][b][0] = 0.f; acc[a][b][1] = 0.f; acc[a][b][2] = 0.f; acc[a][b][3] = 0.f;
          }
      }
    }
  }
  if (PIPE && w < 4) __builtin_amdgcn_s_barrier();
  __syncthreads();

  const int rbase = m0 + wm * 64, cbase = n0 + wn * (BN / 2);
  if (EPI == EPI_G1) {
    if (n0 >= 3072) {
#pragma unroll
      for (int a = 0; a < 4; ++a)
#pragma unroll
        for (int b = 0; b < NT; ++b) {
          const int r16 = (rbase + a * 16) >> 4, c16 = (cbase - 3072 + b * 16) >> 4;
          u16* gp = (u16*)(p.ws + OFF_GH) + ((size_t)(r16 * 192 + c16) * 64 + lane) * 4;
          *(uint2*)gp = make_uint2(pack2(sigmoidf_(acc[a][b][0]), sigmoidf_(acc[a][b][1])), pack2(sigmoidf_(acc[a][b][2]), sigmoidf_(acc[a][b][3])));
        }
    } else {
      float* ct = (float*)smem + w * (64 * 68);
#pragma unroll
      for (int hf = 0; hf < NT / 4; ++hf) {
#pragma unroll
        for (int a = 0; a < 4; ++a)
#pragma unroll
          for (int b = 0; b < 4; ++b)
#pragma unroll
            for (int i = 0; i < 4; ++i)
              ct[(a * 16 + 4 * lq + i) * 68 + b * 16 + lc] = acc[a][(hf * 4 + b) % NT][i];
        g1_epilogue_wave(p, g.l, rbase, cbase + hf * 64, ct, lane);
      }
    }
  } else if (EPI == EPI_G2) {
    u16* o = (u16*)(p.ws + OFF_HM);
    float* ct = (float*)smem + w * (64 * 68);
#pragma unroll
    for (int a = 0; a < 4; ++a)
#pragma unroll
      for (int b = 0; b < NT; ++b)
#pragma unroll
        for (int i = 0; i < 4; ++i) ct[(a * 16 + 4 * lq + i) * 68 + b * 16 + lc] = tot[a][b][i];
#pragma unroll 8
    for (int it = lane; it < 512; it += 64) {
      const int rl = it >> 3, c8 = (it & 7) * 8;
      float4 v0 = *(const float4*)(ct + rl * 68 + c8), v1 = *(const float4*)(ct + rl * 68 + c8 + 4);
      *(uint4*)(o + (size_t)(rbase + rl) * DM + cbase + c8) = make_uint4(pack2(v0.x, v0.y), pack2(v0.z, v0.w), pack2(v1.x, v1.y), pack2(v1.z, v1.w));
    }
  } else if (EPI == EPI_RES) {
    u16* xo = (u16*)(p.ws + OFF_X);
    const bool from_input = (g.res_chunk == 2) && g.l == 0;
    float* ct = (float*)smem + w * (64 * 68);
#pragma unroll
    for (int a = 0; a < 4; ++a)
#pragma unroll
      for (int b = 0; b < NT; ++b)
#pragma unroll
        for (int i = 0; i < 4; ++i) ct[(a * 16 + 4 * lq + i) * 68 + b * 16 + lc] = acc[a][b][i];
#pragma unroll 8
    for (int it = lane; it < 512; it += 64) {
      const int rl = it >> 3, c8 = (it & 7) * 8;
      const int row = rbase + rl, col = cbase + c8;
      float4 v0 = *(const float4*)(ct + rl * 68 + c8), v1 = *(const float4*)(ct + rl * 68 + c8 + 4);
      const float* gate = mod_vec(p, g.l, row, g.res_chunk) + col;
      float4 g0 = *(const float4*)gate, g1 = *(const float4*)(gate + 4);
      float x[8];
      if (from_input) {
        const float* xin = (row < NCTX ? p.in[0] + (size_t)row * DM : p.in[1] + (size_t)(row - NCTX) * DM) + col;
        float4 a0 = *(const float4*)xin, a1 = *(const float4*)(xin + 4);
        x[0] = a0.x; x[1] = a0.y; x[2] = a0.z; x[3] = a0.w; x[4] = a1.x; x[5] = a1.y; x[6] = a1.z; x[7] = a1.w;
      } else {
        uint4 xb = *(const uint4*)(xo + (size_t)row * DM + col);
        x[0] = __uint_as_float(xb.x << 16); x[1] = __uint_as_float(xb.x & 0xffff0000u);
        x[2] = __uint_as_float(xb.y << 16); x[3] = __uint_as_float(xb.y & 0xffff0000u);
        x[4] = __uint_as_float(xb.z << 16); x[5] = __uint_as_float(xb.z & 0xffff0000u);
        x[6] = __uint_as_float(xb.w << 16); x[7] = __uint_as_float(xb.w & 0xffff0000u);
      }
      x[0] += g0.x * v0.x; x[1] += g0.y * v0.y; x[2] += g0.z * v0.z; x[3] += g0.w * v0.w;
      x[4] += g1.x * v1.x; x[5] += g1.y * v1.y; x[6] += g1.z * v1.z; x[7] += g1.w * v1.w;
      *(uint4*)(xo + (size_t)row * DM + col) = make_uint4(pack2(x[0], x[1]), pack2(x[2], x[3]), pack2(x[4], x[5]), pack2(x[6], x[7]));
    }
  } else if (EPI == EPI_SWIGLU) {
    u16* o = (u16*)(p.ws + OFF_GH);
    float* ct = (float*)smem + w * (64 * 68);
#pragma unroll
    for (int a = 0; a < 4; ++a)
#pragma unroll
      for (int b = 0; b < NT / 2; ++b)
#pragma unroll
        for (int i = 0; i < 4; ++i) ct[(a * 16 + 4 * lq + i) * 68 + b * 16 + lc] = siluf_(acc[a][b][i]) * acc[a][(b + NT / 2) % NT][i];
    const int colb0 = (n0 >> 8) * 128 + wn * 64;
#pragma unroll 8
    for (int it = lane; it < 512; it += 64) {
      const int rl = it >> 3, c8 = (it & 7) * 8;
      float4 v0 = *(const float4*)(ct + rl * 68 + c8), v1 = *(const float4*)(ct + rl * 68 + c8 + 4);
      *(uint4*)(o + (size_t)(rbase + rl) * DFF + colb0 + c8) = make_uint4(pack2(v0.x, v0.y), pack2(v0.z, v0.w), pack2(v1.x, v1.y), pack2(v1.z, v1.w));
    }
  }
}

DI void g1_epilogue_wave(const Params& p, int l, int mrow0, int ncol0, const float* ct, int lane) {
  const bool ctx = mrow0 < NCTX;
  int kind;
  int br;
  int nrel;
  const int n0 = ncol0;
  if (n0 < 512) { kind = 0; br = 0; nrel = n0; }
  else if (n0 < 1024) { kind = 1; br = 0; nrel = n0 - 512; }
  else if (n0 < 1536) { kind = 2; br = 0; nrel = n0 - 1024; }
  else if (n0 < 2048) { kind = 0; br = 1; nrel = n0 - 1536; }
  else if (n0 < 2176) { kind = 1; br = 1; nrel = n0 - 2048; }
  else if (n0 < 2304) { kind = 2; br = 1; nrel = n0 - 2176; }
  else if (n0 < 2816) { kind = 0; br = 2; nrel = n0 - 2304; }
  else if (n0 < 2944) { kind = 1; br = 2; nrel = n0 - 2816; }
  else { kind = 2; br = 2; nrel = n0 - 2944; }

  if (kind < 2) {
    const int j = lane & 7, grp = lane >> 3;
    const float* cosT = (const float*)(p.ws + OFF_ROPE);
    const float* sinT = cosT + 1024 * 32;
    const float* gn = (kind == 0 ? p.in[20] : p.in[21]) + l * 64;
    for (int rl = grp; rl < 64; rl += 8) {
      const int row = mrow0 + rl;
      const float* cp = ct + rl * 68;
      float4 lo = *(const float4*)(cp + 4 * j), hi = *(const float4*)(cp + 32 + 4 * j);
      if (br == 1) {
        float ss = lo.x * lo.x + lo.y * lo.y + lo.z * lo.z + lo.w * lo.w + hi.x * hi.x + hi.y * hi.y + hi.z * hi.z + hi.w * hi.w;
        ss += __shfl_xor(ss, 1); ss += __shfl_xor(ss, 2); ss += __shfl_xor(ss, 4);
        float rs = rsqrtf(ss * (1.f / 64.f) + 1e-6f);
        float4 g0 = *(const float4*)(gn + 4 * j), g1 = *(const float4*)(gn + 32 + 4 * j);
        lo.x *= rs * g0.x; lo.y *= rs * g0.y; lo.z *= rs * g0.z; lo.w *= rs * g0.w;
        hi.x *= rs * g1.x; hi.y *= rs * g1.y; hi.z *= rs * g1.z; hi.w *= rs * g1.w;
      }
      if (!ctx) {
        const int pos = (row - NCTX) & 1023;
        float4 c = *(const float4*)(cosT + pos * 32 + 4 * j), sn = *(const float4*)(sinT + pos * 32 + 4 * j);
        float4 nlo = make_float4(lo.x * c.x - hi.x * sn.x, lo.y * c.y - hi.y * sn.y, lo.z * c.z - hi.z * sn.z, lo.w * c.w - hi.w * sn.w);
        float4 nhi = make_float4(hi.x * c.x + lo.x * sn.x, hi.y * c.y + lo.y * sn.y, hi.z * c.z + lo.z * sn.z, hi.w * c.w + lo.w * sn.w);
        lo = nlo; hi = nhi;
      }
      const int nc = nrel;
      if (kind == 0) {
        u16* q = (u16*)(p.ws + OFF_Q) + (size_t)row * 1536 + br * 512 + nc;
        *(uint2*)(q + 4 * j) = make_uint2(pack2(lo.x * 0.125f, lo.y * 0.125f), pack2(lo.z * 0.125f, lo.w * 0.125f));
        *(uint2*)(q + 32 + 4 * j) = make_uint2(pack2(hi.x * 0.125f, hi.y * 0.125f), pack2(hi.z * 0.125f, hi.w * 0.125f));
      } else {
        const int hd = (br == 0) ? 128 : 64, nh = (br == 0) ? 4 : 2;
        const int head = nc / hd, d = nc % hd;
        u16* kd;
        if (ctx) {
          const int b = row >> 8, key = row & 255;
          kd = KVC(p.ws, br) + ((size_t)(b * nh + head) * 256 + key) * hd + d;
          float* od = p.out + (br == 0 ? O_AK : (br == 1 ? O_BK : O_CK)) + ((size_t)((b * 4 + l) * 256 + key) * nh + head) * hd + d;
          st_nt4(od + 4 * j, lo);
          st_nt4(od + 32 + 4 * j, hi);
        } else {
          const int b = (row - NCTX) >> 10, pos = (row - NCTX) & 1023;
          kd = KVL(p.ws, l, br) + ((size_t)(b * nh + head) * 1536 + 512 + pos) * hd + d;
        }
        *(uint2*)(kd + 4 * j) = make_uint2(pack2(lo.x, lo.y), pack2(lo.z, lo.w));
        *(uint2*)(kd + 32 + 4 * j) = make_uint2(pack2(hi.x, hi.y), pack2(hi.z, hi.w));
      }
    }
  } else {
    const int nrows = (br == 0) ? 512 : 128;
    for (int it = lane; it < 256; it += 64) {
      const int gq = it & 3, c = it >> 2;
      const int row0 = mrow0 + gq * 16;
      float v[16];
#pragma unroll
      for (int i = 0; i < 16; ++i) v[i] = ct[(gq * 16 + i) * 68 + c];
      u16* vd;
      if (ctx) {
        const int b = row0 >> 8, key = row0 & 255;
        vd = KVC(p.ws, 3 + br) + ((size_t)b * nrows + nrel + c) * 256 + key;
      } else {
        const int b = (row0 - NCTX) >> 10, pos = (row0 - NCTX) & 1023;
        vd = KVL(p.ws, l, 3 + br) + ((size_t)b * nrows + nrel + c) * 1536 + 512 + pos;
      }
      *(uint4*)vd = make_uint4(pack2(v[0], v[1]), pack2(v[2], v[3]), pack2(v[8], v[9]), pack2(v[10], v[11]));
      *(uint4*)(vd + 8) = make_uint4(pack2(v[4], v[5]), pack2(v[6], v[7]), pack2(v[12], v[13]), pack2(v[14], v[15]));
    }
    if (ctx) {
      float* ob = p.out + (br == 0 ? O_AV : (br == 1 ? O_BV : O_CV));
      for (int it = lane; it < 1024; it += 64) {
        const int rl = it >> 4, c4 = (it & 15) * 4;
        const int row = mrow0 + rl, b = row >> 8, key = row & 255;
        float4 v = *(const float4*)(ct + rl * 68 + c4);
        st_nt4(ob + (size_t)((b * 4 + l) * 256 + key) * nrows + nrel + c4, v);
      }
    }
  }
}

template <int EPI, int BN>
DI void gemm_phase(const Params& p, const GemmArgs& g, int ntn, unsigned char* smem) {
  if (gridDim.x == 256) {
    const int xcd = blockIdx.x & 7, j = blockIdx.x >> 3;
    for (int il = j; il < 4 * ntn; il += 32) {
      const int mt = 4 * xcd + (il & 3), nt = il >> 2;
      gemm_tile<EPI, BN>(p, g, mt * 256, nt * BN, smem);
    }
  } else {
    const int ntiles = 32 * ntn;
    for (int tile = blockIdx.x; tile < ntiles; tile += gridDim.x) {
      const int mt = tile / ntn, nt = tile % ntn;
      gemm_tile<EPI, BN>(p, g, mt * 256, nt * BN, smem);
    }
  }
}

constexpr float LOG2E = 1.4426950408889634f;
constexpr int N_ATT_ITEMS = 768;
constexpr int VT_PITCH = 144;

DI void load_q(bf16x8 (&qf)[4], const u16* Q, int row, int coloff, int h) {
  const u16* qp = Q + (size_t)row * 1536 + coloff + 8 * h;
#pragma unroll
  for (int s = 0; s < 4; ++s) qf[s] = *(const bf16x8*)(qp + 16 * s);
}

template <int DV, int KD>
DI void attn_item(f32x16 (&o)[DV / 32], unsigned char* smem, const u16* __restrict__ Kg, const u16* __restrict__ Vg, int nkeys,
                  int n_tiles, int band_t0, const bf16x8 (&qf)[4], int koff, bool has_band, int qpos, float m_init, float l_init) {
  constexpr int KPITCH = KD * 2 + 16;
  constexpr int KBYTES = 64 * KPITCH;
  constexpr int VBYTES = DV * VT_PITCH;
  constexpr int BUF = KBYTES + VBYTES;
  constexpr int KCH = KD / 8;
  constexpr int NK = KD / 64;
  constexpr int NV = DV / 64;
  const int t = tid_(), lane = t & 63, r = lane & 31, h = lane >> 5;
  const int krow = t / KCH, kkc = t % KCH;
  const int vrow = t >> 3, vkc = t & 7;
  const u16* kgp = Kg + (size_t)krow * KD + kkc * 8;
  const u16* vgp = Vg + (size_t)vrow * nkeys + vkc * 8;
  const int klds = krow * KPITCH + kkc * 16;
  const int vlds = KBYTES + vrow * VT_PITCH + vkc * 16;
  uint4 k0, k1, v0, v1;
  k1 = v1 = make_uint4(0, 0, 0, 0);
#define ATT_TILE(i) ((i) < 8 || !has_band ? (i) : 8 + band_t0 + (i) - 8)
#define ATT_GLOAD(TI)                                                                   \
  {                                                                                     \
    const size_t key0_ = (size_t)(TI) * 64;                                             \
    k0 = *(const uint4*)(kgp + key0_ * KD);                                             \
    if (NK == 2) k1 = *(const uint4*)(kgp + (key0_ + 32) * KD);                         \
    v0 = *(const uint4*)(vgp + key0_);                                                  \
    if (NV == 2) v1 = *(const uint4*)(vgp + key0_ + (size_t)64 * nkeys);                \
  }
#define ATT_LSTORE(DST)                                                                 \
  {                                                                                     \
    *(uint4*)((DST) + klds) = k0;                                                       \
    if (NK == 2) *(uint4*)((DST) + klds + 32 * KPITCH) = k1;                            \
    *(uint4*)((DST) + vlds) = v0;                                                       \
    if (NV == 2) *(uint4*)((DST) + vlds + 64 * VT_PITCH) = v1;                          \
  }
  float m = m_init, l = l_init;
#pragma unroll
  for (int dt = 0; dt < DV / 32; ++dt)
#pragma unroll
    for (int i = 0; i < 16; ++i) o[dt][i] = 0.f;

  ATT_GLOAD(ATT_TILE(0))
  __syncthreads();
  ATT_LSTORE(smem)
  __syncthreads();
  for (int it = 0; it < n_tiles; ++it) {
    const int cur = it & 1;
    const int tile = ATT_TILE(it);
    if (it + 1 < n_tiles) ATT_GLOAD(ATT_TILE(it + 1))
    const unsigned char* kb = smem + cur * BUF + r * KPITCH + (koff + 8 * h) * 2;
    const unsigned char* vb = smem + cur * BUF + KBYTES + r * VT_PITCH + 16 * h;
    f32x16 S0, S1;
#pragma unroll
    for (int i = 0; i < 16; ++i) { S0[i] = 0.f; S1[i] = 0.f; }
#pragma unroll
    for (int s = 0; s < 4; ++s) {
      bf16x8 ka = *(const bf16x8*)(kb + 32 * s);
      bf16x8 kc = *(const bf16x8*)(kb + 32 * KPITCH + 32 * s);
      S0 = MFMA32(ka, qf[s], S0);
      S1 = MFMA32(kc, qf[s], S1);
    }
    if (has_band && it >= 8) {
      const int kbase = (tile - 8) * 64 - qpos;
#pragma unroll
      for (int i = 0; i < 16; ++i) {
        int d0 = kbase + crow(i, h), d1 = d0 + 32;
        if (d0 < -128 || d0 > 128) S0[i] = -1e30f;
        if (d1 < -128 || d1 > 128) S1[i] = -1e30f;
      }
    }
    float mx = fmaxf(S0[0], S1[0]);
#pragma unroll
    for (int i = 1; i < 16; ++i) mx = __builtin_fmaxf(__builtin_fmaxf(mx, S0[i]), S1[i]);
    mx = fmaxf(mx, __shfl_xor(mx, 32));
    const float mn = fmaxf(m, mx);
    const float mb = mn * LOG2E;
    float ps;
    {
      const f2_t sc2 = {LOG2E, LOG2E}, nb2 = {-mb, -mb};
      f2_t ps2 = {0.f, 0.f};
#pragma unroll
      for (int i = 0; i < 8; ++i) {
        f2_t a = {S0[2 * i], S0[2 * i + 1]}, b = {S1[2 * i], S1[2 * i + 1]};
        a = __builtin_elementwise_fma(a, sc2, nb2);
        b = __builtin_elementwise_fma(b, sc2, nb2);
        a.x = __builtin_amdgcn_exp2f(a.x); a.y = __builtin_amdgcn_exp2f(a.y);
        b.x = __builtin_amdgcn_exp2f(b.x); b.y = __builtin_amdgcn_exp2f(b.y);
        S0[2 * i] = a.x; S0[2 * i + 1] = a.y; S1[2 * i] = b.x; S1[2 * i + 1] = b.y;
        ps2 += a; ps2 += b;
      }
      ps = ps2.x + ps2.y;
    }
    if (__any(mn != m)) {
      const float alpha = __builtin_amdgcn_exp2f((m - mn) * LOG2E);
      l *= alpha;
#pragma unroll
      for (int dt = 0; dt < DV / 32; ++dt)
#pragma unroll
        for (int i = 0; i < 16; ++i) o[dt][i] *= alpha;
      m = mn;
    }
    l += ps;
    bf16x8 pf0, pf1, pf2, pf3;
    {
      uint4 u;
      u = make_uint4(pack2(S0[0], S0[1]), pack2(S0[2], S0[3]), pack2(S0[4], S0[5]), pack2(S0[6], S0[7])); pf0 = __builtin_bit_cast(bf16x8, u);
      u = make_uint4(pack2(S0[8], S0[9]), pack2(S0[10], S0[11]), pack2(S0[12], S0[13]), pack2(S0[14], S0[15])); pf1 = __builtin_bit_cast(bf16x8, u);
      u = make_uint4(pack2(S1[0], S1[1]), pack2(S1[2], S1[3]), pack2(S1[4], S1[5]), pack2(S1[6], S1[7])); pf2 = __builtin_bit_cast(bf16x8, u);
      u = make_uint4(pack2(S1[8], S1[9]), pack2(S1[10], S1[11]), pack2(S1[12], S1[13]), pack2(S1[14], S1[15])); pf3 = __builtin_bit_cast(bf16x8, u);
    }
#pragma unroll
    for (int dt = 0; dt < DV / 32; ++dt) {
      const unsigned char* vp = vb + dt * 32 * VT_PITCH;
      o[dt] = MFMA32(*(const bf16x8*)(vp), pf0, o[dt]);
      o[dt] = MFMA32(*(const bf16x8*)(vp + 32), pf1, o[dt]);
      o[dt] = MFMA32(*(const bf16x8*)(vp + 64), pf2, o[dt]);
      o[dt] = MFMA32(*(const bf16x8*)(vp + 96), pf3, o[dt]);
    }
    if (it + 1 < n_tiles) {
      unsigned char* dst = smem + (cur ^ 1) * BUF;
      ATT_LSTORE(dst)
    }
    __syncthreads();
  }
  const float lt = l + __shfl_xor(l, 32);
  const float inv = 1.f / lt;
#pragma unroll
  for (int dt = 0; dt < DV / 32; ++dt)
#pragma unroll
    for (int i = 0; i < 16; ++i) o[dt][i] *= inv;
}

DI void attn_phase(const Params& p, int l, int ph, unsigned char* smem) {
  __shared__ int s_item;
  const int t = tid_(), lane = t & 63, wv = t >> 6, r = lane & 31, h = lane >> 5;
  const u16* Q = (const u16*)(p.ws + OFF_Q);
  u16* AO = (u16*)(p.ws + OFF_ATT);
  unsigned* ctr = (unsigned*)(p.ws + OFF_BAR + 14336) + ph;
  float lam;
  {
    float a = p.in[15][l * 64 + lane] * p.in[16][l * 64 + lane];
    float b = p.in[17][l * 64 + lane] * p.in[18][l * 64 + lane];
    a = wave_sum(a); b = wave_sum(b);
    lam = __expf(a) - __expf(b) + p.lam_init[l];
  }
  const float one_m_li = 1.f - p.lam_init[l];
  const bool static_first = gridDim.x == 256;
  bool first = true;
  for (;;) {
    __syncthreads();
    if (t == 0) {
      if (first && static_first) {
        const int xcd = blockIdx.x & 7, j = blockIdx.x >> 3;
        if (j < 16) { const int g = 2 * xcd + (j >> 3); s_item = (g >> 2) * 32 + (g & 3) * 8 + (j & 7); }
        else s_item = 128 + (xcd >> 1) * 32 + (xcd & 1) * 16 + (j - 16);
      } else {
        s_item = (static_first ? 256 : 0) + (int)atomicAdd(ctr, 1u);
      }
    }
    first = false;
    __syncthreads();
    const int it = s_item;
    if (it >= N_ATT_ITEMS) break;
    const int cls = it >> 7, i = it & 127;
    const int lat = cls < 3, br = cls % 3;
    const int nkeys = lat ? 1536 : 256;
    if (br == 0) {
      int b, hd, qb;
      if (lat) { b = i >> 5; hd = (i >> 3) & 3; qb = i & 7; } else { b = i >> 3; hd = (i >> 1) & 3; qb = i & 1; }
      const int pass = wv >> 2;
      const int row = (lat ? NCTX + b * 1024 : b * 256) + qb * 128 + (wv & 3) * 32 + r;
      const u16* Kb = (lat ? KVL(p.ws, l, 0) : KVC(p.ws, 0)) + (size_t)(b * 4 + hd) * nkeys * 128;
      const u16* Vb = (lat ? KVL(p.ws, l, 3) : KVC(p.ws, 3)) + (size_t)(b * 4 + hd) * 128 * nkeys;
      bf16x8 qf[4];
      load_q(qf, Q, row, hd * 128 + pass * 64, h);
      f32x16 o[4];
      attn_item<128, 128>(o, smem, Kb, Vb, nkeys, nkeys / 64, 0, qf, pass * 64, false, 0, -1e30f, 0.f);
      float* stash = (float*)smem + (wv & 3) * 4096;
      if (pass == 1) {
#pragma unroll
        for (int dt = 0; dt < 4; ++dt)
#pragma unroll
          for (int q = 0; q < 16; ++q) stash[(dt * 16 + q) * 64 + lane] = o[dt][q];
      }
      __syncthreads();
      if (pass == 0) {
        float ss = 0.f;
#pragma unroll
        for (int dt = 0; dt < 4; ++dt)
#pragma unroll
          for (int q = 0; q < 16; ++q) {
            float v = o[dt][q] - lam * stash[(dt * 16 + q) * 64 + lane];
            o[dt][q] = v;
            ss += v * v;
          }
        ss += __shfl_xor(ss, 32);
        const float rs = rsqrtf(ss * (1.f / 128.f) + 1e-6f) * one_m_li;
        const float* sg = p.in[19] + l * 128;
        u16* tl = (u16*)(smem + 65536 + wv * 8704);
#pragma unroll
        for (int dt = 0; dt < 4; ++dt)
#pragma unroll
          for (int g4 = 0; g4 < 4; ++g4) {
            const int d = dt * 32 + 8 * g4 + 4 * h;
            float4 gg = *(const float4*)(sg + d);
            unsigned w0 = pack2(o[dt][4 * g4] * rs * gg.x, o[dt][4 * g4 + 1] * rs * gg.y);
            unsigned w1 = pack2(o[dt][4 * g4 + 2] * rs * gg.z, o[dt][4 * g4 + 3] * rs * gg.w);
            *(uint2*)(tl + r * 136 + d) = make_uint2(w0, w1);
          }
        u16* ob = AO + (size_t)(row - r) * 1536 + hd * 128;
#pragma unroll
        for (int q = 0; q < 8; ++q) {
          const int itx = lane + 64 * q, rr = itx >> 4, c8 = (itx & 15) * 8;
          *(uint4*)(ob + (size_t)rr * 1536 + c8) = *(const uint4*)(tl + rr * 136 + c8);
        }
      }
    } else {
      int b, kvh, qg;
      if (lat) { b = i >> 5; kvh = (i >> 4) & 1; qg = i & 15; } else { b = i >> 3; kvh = (i >> 2) & 1; qg = i & 3; }
      const int hd = kvh * 4 + (wv & 3), qsub = wv >> 2;
      const int row = (lat ? NCTX + b * 1024 : b * 256) + qg * 64 + qsub * 32 + r;
      const u16* Kb = (lat ? KVL(p.ws, l, br) : KVC(p.ws, br)) + (size_t)(b * 2 + kvh) * nkeys * 64;
      const u16* Vb = (lat ? KVL(p.ws, l, 3 + br) : KVC(p.ws, 3 + br)) + (size_t)(b * 2 + kvh) * 64 * nkeys;
      bf16x8 qf[4];
      load_q(qf, Q, row, br * 512 + hd * 64, h);
      f32x16 o[2];
      const bool band = (br == 2) && lat;
      int n_tiles = nkeys / 64, t0 = 0;
      if (band) {
        const int q0 = qg * 64;
        t0 = (q0 - 128) < 0 ? 0 : (q0 - 128) >> 6;
        int t1 = (q0 + 191) >> 6; if (t1 > 15) t1 = 15;
        n_tiles = 8 + (t1 - t0 + 1);
      }
      const float m0 = (br == 2) ? p.in[22][l * 8 + hd] : -1e30f;
      const float l0 = (br == 2 && h == 0) ? 1.f : 0.f;
      attn_item<64, 64>(o, smem, Kb, Vb, nkeys, n_tiles, t0, qf, 0, band, qg * 64 + qsub * 32 + r, m0, l0);
      u16* tl = (u16*)(smem + 65536 + wv * 8704);
#pragma unroll
      for (int dt = 0; dt < 2; ++dt)
#pragma unroll
        for (int g4 = 0; g4 < 4; ++g4) {
          const int d = dt * 32 + 8 * g4 + 4 * h;
          unsigned w0 = pack2(o[dt][4 * g4], o[dt][4 * g4 + 1]);
          unsigned w1 = pack2(o[dt][4 * g4 + 2], o[dt][4 * g4 + 3]);
          *(uint2*)(tl + r * 72 + d) = make_uint2(w0, w1);
        }
      u16* ob = AO + (size_t)(row - r) * 1536 + br * 512 + hd * 64;
#pragma unroll
      for (int q = 0; q < 4; ++q) {
        const int itx = lane + 64 * q, rr = itx >> 3, c8 = (itx & 7) * 8;
        *(uint4*)(ob + (size_t)rr * 1536 + c8) = *(const uint4*)(tl + rr * 72 + c8);
      }
    }
  }
}

#define XB_TMO      128
#define XB_XCNT(j)  (256  + 64 * (j))
#define XB_XSUB(j)  (1280 + 64 * (j))
#define XB_XGEN(j)  (2304 + 64 * (j))
#define XB_TOP      3328
#define XB_TOPGEN   3392
#define XCD_BAR_WORDS 3456
#define XB_SPIN_CAP (1u << 22)
DI unsigned xb_ld(unsigned* p) { return __hip_atomic_load(p, __ATOMIC_RELAXED, __HIP_MEMORY_SCOPE_AGENT); }
DI unsigned xb_add(unsigned* p, unsigned v) { return __hip_atomic_fetch_add(p, v, __ATOMIC_RELAXED, __HIP_MEMORY_SCOPE_AGENT); }
DI unsigned xb_xcc_id() { return (unsigned)__builtin_amdgcn_s_getreg((3 << 11) | 20) & 0xFu; }
#define XB_SPIN(cond, bar) do { unsigned _sp = 0; while (cond) { __builtin_amdgcn_s_sleep(1); \
    if ((++_sp & 255u) == 0u) { if (xb_ld(&(bar)[XB_TMO])) break; if (_sp > XB_SPIN_CAP) { atomicAdd(&(bar)[XB_TMO], 1u); break; } } } } while (0)
struct XcdBarrier { unsigned* bar; unsigned x; volatile LAS unsigned* st; };
DI XcdBarrier xcd_barrier_post(unsigned* bar, volatile LAS unsigned* st) {
  XcdBarrier b; b.bar = bar; b.x = xb_xcc_id(); b.st = st;
  if (threadIdx.x == 0) (void)xb_add(&bar[XB_XCNT(b.x)], 1u);
  return b;
}
DI void xcd_barrier_complete(unsigned* bar, unsigned x, unsigned& nloc, unsigned& nx) {
  const unsigned G = gridDim.x * gridDim.y * gridDim.z;
  unsigned sum, cnt, mine, sp = 0u;
  for (;;) {
    sum = 0u; cnt = 0u; mine = 0u;
#pragma unroll
    for (unsigned j = 0; j < 16; ++j) { const unsigned c = xb_ld(&bar[XB_XCNT(j)]); sum += c; cnt += (c > 0u) ? 1u : 0u; mine = (j == x) ? c : mine; }
    if (sum == G) break;
    __builtin_amdgcn_s_sleep(1);
    if ((++sp & 255u) == 0u) { if (xb_ld(&bar[XB_TMO])) break; if (sp > XB_SPIN_CAP) { atomicAdd(&bar[XB_TMO], 1u); break; } }
  }
  nloc = mine > 0u ? mine : 1u; nx = cnt > 0u ? cnt : 1u;
}
DI void xcd_barrier(const XcdBarrier& b) {
  asm volatile("s_waitcnt vmcnt(0)" ::: "memory");
  __syncthreads();
  if (threadIdx.x == 0) {
    unsigned* bar = b.bar;
    __builtin_amdgcn_s_waitcnt(0);
    unsigned nloc = b.st[0], nx = b.st[1];
    if (nloc == 0u) { xcd_barrier_complete(bar, b.x, nloc, nx); b.st[0] = nloc; b.st[1] = nx; }
    const unsigned old = xb_add(&bar[XB_XSUB(b.x)], 1u);
    const unsigned gen = old / nloc;
    if (old + 1u == (gen + 1u) * nloc) {
      __builtin_amdgcn_fence(__ATOMIC_RELEASE, "agent");
      asm volatile("s_waitcnt vmcnt(0)" ::: "memory");
      const unsigned og = xb_add(&bar[XB_TOP], 1u);
      const unsigned tg = og / nx;
      if (og + 1u == (tg + 1u) * nx) xb_add(&bar[XB_TOPGEN], 1u);
      else XB_SPIN(xb_ld(&bar[XB_TOPGEN]) == tg, bar);
      __builtin_amdgcn_fence(__ATOMIC_ACQUIRE, "agent");
      xb_add(&bar[XB_XGEN(b.x)], 1u);
      asm volatile("s_waitcnt vmcnt(0)" ::: "memory");
    } else {
      XB_SPIN(xb_ld(&bar[XB_XGEN(b.x)]) == gen, bar);
      __builtin_amdgcn_fence(__ATOMIC_ACQUIRE, "agent");
      asm volatile("s_waitcnt vmcnt(0)" ::: "memory");
    }
  }
  __syncthreads();
}

__global__ void __launch_bounds__(512, 2) fwd_megakernel(Params p) {
  __shared__ __attribute__((aligned(16))) unsigned char smem[SMEM_BYTES];
  __shared__ uint4 xb_words;
  cg::grid_group grid = cg::this_grid();
  if (threadIdx.x == 0) xb_words = make_uint4(0u, 0u, 0u, 0u);
  __syncthreads();
  XcdBarrier xb = xcd_barrier_post((unsigned*)(p.ws + OFF_BAR), (volatile LAS unsigned*)&xb_words);
  for (int ph = p.ph_lo; ph < p.ph_hi; ++ph) {
    if (ph > p.ph_lo) {
      if (p.ph_hi > 4096) grid.sync();
      xcd_barrier(xb);
    }
    if (ph == 0) { pre_phase(p, (float*)smem); continue; }
    if (ph == NPH - 1) { norm_phase(p, 0, 2); continue; }
    const int l = (ph - 1) / SEQ_N, sub = (int)((SEQ_PACK >> (4 * ((ph - 1) % SEQ_N))) & 15ull);
    GemmArgs g;
    g.l = l; g.res_chunk = 0;
    switch (sub) {
      case 0: norm_phase(p, l, 0); break;
#ifndef DIS1
      case 1:
        g.A = (const u16*)(p.ws + OFF_HM); g.lda = DM; g.Bt = Wt_in(p.ws, l); g.ldb = DM; g.K = DM;
        gemm_phase<EPI_G1, 256>(p, g, DIN / 256, smem);
        break;
#endif
#ifndef DIS2
      case 2: attn_phase(p, l, ph, smem); break;
#endif
#ifndef DIS3
      case 3:
        g.A = (const u16*)(p.ws + OFF_ATT); g.lda = 1536; g.Bt = Wt_br(p.ws, l); g.ldb = 1536; g.K = 1536;
        gemm_phase<EPI_G2, 128>(p, g, DM / 128, smem);
        break;
#endif
      case 4:
        g.A = (const u16*)(p.ws + OFF_HM); g.lda = DM; g.Bt = Wt_out(p.ws, l); g.ldb = DM; g.K = DM; g.res_chunk = 2;
        gemm_phase<EPI_RES, 128>(p, g, DM / 128, smem);
        break;
      case 5: norm_phase(p, l, 1); break;
      case 6:
        g.A = (const u16*)(p.ws + OFF_HM); g.lda = DM; g.Bt = Wt_f1(p.ws, l); g.ldb = DM; g.K = DM;
        gemm_phase<EPI_SWIGLU, 256>(p, g, 2 * DFF / 256, smem);
        break;
      default:
        g.A = (const u16*)(p.ws + OFF_GH); g.lda = DFF; g.Bt = Wt_f2(p.ws, l); g.ldb = DFF; g.K = DFF; g.res_chunk = 5;
        gemm_phase<EPI_RES, 128>(p, g, DM / 128, smem);
        break;
    }
  }
}

extern "C" void kernel_launch(void* const* d_in, const int* in_sizes, int n_in, void* d_out, int out_size, void* d_ws, size_t ws_size,
                              hipStream_t stream) {
  static int grid_blocks = 0;
  if (!grid_blocks) {
    int dev = 0, cus = 0, per_cu = 0;
    hipGetDevice(&dev);
    hipDeviceGetAttribute(&cus, hipDeviceAttributeMultiprocessorCount, dev);
    hipOccupancyMaxActiveBlocksPerMultiprocessor(&per_cu, fwd_megakernel, 512, 0);
    if (per_cu < 1) per_cu = 1;
    if (per_cu > 1) per_cu = 1;
    grid_blocks = cus * per_cu;
    if (ws_size < WS_END) fprintf(stderr, "kernel_launch: workspace too small: %zu < %zu\n", ws_size, (size_t)WS_END);
  }
  Params p{};
  for (int i = 0; i < 30; ++i) p.in[i] = (const float*)d_in[i];
  p.out = (float*)d_out;
  p.ws = (unsigned char*)d_ws;
  for (int l = 0; l < 4; ++l) p.lam_init[l] = (float)(0.8 - 0.6 * exp(-0.3 * l));
  hipMemsetAsync((unsigned char*)d_ws + OFF_BAR, 0, 16384, stream);
#if ONE_LAUNCH
  p.ph_lo = 0; p.ph_hi = NPH;
  void* args[] = {&p};
  hipError_t e = hipLaunchCooperativeKernel((void*)fwd_megakernel, dim3(grid_blocks), dim3(512), args, 0, stream);
  if (e != hipSuccess) fprintf(stderr, "cooperative launch failed: %s (grid %d)\n", hipGetErrorString(e), grid_blocks);
#else
  for (int ph = 0; ph < NPH; ++ph) {
    p.ph_lo = ph; p.ph_hi = ph + 1;
    hipLaunchKernelGGL(fwd_megakernel, dim3(grid_blocks), dim3(512), 0, stream, p);
  }
#endif
}
```

```cpp
#include <hip/hip_runtime.h>
#include <hip/hip_cooperative_groups.h>
#include <cstdio>
#include <cstdint>
#include <cmath>
namespace cg = cooperative_groups;

#ifndef ONE_LAUNCH
#define ONE_LAUNCH 1
#endif

typedef unsigned short u16;
typedef __attribute__((ext_vector_type(8))) short bf16x8;
typedef __attribute__((ext_vector_type(4))) short s16x4;
typedef __attribute__((ext_vector_type(16))) float f32x16;
typedef __attribute__((ext_vector_type(4))) float f32x4;
typedef __attribute__((ext_vector_type(2))) unsigned u32x2;
typedef __attribute__((ext_vector_type(4))) unsigned u32x4;
typedef __attribute__((ext_vector_type(2))) __bf16 bf2_t;
typedef __attribute__((ext_vector_type(2))) float f2_t;
#define DI __device__ __forceinline__
#define LAS __attribute__((address_space(3)))
#define MFMA32(a, b, c) __builtin_amdgcn_mfma_f32_32x32x16_bf16((a), (b), (c), 0, 0, 0)

constexpr int DM = 1024, NTOK = 8192, NCTX = 4096;
constexpr int DIN = 6144, DFF = 2816, DEPTH = 4;
#ifndef SEQ_PACK
#define SEQ_PACK 0x76543210ull
#define SEQ_N 8
#endif
constexpr int NPH = 2 + SEQ_N * DEPTH;

constexpr size_t SZ_WIN = (size_t)DIN * DM * 2, SZ_WBR = (size_t)DM * 1536 * 2, SZ_WOUT = (size_t)DM * DM * 2;
constexpr size_t SZ_WF1 = (size_t)2 * DFF * DM * 2, SZ_WF2 = (size_t)DM * DFF * 2;
constexpr size_t SZ_WL = SZ_WIN + SZ_WBR + SZ_WOUT + SZ_WF1 + SZ_WF2;
constexpr size_t OFF_W = 0;
constexpr size_t OFF_MOD = OFF_W + SZ_WL * DEPTH;
constexpr size_t OFF_ROPE = OFF_MOD + (size_t)4 * 5 * 6144 * 4;
constexpr size_t OFF_X = OFF_ROPE + (size_t)2 * 1024 * 32 * 4;
constexpr size_t OFF_HM = OFF_X + (size_t)NTOK * DM * 4;
constexpr size_t OFF_Q = OFF_HM + (size_t)NTOK * DM * 2;
constexpr size_t OFF_GH = OFF_Q + (size_t)NTOK * 1536 * 2;
constexpr size_t OFF_ATT = OFF_GH + (size_t)NTOK * 3072 * 2;
constexpr size_t EL_KA = (size_t)4 * 4 * 1536 * 128, EL_KB = (size_t)4 * 2 * 1536 * 64;
constexpr size_t SZ_KVL = (2 * EL_KA + 4 * EL_KB) * 2;
constexpr size_t OFF_KVL = OFF_ATT + (size_t)NTOK * 1536 * 2;
constexpr size_t EL_KAC = (size_t)16 * 4 * 256 * 128, EL_KBC = (size_t)16 * 2 * 256 * 64;
constexpr size_t OFF_KVC = OFF_KVL + SZ_KVL * DEPTH;
constexpr size_t OFF_BAR = OFF_KVC + (2 * EL_KAC + 4 * EL_KBC) * 2;
constexpr size_t WS_END = OFF_BAR + 16384;

constexpr size_t O_YP = 0, O_YS = 4194304, O_AK = 8388608, O_AV = 16777216, O_BK = 25165824, O_BV = 27262976, O_CK = 29360128, O_CV = 31457280;

struct Params {
  const float* in[30];
  float* out;
  unsigned char* ws;
  float lam_init[4];
  int ph_lo, ph_hi;
};

DI unsigned pack2(float a, float b) { f2_t v = {a, b}; bf2_t r = __builtin_convertvector(v, bf2_t); return __builtin_bit_cast(unsigned, r); }
DI int tid_() { int t = threadIdx.x; asm volatile("" : "+v"(t)); return t; }
DI float4 ld_nt4(const float* p) { f32x4 t = __builtin_nontemporal_load((const f32x4*)p); return make_float4(t[0], t[1], t[2], t[3]); }
DI void st_nt4(float* p, float4 v) { f32x4 t = {v.x, v.y, v.z, v.w}; __builtin_nontemporal_store(t, (f32x4*)p); }
DI void st_nt2(float* p, float2 v) { f2_t t = {v.x, v.y}; __builtin_nontemporal_store(t, (f2_t*)p); }
DI float bf2f(u16 x) { return __uint_as_float(((unsigned)x) << 16); }
DI int crow(int reg, int h) { return (reg & 3) + 8 * (reg >> 2) + 4 * h; }
DI float wave_sum(float v) {
#pragma unroll
  for (int o = 32; o > 0; o >>= 1) v += __shfl_xor(v, o);
  return v;
}
DI float sigmoidf_(float x) { return __builtin_amdgcn_rcpf(1.f + __expf(-x)); }
DI float siluf_(float x) { return x * __builtin_amdgcn_rcpf(1.f + __expf(-x)); }
DI u16 bf16_1(float x) { return (u16)(pack2(x, 0.f) & 0xffffu); }

DI u16* Wt_in(unsigned char* ws, int l) { return (u16*)(ws + OFF_W + SZ_WL * l); }
DI u16* Wt_br(unsigned char* ws, int l) { return (u16*)(ws + OFF_W + SZ_WL * l + SZ_WIN); }
DI u16* Wt_out(unsigned char* ws, int l) { return (u16*)(ws + OFF_W + SZ_WL * l + SZ_WIN + SZ_WBR); }
DI u16* Wt_f1(unsigned char* ws, int l) { return (u16*)(ws + OFF_W + SZ_WL * l + SZ_WIN + SZ_WBR + SZ_WOUT); }
DI u16* Wt_f2(unsigned char* ws, int l) { return (u16*)(ws + OFF_W + SZ_WL * l + SZ_WIN + SZ_WBR + SZ_WOUT + SZ_WF1); }
DI u16* KVL(unsigned char* ws, int l, int which) {
  size_t off = 0;
  if (which >= 1) off += EL_KA;
  if (which >= 2) off += EL_KB;
  if (which >= 3) off += EL_KB;
  if (which >= 4) off += EL_KA;
  if (which >= 5) off += EL_KB;
  return (u16*)(ws + OFF_KVL + SZ_KVL * l) + off;
}
DI u16* KVC(unsigned char* ws, int which) {
  size_t off = 0;
  if (which >= 1) off += EL_KAC;
  if (which >= 2) off += EL_KBC;
  if (which >= 3) off += EL_KBC;
  if (which >= 4) off += EL_KAC;
  if (which >= 5) off += EL_KBC;
  return (u16*)(ws + OFF_KVC) + off;
}
DI const float* x_src(const Params& p, int l, int row) {
  if (l == 0) return row < NCTX ? p.in[0] + (size_t)row * DM : p.in[1] + (size_t)(row - NCTX) * DM;
  return (const float*)(p.ws + OFF_X) + (size_t)row * DM;
}
DI const float* mod_vec(const Params& p, int l, int row, int chunk) {
  int v = row < NCTX ? 4 : ((row - NCTX) >> 10);
  return (const float*)(p.ws + OFF_MOD) + ((size_t)(l * 5 + v) * 6144 + chunk * 1024);
}

template <int NT64>
DI void transpose_tile(const float* __restrict__ src, int ldsrc, int k0, int n0, u16* __restrict__ dst, int ldd, int mode, float* tile) {
  const int t = tid_() & 255;
  __syncthreads();
  {
    const int kk = t >> 4, c4 = (t & 15) * 4;
    float4 v[NT64 * 4];
#pragma unroll
    for (int q = 0; q < NT64; ++q)
#pragma unroll
      for (int i = 0; i < 4; ++i) { f32x4 t_ = __builtin_nontemporal_load((const f32x4*)(src + (size_t)(k0 + kk + 16 * i) * ldsrc + n0 + 64 * q + c4)); v[q * 4 + i] = make_float4(t_[0], t_[1], t_[2], t_[3]); }
#pragma unroll
    for (int q = 0; q < NT64; ++q)
#pragma unroll
      for (int i = 0; i < 4; ++i) {
        float* tp = tile + q * 4160 + (kk + 16 * i) * 65 + c4;
        tp[0] = v[q * 4 + i].x; tp[1] = v[q * 4 + i].y; tp[2] = v[q * 4 + i].z; tp[3] = v[q * 4 + i].w;
      }
  }
  __syncthreads();
  const int n = t >> 2, kc = (t & 3) * 16;
#pragma unroll
  for (int q = 0; q < NT64; ++q) {
    const float* tq = tile + q * 4160;
    const int n0q = n0 + 64 * q;
    unsigned w[8];
#pragma unroll
    for (int j = 0; j < 8; ++j) w[j] = pack2(tq[(kc + 2 * j) * 65 + n], tq[(kc + 2 * j + 1) * 65 + n]);
    int drow;
    if (mode != 1) drow = n0q + n;
    else {
      int isb = n0q >= DFF;
      int c0 = n0q - (isb ? DFF : 0);
      drow = (c0 >> 7) * 256 + ((c0 >> 6) & 1) * 128 + isb * 64 + n;
    }
    uint4* dp = (uint4*)(dst + (size_t)drow * ldd + k0 + kc);
    if (mode == 2) {
      dp[0] = make_uint4(w[0], w[1], w[4], w[5]);
      dp[1] = make_uint4(w[2], w[3], w[6], w[7]);
    } else {
      dp[0] = make_uint4(w[0], w[1], w[2], w[3]);
      dp[1] = make_uint4(w[4], w[5], w[6], w[7]);
    }
  }
}

DI void mod_task(const Params& p, int l, int cgp, float* sm) {
  float* sv = sm;
  float* red = sm + 5 * 1024;
  const int t = tid_() & 255;
  __syncthreads();
  for (int e = t; e < 5 * 1024; e += 256) {
    int v = e >> 10, k = e & 1023;
    float x = v < 4 ? p.in[8][v * 1024 + k] : p.in[9][k];
    sv[e] = siluf_(x);
  }
  __syncthreads();
  const int c4 = t & 31, ks = t >> 5;
  const float* w = p.in[10] + (size_t)l * 1024 * 6144 + cgp * 128 + c4 * 4;
  float acc[5][4];
#pragma unroll
  for (int v = 0; v < 5; ++v) { acc[v][0] = acc[v][1] = acc[v][2] = acc[v][3] = 0.f; }
#pragma unroll 8
  for (int k = ks * 128; k < ks * 128 + 128; ++k) {
    f32x4 wt_ = __builtin_nontemporal_load((const f32x4*)(w + (size_t)k * 6144));
    float4 wv = make_float4(wt_[0], wt_[1], wt_[2], wt_[3]);
#pragma unroll
    for (int v = 0; v < 5; ++v) {
      float s = sv[v * 1024 + k];
      acc[v][0] += s * wv.x; acc[v][1] += s * wv.y; acc[v][2] += s * wv.z; acc[v][3] += s * wv.w;
    }
  }
#pragma unroll
  for (int v = 0; v < 5; ++v)
#pragma unroll
    for (int j = 0; j < 4; ++j) red[(ks * 32 + c4) * 20 + v * 4 + j] = acc[v][j];
  __syncthreads();
  for (int o = t; o < 640; o += 256) {
    int cc = o / 20, r = o % 20, v = r >> 2, j = r & 3;
    float s = 0.f;
#pragma unroll
    for (int q = 0; q < 8; ++q) s += red[(q * 32 + cc) * 20 + r];
    int col = cgp * 128 + cc * 4 + j;
    s += p.in[11][l * 6144 + col];
    ((float*)(p.ws + OFF_MOD))[(size_t)(l * 5 + v) * 6144 + col] = s;
  }
}

constexpr int T_MOD = 192, T_ROPE = 32, T_WTL = 1072, T_WT = T_WTL * 4, T_CVA = 256, T_CVB = 128, T_CKA = 2048, T_CKB = 512;
constexpr int T_PRE = T_MOD + T_ROPE + T_WT + T_CVA + 2 * T_CVB + T_CKA + 2 * T_CKB;

DI void pre_phase(const Params& p, float* sm0) {
  const int t = tid_() & 255, half = tid_() >> 8;
  float* sm = sm0 + half * 16640;
  for (int pair = blockIdx.x; pair < T_PRE / 2; pair += gridDim.x) {
    int i = pair * 2 + half;
    if (i < T_MOD) { mod_task(p, i / 48, i % 48, sm); continue; }
    i -= T_MOD;
    if (i < T_ROPE) {
      float* cosT = (float*)(p.ws + OFF_ROPE);
      float* sinT = cosT + 1024 * 32;
#pragma unroll
      for (int q = 0; q < 4; ++q) {
        int e = i * 1024 + q * 256 + t;
        int pos = e >> 5, j = e & 31;
        int rr = pos >> 6, cc = pos & 63;
        float inv = exp2f(-(float)(j & 15) * (13.287712379549449f / 16.f));
        float ang = (float)(j < 16 ? rr : cc) * inv;
        cosT[e] = __cosf(ang);
        sinT[e] = __sinf(ang);
      }
      continue;
    }
    i -= T_ROPE;
    if (i < T_WT) {
      int l = i / T_WTL, j = i % T_WTL;
      if (j < 384) { transpose_tile<4>(p.in[14] + (size_t)l * 1024 * 6144, 6144, (j / 24) * 64, (j % 24) * 256, Wt_in(p.ws, l), 1024, 0, sm); continue; }
      j -= 384;
      if (j < 96) {
        int seg = j / 32, jj = j % 32;
        transpose_tile<4>((seg == 0 ? p.in[23] : (seg == 1 ? p.in[24] : p.in[25])) + (size_t)l * 512 * 1024, 1024, (jj / 4) * 64, (jj % 4) * 256, Wt_br(p.ws, l) + seg * 512, 1536, 0, sm);
        continue;
      }
      j -= 96;
      if (j < 64) { transpose_tile<4>(p.in[26] + (size_t)l * 1024 * 1024, 1024, (j / 4) * 64, (j % 4) * 256, Wt_out(p.ws, l), 1024, 0, sm); continue; }
      j -= 64;
      if (j < 352) { transpose_tile<4>(p.in[27] + (size_t)l * 1024 * 5632, 5632, (j / 22) * 64, (j % 22) * 256, Wt_f1(p.ws, l), 1024, 1, sm); continue; }
      j -= 352;
      transpose_tile<4>(p.in[28] + (size_t)l * 2816 * 1024, 1024, (j / 4) * 64, (j % 4) * 256, Wt_f2(p.ws, l), 2816, 0, sm);
      continue;
    }
    i -= T_WT;
    if (i < T_CVA) {
      int bl = i / 16, jj = i % 16, b = bl >> 2, l = bl & 3;
      transpose_tile<4>(p.in[3] + (size_t)bl * 512 * 512, 512, (jj / 2) * 64, (jj % 2) * 256, KVL(p.ws, l, 3) + (size_t)b * 512 * 1536, 1536, 2, sm);
      continue;
    }
    i -= T_CVA;
    if (i < 2 * T_CVB) {
      int wh = i / T_CVB, ii = i % T_CVB;
      int bl = ii / 8, jj = ii % 8, b = bl >> 2, l = bl & 3;
      transpose_tile<2>((wh ? p.in[7] : p.in[5]) + (size_t)bl * 512 * 128, 128, jj * 64, 0, KVL(p.ws, l, wh ? 5 : 4) + (size_t)b * 128 * 1536, 1536, 2, sm);
      continue;
    }
    i -= 2 * T_CVB;
    if (i < T_CKA) {
      size_t e = ((size_t)i * 256 + t) * 8;
      int d = e & 127, h = (e >> 7) & 3, pp = (e >> 9) & 511, l = (e >> 18) & 3, b = (int)(e >> 20);
      const float* sp = p.in[2] + e;
      float4 a = ld_nt4(sp), c = ld_nt4(sp + 4);
      u16* dp = KVL(p.ws, l, 0) + (((size_t)(b * 4 + h) * 1536 + pp) * 128 + d);
      *(uint4*)dp = make_uint4(pack2(a.x, a.y), pack2(a.z, a.w), pack2(c.x, c.y), pack2(c.z, c.w));
      continue;
    }
    i -= T_CKA;
    {
      int wh = i / T_CKB, ii = i % T_CKB;
      size_t e = ((size_t)ii * 256 + t) * 8;
      int d = e & 63, h = (e >> 6) & 1, pp = (e >> 7) & 511, l = (e >> 16) & 3, b = (int)(e >> 18);
      const float* sp = (wh ? p.in[6] : p.in[4]) + e;
      float4 a = ld_nt4(sp), c = ld_nt4(sp + 4);
      u16* dp = KVL(p.ws, l, wh ? 2 : 1) + (((size_t)(b * 2 + h) * 1536 + pp) * 64 + d);
      *(uint4*)dp = make_uint4(pack2(a.x, a.y), pack2(a.z, a.w), pack2(c.x, c.y), pack2(c.z, c.w));
    }
  }
}

DI void norm_phase(const Params& p, int l, int which) {
  const int lane = tid_() & 63;
  const int gw = blockIdx.x * 8 + (tid_() >> 6), nw = gridDim.x * 8;
  for (int row = gw; row < NTOK; row += nw) {
    float v[2][8];
    const bool from_input = (which == 0 && l == 0);
    if (from_input) {
      const float* x = row < NCTX ? p.in[0] + (size_t)row * DM : p.in[1] + (size_t)(row - NCTX) * DM;
#pragma unroll
      for (int c = 0; c < 2; ++c) {
        float4 a = *(const float4*)(x + 8 * lane + 512 * c), b = *(const float4*)(x + 8 * lane + 512 * c + 4);
        v[c][0] = a.x; v[c][1] = a.y; v[c][2] = a.z; v[c][3] = a.w; v[c][4] = b.x; v[c][5] = b.y; v[c][6] = b.z; v[c][7] = b.w;
      }
    } else {
      const u16* x = (const u16*)(p.ws + OFF_X) + (size_t)row * DM;
#pragma unroll
      for (int c = 0; c < 2; ++c) {
        uint4 a = *(const uint4*)(x + 8 * lane + 512 * c);
        v[c][0] = __uint_as_float(a.x << 16); v[c][1] = __uint_as_float(a.x & 0xffff0000u);
        v[c][2] = __uint_as_float(a.y << 16); v[c][3] = __uint_as_float(a.y & 0xffff0000u);
        v[c][4] = __uint_as_float(a.z << 16); v[c][5] = __uint_as_float(a.z & 0xffff0000u);
        v[c][6] = __uint_as_float(a.w << 16); v[c][7] = __uint_as_float(a.w & 0xffff0000u);
      }
    }
    float ss = 0.f;
#pragma unroll
    for (int c = 0; c < 2; ++c)
#pragma unroll
      for (int i = 0; i < 8; ++i) ss += v[c][i] * v[c][i];
    ss = wave_sum(ss);
    const float rs = rsqrtf(ss * (1.f / 1024.f) + 1e-6f);
    if (which == 2) {
      float* o = p.out + (row < NCTX ? O_YP + (size_t)row * DM : O_YS + (size_t)(row - NCTX) * DM);
#pragma unroll
      for (int c = 0; c < 2; ++c) {
        const int col = 8 * lane + 512 * c;
        float4 g0 = *(const float4*)(p.in[29] + col), g1 = *(const float4*)(p.in[29] + col + 4);
        st_nt4(o + col, make_float4(v[c][0] * rs * g0.x, v[c][1] * rs * g0.y, v[c][2] * rs * g0.z, v[c][3] * rs * g0.w));
        st_nt4(o + col + 4, make_float4(v[c][4] * rs * g1.x, v[c][5] * rs * g1.y, v[c][6] * rs * g1.z, v[c][7] * rs * g1.w));
      }
    } else {
      const float* gp = (which == 0 ? p.in[12] : p.in[13]) + l * 1024;
      const float* sh = mod_vec(p, l, row, which == 0 ? 0 : 3);
      const float* sc = mod_vec(p, l, row, which == 0 ? 1 : 4);
      u16* o = (u16*)(p.ws + OFF_HM) + (size_t)row * DM;
#pragma unroll
      for (int c = 0; c < 2; ++c) {
        const int col = 8 * lane + 512 * c;
        float gg[8], s1[8], s0[8];
        *(float4*)&gg[0] = *(const float4*)(gp + col); *(float4*)&gg[4] = *(const float4*)(gp + col + 4);
        *(float4*)&s1[0] = *(const float4*)(sc + col); *(float4*)&s1[4] = *(const float4*)(sc + col + 4);
        *(float4*)&s0[0] = *(const float4*)(sh + col); *(float4*)&s0[4] = *(const float4*)(sh + col + 4);
        float r[8];
#pragma unroll
        for (int i = 0; i < 8; ++i) r[i] = v[c][i] * rs * gg[i] * (1.f + s1[i]) + s0[i];
        *(uint4*)(o + col) = make_uint4(pack2(r[0], r[1]), pack2(r[2], r[3]), pack2(r[4], r[5]), pack2(r[6], r[7]));
      }
    }
  }
}

constexpr int SMEM_BYTES = 8 * 64 * 68 * 4;
enum { EPI_G1 = 0, EPI_G2 = 1, EPI_RES = 2, EPI_SWIGLU = 3 };

struct GemmArgs {
  const u16* A; int lda;
  const u16* Bt; int ldb;
  int K;
  int l;
  int res_chunk;
};

DI void g1_epilogue_wave(const Params& p, int l, int mrow0, int ncol0, const float* ct, int lane);

#define RAW_BARRIER() do { asm volatile("s_waitcnt lgkmcnt(0)" ::: "memory"); __builtin_amdgcn_s_barrier(); } while (0)

template <int EPI, int BN>
DI void gemm_tile(const Params& p, const GemmArgs& g, int m0, int n0, unsigned char* smem) {
  constexpr int NT = BN / 32;
  constexpr int NH = NT / 2;
  constexpr int NI = (256 + BN) / 128;
  constexpr int STAGE = (256 + BN) * 64;
  const int t = tid_(), lane = t & 63, w = t >> 6, wm = w >> 1, wn = w & 1, lc = lane & 15, lq = lane >> 4;
  f32x4 acc[4][NT];
  f32x4 tot[4][NT];
#pragma unroll
  for (int a = 0; a < 4; ++a)
#pragma unroll
    for (int b = 0; b < NT; ++b)
#pragma unroll
      for (int i = 0; i < 4; ++i) { acc[a][b][i] = 0.f; if (EPI == EPI_G2) tot[a][b][i] = 0.f; }

  const int nk = g.K >> 5;
  const int dl_rr = lane >> 2, dl_p = lane & 3;
  const u16* gsrc[NI];
#pragma unroll
  for (int i = 0; i < NI; ++i) {
    const int blk = i * 8 + w, kc = dl_p ^ (dl_rr >> 2);
    if (blk < 16) gsrc[i] = g.A + (size_t)(m0 + blk * 16 + dl_rr) * g.lda + kc * 8;
    else gsrc[i] = g.Bt + (size_t)(n0 + (blk - 16) * 16 + dl_rr) * g.ldb + kc * 8;
  }
  const int dma_off = w * 1024 + lane * 16;
  const unsigned smem_lds = (unsigned)(size_t)smem;
#define DMA_SLICE(J)                                                                                                   \
  {                                                                                                                    \
    unsigned char* bufp_ = smem + ((J) & 3) * STAGE + dma_off;                                                         \
    const size_t koff_ = (size_t)(J) * 32;                                                                             \
    _Pragma("unroll") for (int i_ = 0; i_ < NI; ++i_)                                                                  \
        __builtin_amdgcn_global_load_lds((const unsigned*)(gsrc[i_] + koff_), (LAS unsigned*)(bufp_ + i_ * 8192), 16, 0, 0); \
  }
  __syncthreads();
  DMA_SLICE(0) DMA_SLICE(1) DMA_SLICE(2)
  const unsigned frag_off = lc * 64 + (((lq ^ (lc >> 2)) & 3) << 4);
  const unsigned a_base = smem_lds + (wm * 4) * 1024 + frag_off;
  const unsigned b_base = smem_lds + 16384 + (wn * NT) * 1024 + frag_off;
  bf16x8 a0, a1, a2, a3, c0, c1, c2, c3, bl0, bl1, bl2, bl3, bh0, bh1, bh2, bh3;
#define RD4(ADDR, F0, F1, F2, F3)                                                                                      \
  asm volatile("ds_read_b128 %0, %4\n\tds_read_b128 %1, %4 offset:1024\n\tds_read_b128 %2, %4 offset:2048\n\t"         \
               "ds_read_b128 %3, %4 offset:3072"                                                                       \
               : "=&v"(F0), "=&v"(F1), "=&v"(F2), "=&v"(F3) : "v"(ADDR) : "memory");
#define RD2(ADDR, F0, F1)                                                                                              \
  asm volatile("ds_read_b128 %0, %2\n\tds_read_b128 %1, %2 offset:1024" : "=&v"(F0), "=&v"(F1) : "v"(ADDR) : "memory");
#define RD_B(ADDR, F0, F1, F2, F3) if (NH == 4) { RD4(ADDR, F0, F1, F2, F3) } else { RD2(ADDR, F0, F1) }
#define WT4(F0, F1, F2, F3) asm volatile("s_waitcnt lgkmcnt(0)" : "+v"(F0), "+v"(F1), "+v"(F2), "+v"(F3) :: "memory");
#define WT8(F0, F1, F2, F3, F4, F5, F6, F7)                                                                            \
  asm volatile("s_waitcnt lgkmcnt(0)" : "+v"(F0), "+v"(F1), "+v"(F2), "+v"(F3), "+v"(F4), "+v"(F5), "+v"(F6), "+v"(F7) :: "memory");
#define MF16(A, B, C) __builtin_amdgcn_mfma_f32_16x16x32_bf16((A), (B), (C), 0, 0, 0)
#define MM_HALF(A0, A1, A2, A3, B0, B1, B2, B3, NB)                                                                    \
  acc[0][(NB)] = MF16(A0, B0, acc[0][(NB)]); acc[1][(NB)] = MF16(A1, B0, acc[1][(NB)]);                                \
  acc[2][(NB)] = MF16(A2, B0, acc[2][(NB)]); acc[3][(NB)] = MF16(A3, B0, acc[3][(NB)]);                                \
  acc[0][(NB) + 1] = MF16(A0, B1, acc[0][(NB) + 1]); acc[1][(NB) + 1] = MF16(A1, B1, acc[1][(NB) + 1]);                \
  acc[2][(NB) + 1] = MF16(A2, B1, acc[2][(NB) + 1]); acc[3][(NB) + 1] = MF16(A3, B1, acc[3][(NB) + 1]);                \
  if (NH == 4) {                                                                                                       \
    acc[0][((NB) + 2) % NT] = MF16(A0, B2, acc[0][((NB) + 2) % NT]); acc[1][((NB) + 2) % NT] = MF16(A1, B2, acc[1][((NB) + 2) % NT]); \
    acc[2][((NB) + 2) % NT] = MF16(A2, B2, acc[2][((NB) + 2) % NT]); acc[3][((NB) + 2) % NT] = MF16(A3, B2, acc[3][((NB) + 2) % NT]); \
    acc[0][((NB) + 3) % NT] = MF16(A0, B3, acc[0][((NB) + 3) % NT]); acc[1][((NB) + 3) % NT] = MF16(A1, B3, acc[1][((NB) + 3) % NT]); \
    acc[2][((NB) + 3) % NT] = MF16(A2, B3, acc[2][((NB) + 3) % NT]); acc[3][((NB) + 3) % NT] = MF16(A3, B3, acc[3][((NB) + 3) % NT]); \
  }
#define SLICE_STEP(KT, A0, A1, A2, A3, N0, N1, N2, N3)                                                                 \
  {                                                                                                                    \
    if ((KT) + 2 < nk) { if (NI == 4) asm volatile("s_waitcnt vmcnt(4)" ::: "memory"); else asm volatile("s_waitcnt vmcnt(3)" ::: "memory"); } \
    else asm volatile("s_waitcnt vmcnt(0)" ::: "memory");                                                              \
    WT8(A0, A1, A2, A3, bl0, bl1, bl2, bl3)                                                                            \
    __builtin_amdgcn_s_barrier();                      \
    if ((KT) + 3 < nk) DMA_SLICE((KT) + 3)                                                                             \
    const unsigned so_ = ((KT) & 3) * STAGE;                                                                           \
    RD_B(b_base + so_ + NH * 1024, bh0, bh1, bh2, bh3)                                                                 \
    __builtin_amdgcn_sched_barrier(0);                                           \
    MM_HALF(A0, A1, A2, A3, bl0, bl1, bl2, bl3, 0)                                                                     \
    __builtin_amdgcn_sched_barrier(0);                                                                                 \
    WT4(bh0, bh1, bh2, bh3)                                                                                            \
    __builtin_amdgcn_s_barrier();     \
                                      \
      \
                                                                        \
    MM_PART(A0, A1, A2, A3, bh0, bh1, NH)                                                                              \
    __builtin_amdgcn_sched_barrier(0);                                                                                 \
    if ((KT) + 1 < nk) {                                                                                               \
      const unsigned sn_ = (((KT) + 1) & 3) * STAGE;                                                                   \
      RD4(a_base + sn_, N0, N1, N2, N3)                                                                                \
      RD_B(b_base + sn_, bl0, bl1, bl2, bl3)                                                                           \
    }                                                                                                                  \
    __builtin_amdgcn_sched_barrier(0);                                                                                 \
    MM_REST(A0, A1, A2, A3, bh0, bh1, bh2, bh3, NH)                                                                    \
    __builtin_amdgcn_sched_barrier(0);                                                                                 \
  }
#define MM_PART(A0, A1, A2, A3, B0, B1, NB)                                                                            \
  acc[0][(NB)] = MF16(A0, B0, acc[0][(NB)]); acc[1][(NB)] = MF16(A1, B0, acc[1][(NB)]);                                \
  acc[2][(NB)] = MF16(A2, B0, acc[2][(NB)]); acc[3][(NB)] = MF16(A3, B0, acc[3][(NB)]);                                \
  if (NH == 4) {                                                                                                       \
    acc[0][(NB) + 1] = MF16(A0, B1, acc[0][(NB) + 1]); acc[1][(NB) + 1] = MF16(A1, B1, acc[1][(NB) + 1]);              \
    acc[2][(NB) + 1] = MF16(A2, B1, acc[2][(NB) + 1]); acc[3][(NB) + 1] = MF16(A3, B1, acc[3][(NB) + 1]);              \
  }
#define MM_REST(A0, A1, A2, A3, B0, B1, B2, B3, NB)                                                                    \
  if (NH == 4) {                                                                                                       \
    acc[0][((NB) + 2) % NT] = MF16(A0, B2, acc[0][((NB) + 2) % NT]); acc[1][((NB) + 2) % NT] = MF16(A1, B2, acc[1][((NB) + 2) % NT]); \
    acc[2][((NB) + 2) % NT] = MF16(A2, B2, acc[2][((NB) + 2) % NT]); acc[3][((NB) + 2) % NT] = MF16(A3, B2, acc[3][((NB) + 2) % NT]); \
    acc[0][((NB) + 3) % NT] = MF16(A0, B3, acc[0][((NB) + 3) % NT]); acc[1][((NB) + 3) % NT] = MF16(A1, B3, acc[1][((NB) + 3) % NT]); \
    acc[2][((NB) + 3) % NT] = MF16(A2, B3, acc[2][((NB) + 3) % NT]); acc[3][((NB) + 3) % NT] = MF16(A3, B3, acc[3][((NB) + 3) % NT]); \
  } else {                                                                                                             \
    acc[0][(NB) + 1] = MF16(A0, B1, acc[0][(NB) + 1]); acc[1][(NB) + 1] = MF16(A1, B1, acc[1][(NB) + 1]);              \
    acc[2][(NB) + 1] = MF16(A2, B1, acc[2][(NB) + 1]); acc[3][(NB) + 1] = MF16(A3, B1, acc[3][(NB) + 1]);              \
  }
#ifndef PIPE_BN
#define PIPE_BN 256
#endif
#define SIMPLE_STEP(KT)                                                                                                \
  {                                                                                                                    \
    if ((KT) + 2 < nk) { if (NI == 4) asm volatile("s_waitcnt vmcnt(8)" ::: "memory"); else asm volatile("s_waitcnt vmcnt(6)" ::: "memory"); } \
    else if ((KT) + 1 < nk) { if (NI == 4) asm volatile("s_waitcnt vmcnt(4)" ::: "memory"); else asm volatile("s_waitcnt vmcnt(3)" ::: "memory"); } \
    else asm volatile("s_waitcnt vmcnt(0)" ::: "memory");                                                              \
    RAW_BARRIER();                                                                                                     \
    G2_PREFETCH(KT)                                                                                                    \
    if ((KT) + 3 < nk) DMA_SLICE((KT) + 3)                                                                             \
    const unsigned so_ = ((KT) & 3) * STAGE;                                                                           \
    RD4(a_base + so_, a0, a1, a2, a3)                                                                                  \
    RD_B(b_base + so_, bl0, bl1, bl2, bl3)                                                                             \
    RD_B(b_base + so_ + NH * 1024, bh0, bh1, bh2, bh3)                                                                 \
    WT8(a0, a1, a2, a3, bl0, bl1, bl2, bl3)                                                                            \
    WT4(bh0, bh1, bh2, bh3)                                                                                            \
    MM_HALF(a0, a1, a2, a3, bl0, bl1, bl2, bl3, 0)                                                                     \
    MM_HALF(a0, a1, a2, a3, bh0, bh1, bh2, bh3, NH)                                                                    \
  }
  u32x2 gqr[4][NT];
#pragma unroll
  for (int a = 0; a < 4; ++a)
#pragma unroll
    for (int b = 0; b < NT; ++b) gqr[a][b] = (u32x2){0u, 0u};
#define G2_PREFETCH(KT)                                                                                                \
  if (EPI == EPI_G2 && (((KT) & 15) == 15)) {                                                                          \
    const int seg_ = (KT) >> 4;                                                                                        \
    _Pragma("unroll") for (int a = 0; a < 4; ++a) _Pragma("unroll") for (int b = 0; b < NT; ++b) {                     \
      const int r16 = (m0 + wm * 64 + a * 16) >> 4, c16 = (seg_ * 1024 + n0 + wn * (BN / 2) + b * 16) >> 4;           \
      gqr[a][b] = __builtin_nontemporal_load((const u32x2*)((const u16*)(p.ws + OFF_GH) + ((size_t)(r16 * 192 + c16) * 64 + lane) * 4)); \
    }                                                                                                                  \
  }
  constexpr bool PIPE = true;
  c0 = c1 = c2 = c3 = a0 = a1 = a2 = a3 = bl0 = bl1 = bl2 = bl3 = bh0 = bh1 = bh2 = bh3 = (bf16x8)(0);
  if (PIPE) {
    if (NI == 4) asm volatile("s_waitcnt vmcnt(8)" ::: "memory"); else asm volatile("s_waitcnt vmcnt(6)" ::: "memory");
    RAW_BARRIER();
    RD4(a_base, a0, a1, a2, a3)
    RD_B(b_base, bl0, bl1, bl2, bl3)
    if (w >= 4) __builtin_amdgcn_s_barrier();
  }
  for (int kt = 0; kt < nk; kt += 2) {
    if (PIPE) {
      SLICE_STEP(kt, a0, a1, a2, a3, c0, c1, c2, c3)
      SLICE_STEP(kt + 1, c0, c1, c2, c3, a0, a1, a2, a3)
    } else {
      SIMPLE_STEP(kt)
      SIMPLE_STEP(kt + 1)
    }
    if (EPI == EPI_G2) {
      if (((kt + 1) & 15) == 15) {
        const int seg = (kt + 1) >> 4;
        if (PIPE) {
#pragma unroll
          for (int a = 0; a < 4; ++a)
#pragma unroll
            for (int b = 0; b < NT; ++b) {
              const int r16 = (m0 + wm * 64 + a * 16) >> 4, c16 = (seg * 1024 + n0 + wn * (BN / 2) + b * 16) >> 4;
              gqr[a][b] = __builtin_nontemporal_load((const u32x2*)((const u16*)(p.ws + OFF_GH) + ((size_t)(r16 * 192 + c16) * 64 + lane) * 4));
            }
          WT8(a0, a1, a2, a3, bl0, bl1, bl2, bl3)
        }
#pragma unroll
        for (int a = 0; a < 4; ++a)
#pragma unroll
          for (int b = 0; b < NT; ++b) {
            const int r16 = (m0 + wm * 64 + a * 16) >> 4, c16 = (seg * 1024 + n0 + wn * (BN / 2) + b * 16) >> 4;
            const u32x2 gq_ = gqr[a][b];
            const uint2 gq = make_uint2(gq_[0], gq_[1]);
            tot[a][b][0] += __uint_as_float(gq.x << 16) * acc[a][b][0];
            tot[a][b][1] += __uint_as_float(gq.x & 0xffff0000u) * acc[a][b][1];
            tot[a][b][2] += __uint_as_float(gq.y << 16) * acc[a][b][2];
            tot[a][b][3] += __uint_as_float(gq.y & 0xffff0000u) * acc[a][b][3];
            acc[a][b][0] = 0.f; acc[a][b][1] = 0.f; acc[a][b][2] = 0.f; acc[a][b][3] = 0.f;
          }
      }
    }
  }
  if (PIPE && w < 4) __builtin_amdgcn_s_barrier();
  __syncthreads();

  const int rbase = m0 + wm * 64, cbase = n0 + wn * (BN / 2);
  if (EPI == EPI_G1) {
    if (n0 >= 3072) {
#pragma unroll
      for (int a = 0; a < 4; ++a)
#pragma unroll
        for (int b = 0; b < NT; ++b) {
          const int r16 = (rbase + a * 16) >> 4, c16 = (cbase - 3072 + b * 16) >> 4;
          u16* gp = (u16*)(p.ws + OFF_GH) + ((size_t)(r16 * 192 + c16) * 64 + lane) * 4;
          *(uint2*)gp = make_uint2(pack2(sigmoidf_(acc[a][b][0]), sigmoidf_(acc[a][b][1])), pack2(sigmoidf_(acc[a][b][2]), sigmoidf_(acc[a][b][3])));
        }
    } else {
      float* ct = (float*)smem + w * (64 * 68);
#pragma unroll
      for (int hf = 0; hf < NT / 4; ++hf) {
#pragma unroll
        for (int a = 0; a < 4; ++a)
#pragma unroll
          for (int b = 0; b < 4; ++b)
#pragma unroll
            for (int i = 0; i < 4; ++i)
              ct[(a * 16 + 4 * lq + i) * 68 + b * 16 + lc] = acc[a][(hf * 4 + b) % NT][i];
        g1_epilogue_wave(p, g.l, rbase, cbase + hf * 64, ct, lane);
      }
    }
  } else if (EPI == EPI_G2) {
    u16* o = (u16*)(p.ws + OFF_HM);
    float* ct = (float*)smem + w * (64 * 68);
#pragma unroll
    for (int a = 0; a < 4; ++a)
#pragma unroll
      for (int b = 0; b < NT; ++b)
#pragma unroll
        for (int i = 0; i < 4; ++i) ct[(a * 16 + 4 * lq + i) * 68 + b * 16 + lc] = tot[a][b][i];
#pragma unroll 8
    for (int it = lane; it < 512; it += 64) {
      const int rl = it >> 3, c8 = (it & 7) * 8;
      float4 v0 = *(const float4*)(ct + rl * 68 + c8), v1 = *(const float4*)(ct + rl * 68 + c8 + 4);
      *(uint4*)(o + (size_t)(rbase + rl) * DM + cbase + c8) = make_uint4(pack2(v0.x, v0.y), pack2(v0.z, v0.w), pack2(v1.x, v1.y), pack2(v1.z, v1.w));
    }
  } else if (EPI == EPI_RES) {
    u16* xo = (u16*)(p.ws + OFF_X);
    const bool from_input = (g.res_chunk == 2) && g.l == 0;
    float* ct = (float*)smem + w * (64 * 68);
#pragma unroll
    for (int a = 0; a < 4; ++a)
#pragma unroll
      for (int b = 0; b < NT; ++b)
#pragma unroll
        for (int i = 0; i < 4; ++i) ct[(a * 16 + 4 * lq + i) * 68 + b * 16 + lc] = acc[a][b][i];
#pragma unroll 8
    for (int it = lane; it < 512; it += 64) {
      const int rl = it >> 3, c8 = (it & 7) * 8;
      const int row = rbase + rl, col = cbase + c8;
      float4 v0 = *(const float4*)(ct + rl * 68 + c8), v1 = *(const float4*)(ct + rl * 68 + c8 + 4);
      const float* gate = mod_vec(p, g.l, row, g.res_chunk) + col;
      float4 g0 = *(const float4*)gate, g1 = *(const float4*)(gate + 4);
      float x[8];
      if (from_input) {
        const float* xin = (row < NCTX ? p.in[0] + (size_t)row * DM : p.in[1] + (size_t)(row - NCTX) * DM) + col;
        float4 a0 = *(const float4*)xin, a1 = *(const float4*)(xin + 4);
        x[0] = a0.x; x[1] = a0.y; x[2] = a0.z; x[3] = a0.w; x[4] = a1.x; x[5] = a1.y; x[6] = a1.z; x[7] = a1.w;
      } else {
        uint4 xb = *(const uint4*)(xo + (size_t)row * DM + col);
        x[0] = __uint_as_float(xb.x << 16); x[1] = __uint_as_float(xb.x & 0xffff0000u);
        x[2] = __uint_as_float(xb.y << 16); x[3] = __uint_as_float(xb.y & 0xffff0000u);
        x[4] = __uint_as_float(xb.z << 16); x[5] = __uint_as_float(xb.z & 0xffff0000u);
        x[6] = __uint_as_float(xb.w << 16); x[7] = __uint_as_float(xb.w & 0xffff0000u);
      }
      x[0] += g0.x * v0.x; x[1] += g0.y * v0.y; x[2] += g0.z * v0.z; x[3] += g0.w * v0.w;
      x[4] += g1.x * v1.x; x[5] += g1.y * v1.y; x[6] += g1.z * v1.z; x[7] += g1.w * v1.w;
      *(uint4*)(xo + (size_t)row * DM + col) = make_uint4(pack2(x[0], x[1]), pack2(x[2], x[3]), pack2(x[4], x[5]), pack2(x[6], x[7]));
    }
  } else if (EPI == EPI_SWIGLU) {
    u16* o = (u16*)(p.ws + OFF_GH);
    float* ct = (float*)smem + w * (64 * 68);
#pragma unroll
    for (int a = 0; a < 4; ++a)
#pragma unroll
      for (int b = 0; b < NT / 2; ++b)
#pragma unroll
        for (int i = 0; i < 4; ++i) ct[(a * 16 + 4 * lq + i) * 68 + b * 16 + lc] = siluf_(acc[a][b][i]) * acc[a][(b + NT / 2) % NT][i];
    const int colb0 = (n0 >> 8) * 128 + wn * 64;
#pragma unroll 8
    for (int it = lane; it < 512; it += 64) {
      const int rl = it >> 3, c8 = (it & 7) * 8;
      float4 v0 = *(const float4*)(ct + rl * 68 + c8), v1 = *(const float4*)(ct + rl * 68 + c8 + 4);
      *(uint4*)(o + (size_t)(rbase + rl) * DFF + colb0 + c8) = make_uint4(pack2(v0.x, v0.y), pack2(v0.z, v0.w), pack2(v1.x, v1.y), pack2(v1.z, v1.w));
    }
  }
}

DI void g1_epilogue_wave(const Params& p, int l, int mrow0, int ncol0, const float* ct, int lane) {
  const bool ctx = mrow0 < NCTX;
  int kind;
  int br;
  int nrel;
  const int n0 = ncol0;
  if (n0 < 512) { kind = 0; br = 0; nrel = n0; }
  else if (n0 < 1024) { kind = 1; br = 0; nrel = n0 - 512; }
  else if (n0 < 1536) { kind = 2; br = 0; nrel = n0 - 1024; }
  else if (n0 < 2048) { kind = 0; br = 1; nrel = n0 - 1536; }
  else if (n0 < 2176) { kind = 1; br = 1; nrel = n0 - 2048; }
  else if (n0 < 2304) { kind = 2; br = 1; nrel = n0 - 2176; }
  else if (n0 < 2816) { kind = 0; br = 2; nrel = n0 - 2304; }
  else if (n0 < 2944) { kind = 1; br = 2; nrel = n0 - 2816; }
  else { kind = 2; br = 2; nrel = n0 - 2944; }

  if (kind < 2) {
    const int j = lane & 7, grp = lane >> 3;
    const float* cosT = (const float*)(p.ws + OFF_ROPE);
    const float* sinT = cosT + 1024 * 32;
    const float* gn = (kind == 0 ? p.in[20] : p.in[21]) + l * 64;
    for (int rl = grp; rl < 64; rl += 8) {
      const int row = mrow0 + rl;
      const float* cp = ct + rl * 68;
      float4 lo = *(const float4*)(cp + 4 * j), hi = *(const float4*)(cp + 32 + 4 * j);
      if (br == 1) {
        float ss = lo.x * lo.x + lo.y * lo.y + lo.z * lo.z + lo.w * lo.w + hi.x * hi.x + hi.y * hi.y + hi.z * hi.z + hi.w * hi.w;
        ss += __shfl_xor(ss, 1); ss += __shfl_xor(ss, 2); ss += __shfl_xor(ss, 4);
        float rs = rsqrtf(ss * (1.f / 64.f) + 1e-6f);
        float4 g0 = *(const float4*)(gn + 4 * j), g1 = *(const float4*)(gn + 32 + 4 * j);
        lo.x *= rs * g0.x; lo.y *= rs * g0.y; lo.z *= rs * g0.z; lo.w *= rs * g0.w;
        hi.x *= rs * g1.x; hi.y *= rs * g1.y; hi.z *= rs * g1.z; hi.w *= rs * g1.w;
      }
      if (!ctx) {
        const int pos = (row - NCTX) & 1023;
        float4 c = *(const float4*)(cosT + pos * 32 + 4 * j), sn = *(const float4*)(sinT + pos * 32 + 4 * j);
        float4 nlo = make_float4(lo.x * c.x - hi.x * sn.x, lo.y * c.y - hi.y * sn.y, lo.z * c.z - hi.z * sn.z, lo.w * c.w - hi.w * sn.w);
        float4 nhi = make_float4(hi.x * c.x + lo.x * sn.x, hi.y * c.y + lo.y * sn.y, hi.z * c.z + lo.z * sn.z, hi.w * c.w + lo.w * sn.w);
        lo = nlo; hi = nhi;
      }
      const int nc = nrel;
      if (kind == 0) {
        u16* q = (u16*)(p.ws + OFF_Q) + (size_t)row * 1536 + br * 512 + nc;
        *(uint2*)(q + 4 * j) = make_uint2(pack2(lo.x * 0.125f, lo.y * 0.125f), pack2(lo.z * 0.125f, lo.w * 0.125f));
        *(uint2*)(q + 32 + 4 * j) = make_uint2(pack2(hi.x * 0.125f, hi.y * 0.125f), pack2(hi.z * 0.125f, hi.w * 0.125f));
      } else {
        const int hd = (br == 0) ? 128 : 64, nh = (br == 0) ? 4 : 2;
        const int head = nc / hd, d = nc % hd;
        u16* kd;
        if (ctx) {
          const int b = row >> 8, key = row & 255;
          kd = KVC(p.ws, br) + ((size_t)(b * nh + head) * 256 + key) * hd + d;
          float* od = p.out + (br == 0 ? O_AK : (br == 1 ? O_BK : O_CK)) + ((size_t)((b * 4 + l) * 256 + key) * nh + head) * hd + d;
          st_nt4(od + 4 * j, lo);
          st_nt4(od + 32 + 4 * j, hi);
        } else {
          const int b = (row - NCTX) >> 10, pos = (row - NCTX) & 1023;
          kd = KVL(p.ws, l, br) + ((size_t)(b * nh + head) * 1536 + 512 + pos) * hd + d;
        }
        *(uint2*)(kd + 4 * j) = make_uint2(pack2(lo.x, lo.y), pack2(lo.z, lo.w));
        *(uint2*)(kd + 32 + 4 * j) = make_uint2(pack2(hi.x, hi.y), pack2(hi.z, hi.w));
      }
    }
  } else {
    const int nrows = (br == 0) ? 512 : 128;
    for (int it = lane; it < 256; it += 64) {
      const int gq = it & 3, c = it >> 2;
      const int row0 = mrow0 + gq * 16;
      float v[16];
#pragma unroll
      for (int i = 0; i < 16; ++i) v[i] = ct[(gq * 16 + i) * 68 + c];
      u16* vd;
      if (ctx) {
        const int b = row0 >> 8, key = row0 & 255;
        vd = KVC(p.ws, 3 + br) + ((size_t)b * nrows + nrel + c) * 256 + key;
      } else {
        const int b = (row0 - NCTX) >> 10, pos = (row0 - NCTX) & 1023;
        vd = KVL(p.ws, l, 3 + br) + ((size_t)b * nrows + nrel + c) * 1536 + 512 + pos;
      }
      *(uint4*)vd = make_uint4(pack2(v[0], v[1]), pack2(v[2], v[3]), pack2(v[8], v[9]), pack2(v[10], v[11]));
      *(uint4*)(vd + 8) = make_uint4(pack2(v[4], v[5]), pack2(v[6], v[7]), pack2(v[12], v[13]), pack2(v[14], v[15]));
    }
    if (ctx) {
      float* ob = p.out + (br == 0 ? O_AV : (br == 1 ? O_BV : O_CV));
      for (int it = lane; it < 1024; it += 64) {
        const int rl = it >> 4, c4 = (it & 15) * 4;
        const int row = mrow0 + rl, b = row >> 8, key = row & 255;
        float4 v = *(const float4*)(ct + rl * 68 + c4);
        st_nt4(ob + (size_t)((b * 4 + l) * 256 + key) * nrows + nrel + c4, v);
      }
    }
  }
}

template <int EPI, int BN>
DI void gemm_phase(const Params& p, const GemmArgs& g, int ntn, unsigned char* smem) {
  if (gridDim.x == 256) {
    const int xcd = blockIdx.x & 7, j = blockIdx.x >> 3;
    for (int il = j; il < 4 * ntn; il += 32) {
      const int mt = 4 * xcd + (il & 3), nt = il >> 2;
      gemm_tile<EPI, BN>(p, g, mt * 256, nt * BN, smem);
    }
  } else {
    const int ntiles = 32 * ntn;
    for (int tile = blockIdx.x; tile < ntiles; tile += gridDim.x) {
      const int mt = tile / ntn, nt = tile % ntn;
      gemm_tile<EPI, BN>(p, g, mt * 256, nt * BN, smem);
    }
  }
}

constexpr float LOG2E = 1.4426950408889634f;
constexpr int N_ATT_ITEMS = 768;
constexpr int VT_PITCH = 144;

DI void load_q(bf16x8 (&qf)[4], const u16* Q, int row, int coloff, int h) {
  const u16* qp = Q + (size_t)row * 1536 + coloff + 8 * h;
#pragma unroll
  for (int s = 0; s < 4; ++s) qf[s] = __builtin_nontemporal_load((const bf16x8*)(qp + 16 * s));
}

template <int DV, int KD>
DI void attn_item(f32x16 (&o)[DV / 32], unsigned char* smem, const u16* __restrict__ Kg, const u16* __restrict__ Vg, int nkeys,
                  int n_tiles, int band_t0, const bf16x8 (&qf)[4], int koff, bool has_band, int qpos, float m_init, float l_init) {
  constexpr int KPITCH = KD * 2 + 16;
  constexpr int KBYTES = 64 * KPITCH;
  constexpr int VBYTES = DV * VT_PITCH;
  constexpr int BUF = KBYTES + VBYTES;
  constexpr int KCH = KD / 8;
  constexpr int NK = KD / 64;
  constexpr int NV = DV / 64;
  const int t = tid_(), lane = t & 63, r = lane & 31, h = lane >> 5;
  const int krow = t / KCH, kkc = t % KCH;
  const int vrow = t >> 3, vkc = t & 7;
  const u16* kgp = Kg + (size_t)krow * KD + kkc * 8;
  const u16* vgp = Vg + (size_t)vrow * nkeys + vkc * 8;
  const int klds = krow * KPITCH + kkc * 16;
  const int vlds = KBYTES + vrow * VT_PITCH + vkc * 16;
  uint4 k0, k1, v0, v1;
  k1 = v1 = make_uint4(0, 0, 0, 0);
#define ATT_TILE(i) ((i) < 8 || !has_band ? (i) : 8 + band_t0 + (i) - 8)
#define ATT_GLOAD(TI)                                                                   \
  {                                                                                     \
    const size_t key0_ = (size_t)(TI) * 64;                                             \
    k0 = *(const uint4*)(kgp + key0_ * KD);                                             \
    if (NK == 2) k1 = *(const uint4*)(kgp + (key0_ + 32) * KD);                         \
    v0 = *(const uint4*)(vgp + key0_);                                                  \
    if (NV == 2) v1 = *(const uint4*)(vgp + key0_ + (size_t)64 * nkeys);                \
  }
#define ATT_LSTORE(DST)                                                                 \
  {                                                                                     \
    *(uint4*)((DST) + klds) = k0;                                                       \
    if (NK == 2) *(uint4*)((DST) + klds + 32 * KPITCH) = k1;                            \
    *(uint4*)((DST) + vlds) = v0;                                                       \
    if (NV == 2) *(uint4*)((DST) + vlds + 64 * VT_PITCH) = v1;                          \
  }
  float m = m_init, l = l_init;
#pragma unroll
  for (int dt = 0; dt < DV / 32; ++dt)
#pragma unroll
    for (int i = 0; i < 16; ++i) o[dt][i] = 0.f;

  ATT_GLOAD(ATT_TILE(0))
  __syncthreads();
  ATT_LSTORE(smem)
  __syncthreads();
  for (int it = 0; it < n_tiles; ++it) {
    const int cur = it & 1;
    const int tile = ATT_TILE(it);
    if (it + 1 < n_tiles) ATT_GLOAD(ATT_TILE(it + 1))
    const unsigned char* kb = smem + cur * BUF + r * KPITCH + (koff + 8 * h) * 2;
    const unsigned char* vb = smem + cur * BUF + KBYTES + r * VT_PITCH + 16 * h;
    f32x16 S0, S1;
#pragma unroll
    for (int i = 0; i < 16; ++i) { S0[i] = 0.f; S1[i] = 0.f; }
#pragma unroll
    for (int s = 0; s < 4; ++s) {
      bf16x8 ka = *(const bf16x8*)(kb + 32 * s);
      bf16x8 kc = *(const bf16x8*)(kb + 32 * KPITCH + 32 * s);
      S0 = MFMA32(ka, qf[s], S0);
      S1 = MFMA32(kc, qf[s], S1);
    }
    if (has_band && it >= 8) {
      const int kbase = (tile - 8) * 64 - qpos;
#pragma unroll
      for (int i = 0; i < 16; ++i) {
        int d0 = kbase + crow(i, h), d1 = d0 + 32;
        if (d0 < -128 || d0 > 128) S0[i] = -1e30f;
        if (d1 < -128 || d1 > 128) S1[i] = -1e30f;
      }
    }
    float mx = fmaxf(S0[0], S1[0]);
#pragma unroll
    for (int i = 1; i < 16; ++i) mx = __builtin_fmaxf(__builtin_fmaxf(mx, S0[i]), S1[i]);
    mx = fmaxf(mx, __shfl_xor(mx, 32));
    const float mn = fmaxf(m, mx);
    const float mb = mn * LOG2E;
    float ps;
    {
      const f2_t sc2 = {LOG2E, LOG2E}, nb2 = {-mb, -mb};
      f2_t ps2 = {0.f, 0.f};
#pragma unroll
      for (int i = 0; i < 8; ++i) {
        f2_t a = {S0[2 * i], S0[2 * i + 1]}, b = {S1[2 * i], S1[2 * i + 1]};
        a = __builtin_elementwise_fma(a, sc2, nb2);
        b = __builtin_elementwise_fma(b, sc2, nb2);
        a.x = __builtin_amdgcn_exp2f(a.x); a.y = __builtin_amdgcn_exp2f(a.y);
        b.x = __builtin_amdgcn_exp2f(b.x); b.y = __builtin_amdgcn_exp2f(b.y);
        S0[2 * i] = a.x; S0[2 * i + 1] = a.y; S1[2 * i] = b.x; S1[2 * i + 1] = b.y;
        ps2 += a; ps2 += b;
      }
      ps = ps2.x + ps2.y;
    }
    if (__any(mn != m)) {
      const float alpha = __builtin_amdgcn_exp2f((m - mn) * LOG2E);
      l *= alpha;
#pragma unroll
      for (int dt = 0; dt < DV / 32; ++dt)
#pragma unroll
        for (int i = 0; i < 16; ++i) o[dt][i] *= alpha;
      m = mn;
    }
    l += ps;
    bf16x8 pf0, pf1, pf2, pf3;
    {
      uint4 u;
      u = make_uint4(pack2(S0[0], S0[1]), pack2(S0[2], S0[3]), pack2(S0[4], S0[5]), pack2(S0[6], S0[7])); pf0 = __builtin_bit_cast(bf16x8, u);
      u = make_uint4(pack2(S0[8], S0[9]), pack2(S0[10], S0[11]), pack2(S0[12], S0[13]), pack2(S0[14], S0[15])); pf1 = __builtin_bit_cast(bf16x8, u);
      u = make_uint4(pack2(S1[0], S1[1]), pack2(S1[2], S1[3]), pack2(S1[4], S1[5]), pack2(S1[6], S1[7])); pf2 = __builtin_bit_cast(bf16x8, u);
      u = make_uint4(pack2(S1[8], S1[9]), pack2(S1[10], S1[11]), pack2(S1[12], S1[13]), pack2(S1[14], S1[15])); pf3 = __builtin_bit_cast(bf16x8, u);
    }
#pragma unroll
    for (int dt = 0; dt < DV / 32; ++dt) {
      const unsigned char* vp = vb + dt * 32 * VT_PITCH;
      o[dt] = MFMA32(*(const bf16x8*)(vp), pf0, o[dt]);
      o[dt] = MFMA32(*(const bf16x8*)(vp + 32), pf1, o[dt]);
      o[dt] = MFMA32(*(const bf16x8*)(vp + 64), pf2, o[dt]);
      o[dt] = MFMA32(*(const bf16x8*)(vp + 96), pf3, o[dt]);
    }
    if (it + 1 < n_tiles) {
      unsigned char* dst = smem + (cur ^ 1) * BUF;
      ATT_LSTORE(dst)
    }
    __syncthreads();
  }
  const float lt = l + __shfl_xor(l, 32);
  const float inv = 1.f / lt;
#pragma unroll
  for (int dt = 0; dt < DV / 32; ++dt)
#pragma unroll
    for (int i = 0; i < 16; ++i) o[dt][i] *= inv;
}

DI void attn_phase(const Params& p, int l, int ph, unsigned char* smem) {
  __shared__ int s_item;
  const int t = tid_(), lane = t & 63, wv = t >> 6, r = lane & 31, h = lane >> 5;
  const u16* Q = (const u16*)(p.ws + OFF_Q);
  u16* AO = (u16*)(p.ws + OFF_ATT);
  unsigned* ctr = (unsigned*)(p.ws + OFF_BAR + 14336) + ph;
  float lam;
  {
    float a = p.in[15][l * 64 + lane] * p.in[16][l * 64 + lane];
    float b = p.in[17][l * 64 + lane] * p.in[18][l * 64 + lane];
    a = wave_sum(a); b = wave_sum(b);
    lam = __expf(a) - __expf(b) + p.lam_init[l];
  }
  const float one_m_li = 1.f - p.lam_init[l];
  const bool static_first = gridDim.x == 256;
  bool first = true;
  for (;;) {
    __syncthreads();
    if (t == 0) {
      if (first && static_first) {
        const int xcd = blockIdx.x & 7, j = blockIdx.x >> 3;
        if (j < 16) { const int g = 2 * xcd + (j >> 3); s_item = (g >> 2) * 32 + (g & 3) * 8 + (j & 7); }
        else s_item = 128 + (xcd >> 1) * 32 + (xcd & 1) * 16 + (j - 16);
      } else {
        s_item = (static_first ? 256 : 0) + (int)atomicAdd(ctr, 1u);
      }
    }
    first = false;
    __syncthreads();
    const int it = s_item;
    if (it >= N_ATT_ITEMS) break;
    const int cls = it >> 7, i = it & 127;
    const int lat = cls < 3, br = cls % 3;
    const int nkeys = lat ? 1536 : 256;
    if (br == 0) {
      int b, hd, qb;
      if (lat) { b = i >> 5; hd = (i >> 3) & 3; qb = i & 7; } else { b = i >> 3; hd = (i >> 1) & 3; qb = i & 1; }
      const int pass = wv >> 2;
      const int row = (lat ? NCTX + b * 1024 : b * 256) + qb * 128 + (wv & 3) * 32 + r;
      const u16* Kb = (lat ? KVL(p.ws, l, 0) : KVC(p.ws, 0)) + (size_t)(b * 4 + hd) * nkeys * 128;
      const u16* Vb = (lat ? KVL(p.ws, l, 3) : KVC(p.ws, 3)) + (size_t)(b * 4 + hd) * 128 * nkeys;
      bf16x8 qf[4];
      load_q(qf, Q, row, hd * 128 + pass * 64, h);
      f32x16 o[4];
      attn_item<128, 128>(o, smem, Kb, Vb, nkeys, nkeys / 64, 0, qf, pass * 64, false, 0, -1e30f, 0.f);
      float* stash = (float*)smem + (wv & 3) * 4096;
      if (pass == 1) {
#pragma unroll
        for (int dt = 0; dt < 4; ++dt)
#pragma unroll
          for (int q = 0; q < 16; ++q) stash[(dt * 16 + q) * 64 + lane] = o[dt][q];
      }
      __syncthreads();
      if (pass == 0) {
        float ss = 0.f;
#pragma unroll
        for (int dt = 0; dt < 4; ++dt)
#pragma unroll
          for (int q = 0; q < 16; ++q) {
            float v = o[dt][q] - lam * stash[(dt * 16 + q) * 64 + lane];
            o[dt][q] = v;
            ss += v * v;
          }
        ss += __shfl_xor(ss, 32);
        const float rs = rsqrtf(ss * (1.f / 128.f) + 1e-6f) * one_m_li;
        const float* sg = p.in[19] + l * 128;
        u16* tl = (u16*)(smem + 65536 + wv * 8704);
#pragma unroll
        for (int dt = 0; dt < 4; ++dt)
#pragma unroll
          for (int g4 = 0; g4 < 4; ++g4) {
            const int d = dt * 32 + 8 * g4 + 4 * h;
            float4 gg = *(const float4*)(sg + d);
            unsigned w0 = pack2(o[dt][4 * g4] * rs * gg.x, o[dt][4 * g4 + 1] * rs * gg.y);
            unsigned w1 = pack2(o[dt][4 * g4 + 2] * rs * gg.z, o[dt][4 * g4 + 3] * rs * gg.w);
            *(uint2*)(tl + r * 136 + d) = make_uint2(w0, w1);
          }
        u16* ob = AO + (size_t)(row - r) * 1536 + hd * 128;
#pragma unroll
        for (int q = 0; q < 8; ++q) {
          const int itx = lane + 64 * q, rr = itx >> 4, c8 = (itx & 15) * 8;
          *(uint4*)(ob + (size_t)rr * 1536 + c8) = *(const uint4*)(tl + rr * 136 + c8);
        }
      }
    } else {
      int b, kvh, qg;
      if (lat) { b = i >> 5; kvh = (i >> 4) & 1; qg = i & 15; } else { b = i >> 3; kvh = (i >> 2) & 1; qg = i & 3; }
      const int hd = kvh * 4 + (wv & 3), qsub = wv >> 2;
      const int row = (lat ? NCTX + b * 1024 : b * 256) + qg * 64 + qsub * 32 + r;
      const u16* Kb = (lat ? KVL(p.ws, l, br) : KVC(p.ws, br)) + (size_t)(b * 2 + kvh) * nkeys * 64;
      const u16* Vb = (lat ? KVL(p.ws, l, 3 + br) : KVC(p.ws, 3 + br)) + (size_t)(b * 2 + kvh) * 64 * nkeys;
      bf16x8 qf[4];
      load_q(qf, Q, row, br * 512 + hd * 64, h);
      f32x16 o[2];
      const bool band = (br == 2) && lat;
      int n_tiles = nkeys / 64, t0 = 0;
      if (band) {
        const int q0 = qg * 64;
        t0 = (q0 - 128) < 0 ? 0 : (q0 - 128) >> 6;
        int t1 = (q0 + 191) >> 6; if (t1 > 15) t1 = 15;
        n_tiles = 8 + (t1 - t0 + 1);
      }
      const float m0 = (br == 2) ? p.in[22][l * 8 + hd] : -1e30f;
      const float l0 = (br == 2 && h == 0) ? 1.f : 0.f;
      attn_item<64, 64>(o, smem, Kb, Vb, nkeys, n_tiles, t0, qf, 0, band, qg * 64 + qsub * 32 + r, m0, l0);
      u16* tl = (u16*)(smem + 65536 + wv * 8704);
#pragma unroll
      for (int dt = 0; dt < 2; ++dt)
#pragma unroll
        for (int g4 = 0; g4 < 4; ++g4) {
          const int d = dt * 32 + 8 * g4 + 4 * h;
          unsigned w0 = pack2(o[dt][4 * g4], o[dt][4 * g4 + 1]);
          unsigned w1 = pack2(o[dt][4 * g4 + 2], o[dt][4 * g4 + 3]);
          *(uint2*)(tl + r * 72 + d) = make_uint2(w0, w1);
        }
      u16* ob = AO + (size_t)(row - r) * 1536 + br * 512 + hd * 64;
#pragma unroll
      for (int q = 0; q < 4; ++q) {
        const int itx = lane + 64 * q, rr = itx >> 3, c8 = (itx & 7) * 8;
        *(uint4*)(ob + (size_t)rr * 1536 + c8) = *(const uint4*)(tl + rr * 72 + c8);
      }
    }
  }
}

#define XB_TMO      128
#define XB_XCNT(j)  (256  + 64 * (j))
#define XB_XSUB(j)  (1280 + 64 * (j))
#define XB_XGEN(j)  (2304 + 64 * (j))
#define XB_TOP      3328
#define XB_TOPGEN   3392
#define XCD_BAR_WORDS 3456
#define XB_SPIN_CAP (1u << 22)
DI unsigned xb_ld(unsigned* p) { return __hip_atomic_load(p, __ATOMIC_RELAXED, __HIP_MEMORY_SCOPE_AGENT); }
DI unsigned xb_add(unsigned* p, unsigned v) { return __hip_atomic_fetch_add(p, v, __ATOMIC_RELAXED, __HIP_MEMORY_SCOPE_AGENT); }
DI unsigned xb_xcc_id() { return (unsigned)__builtin_amdgcn_s_getreg((3 << 11) | 20) & 0xFu; }
#define XB_SPIN(cond, bar) do { unsigned _sp = 0; while (cond) { __builtin_amdgcn_s_sleep(1); \
    if ((++_sp & 255u) == 0u) { if (xb_ld(&(bar)[XB_TMO])) break; if (_sp > XB_SPIN_CAP) { atomicAdd(&(bar)[XB_TMO], 1u); break; } } } } while (0)
struct XcdBarrier { unsigned* bar; unsigned x; volatile LAS unsigned* st; };
DI XcdBarrier xcd_barrier_post(unsigned* bar, volatile LAS unsigned* st) {
  XcdBarrier b; b.bar = bar; b.x = xb_xcc_id(); b.st = st;
  if (threadIdx.x == 0) (void)xb_add(&bar[XB_XCNT(b.x)], 1u);
  return b;
}
DI void xcd_barrier_complete(unsigned* bar, unsigned x, unsigned& nloc, unsigned& nx) {
  const unsigned G = gridDim.x * gridDim.y * gridDim.z;
  unsigned sum, cnt, mine, sp = 0u;
  for (;;) {
    sum = 0u; cnt = 0u; mine = 0u;
#pragma unroll
    for (unsigned j = 0; j < 16; ++j) { const unsigned c = xb_ld(&bar[XB_XCNT(j)]); sum += c; cnt += (c > 0u) ? 1u : 0u; mine = (j == x) ? c : mine; }
    if (sum == G) break;
    __builtin_amdgcn_s_sleep(1);
    if ((++sp & 255u) == 0u) { if (xb_ld(&bar[XB_TMO])) break; if (sp > XB_SPIN_CAP) { atomicAdd(&bar[XB_TMO], 1u); break; } }
  }
  nloc = mine > 0u ? mine : 1u; nx = cnt > 0u ? cnt : 1u;
}
DI void xcd_barrier(const XcdBarrier& b) {
  asm volatile("s_waitcnt vmcnt(0)" ::: "memory");
  __syncthreads();
  if (threadIdx.x == 0) {
    unsigned* bar = b.bar;
    __builtin_amdgcn_s_waitcnt(0);
    unsigned nloc = b.st[0], nx = b.st[1];
    if (nloc == 0u) { xcd_barrier_complete(bar, b.x, nloc, nx); b.st[0] = nloc; b.st[1] = nx; }
    const unsigned old = xb_add(&bar[XB_XSUB(b.x)], 1u);
    const unsigned gen = old / nloc;
    if (old + 1u == (gen + 1u) * nloc) {
      __builtin_amdgcn_fence(__ATOMIC_RELEASE, "agent");
      asm volatile("s_waitcnt vmcnt(0)" ::: "memory");
      const unsigned og = xb_add(&bar[XB_TOP], 1u);
      const unsigned tg = og / nx;
      if (og + 1u == (tg + 1u) * nx) xb_add(&bar[XB_TOPGEN], 1u);
      else XB_SPIN(xb_ld(&bar[XB_TOPGEN]) == tg, bar);
      __builtin_amdgcn_fence(__ATOMIC_ACQUIRE, "agent");
      xb_add(&bar[XB_XGEN(b.x)], 1u);
      asm volatile("s_waitcnt vmcnt(0)" ::: "memory");
    } else {
      XB_SPIN(xb_ld(&bar[XB_XGEN(b.x)]) == gen, bar);
      __builtin_amdgcn_fence(__ATOMIC_ACQUIRE, "agent");
      asm volatile("s_waitcnt vmcnt(0)" ::: "memory");
    }
  }
  __syncthreads();
}

__global__ void __launch_bounds__(512, 2) fwd_megakernel(Params p) {
  __shared__ __attribute__((aligned(16))) unsigned char smem[SMEM_BYTES];
  __shared__ uint4 xb_words;
  cg::grid_group grid = cg::this_grid();
  if (threadIdx.x == 0) xb_words = make_uint4(0u, 0u, 0u, 0u);
  __syncthreads();
  XcdBarrier xb = xcd_barrier_post((unsigned*)(p.ws + OFF_BAR), (volatile LAS unsigned*)&xb_words);
  for (int ph = p.ph_lo; ph < p.ph_hi; ++ph) {
    if (ph > p.ph_lo) {
      if (p.ph_hi > 4096) grid.sync();
      xcd_barrier(xb);
    }
    if (ph == 0) { pre_phase(p, (float*)smem); continue; }
    if (ph == NPH - 1) { norm_phase(p, 0, 2); continue; }
    const int l = (ph - 1) / SEQ_N, sub = (int)((SEQ_PACK >> (4 * ((ph - 1) % SEQ_N))) & 15ull);
    GemmArgs g;
    g.l = l; g.res_chunk = 0;
    switch (sub) {
      case 0: norm_phase(p, l, 0); break;
#ifndef DIS1
      case 1:
        g.A = (const u16*)(p.ws + OFF_HM); g.lda = DM; g.Bt = Wt_in(p.ws, l); g.ldb = DM; g.K = DM;
        gemm_phase<EPI_G1, 256>(p, g, DIN / 256, smem);
        break;
#endif
#ifndef DIS2
      case 2: attn_phase(p, l, ph, smem); break;
#endif
#ifndef DIS3
      case 3:
        g.A = (const u16*)(p.ws + OFF_ATT); g.lda = 1536; g.Bt = Wt_br(p.ws, l); g.ldb = 1536; g.K = 1536;
        gemm_phase<EPI_G2, 128>(p, g, DM / 128, smem);
        break;
#endif
      case 4:
        g.A = (const u16*)(p.ws + OFF_HM); g.lda = DM; g.Bt = Wt_out(p.ws, l); g.ldb = DM; g.K = DM; g.res_chunk = 2;
        gemm_phase<EPI_RES, 128>(p, g, DM / 128, smem);
        break;
      case 5: norm_phase(p, l, 1); break;
      case 6:
        g.A = (const u16*)(p.ws + OFF_HM); g.lda = DM; g.Bt = Wt_f1(p.ws, l); g.ldb = DM; g.K = DM;
        gemm_phase<EPI_SWIGLU, 256>(p, g, 2 * DFF / 256, smem);
        break;
      default:
        g.A = (const u16*)(p.ws + OFF_GH); g.lda = DFF; g.Bt = Wt_f2(p.ws, l); g.ldb = DFF; g.K = DFF; g.res_chunk = 5;
        gemm_phase<EPI_RES, 128>(p, g, DM / 128, smem);
        break;
    }
  }
}

extern "C" void kernel_launch(void* const* d_in, const int* in_sizes, int n_in, void* d_out, int out_size, void* d_ws, size_t ws_size,
                              hipStream_t stream) {
  static int grid_blocks = 0;
  if (!grid_blocks) {
    int dev = 0, cus = 0, per_cu = 0;
    hipGetDevice(&dev);
    hipDeviceGetAttribute(&cus, hipDeviceAttributeMultiprocessorCount, dev);
    hipOccupancyMaxActiveBlocksPerMultiprocessor(&per_cu, fwd_megakernel, 512, 0);
    if (per_cu < 1) per_cu = 1;
    if (per_cu > 1) per_cu = 1;
    grid_blocks = cus * per_cu;
    if (ws_size < WS_END) fprintf(stderr, "kernel_launch: workspace too small: %zu < %zu\n", ws_size, (size_t)WS_END);
  }
  Params p{};
  for (int i = 0; i < 30; ++i) p.in[i] = (const float*)d_in[i];
  p.out = (float*)d_out;
  p.ws = (unsigned char*)d_ws;
  for (int l = 0; l < 4; ++l) p.lam_init[l] = (float)(0.8 - 0.6 * exp(-0.3 * l));
  hipMemsetAsync((unsigned char*)d_ws + OFF_BAR, 0, 16384, stream);
#if ONE_LAUNCH
  p.ph_lo = 0; p.ph_hi = NPH;
  void* args[] = {&p};
  hipError_t e = hipLaunchCooperativeKernel((void*)fwd_megakernel, dim3(grid_blocks), dim3(512), args, 0, stream);
  if (e != hipSuccess) fprintf(stderr, "cooperative launch failed: %s (grid %d)\n", hipGetErrorString(e), grid_blocks);
#else
  for (int ph = 0; ph < NPH; ++ph) {
    p.ph_lo = ph; p.ph_hi = ph + 1;
    hipLaunchKernelGGL(fwd_megakernel, dim3(grid_blocks), dim3(512), 0, stream, p);
  }
#endif
}
```

```cpp
#include <hip/hip_runtime.h>
#include <hip/hip_cooperative_groups.h>
#include <cstdio>
#include <cstdint>
#include <cmath>
namespace cg = cooperative_groups;

#ifndef ONE_LAUNCH
#define ONE_LAUNCH 1
#endif

typedef unsigned short u16;
typedef __attribute__((ext_vector_type(8))) short bf16x8;
typedef __attribute__((ext_vector_type(4))) short s16x4;
typedef __attribute__((ext_vector_type(16))) float f32x16;
typedef __attribute__((ext_vector_type(4))) float f32x4;
typedef __attribute__((ext_vector_type(2))) unsigned u32x2;
typedef __attribute__((ext_vector_type(4))) unsigned u32x4;
typedef __attribute__((ext_vector_type(2))) __bf16 bf2_t;
typedef __attribute__((ext_vector_type(2))) float f2_t;
#define DI __device__ __forceinline__
#define LAS __attribute__((address_space(3)))
#define MFMA32(a, b, c) __builtin_amdgcn_mfma_f32_32x32x16_bf16((a), (b), (c), 0, 0, 0)

constexpr int DM = 1024, NTOK = 8192, NCTX = 4096;
constexpr int DIN = 6144, DFF = 2816, DEPTH = 4;
#ifndef SEQ_PACK
#define SEQ_PACK 0x76543210ull
#define SEQ_N 8
#endif
constexpr int NPH = 2 + SEQ_N * DEPTH;

constexpr size_t SZ_WIN = (size_t)DIN * DM * 2, SZ_WBR = (size_t)DM * 1536 * 2, SZ_WOUT = (size_t)DM * DM * 2;
constexpr size_t SZ_WF1 = (size_t)2 * DFF * DM * 2, SZ_WF2 = (size_t)DM * DFF * 2;
constexpr size_t SZ_WL = SZ_WIN + SZ_WBR + SZ_WOUT + SZ_WF1 + SZ_WF2;
constexpr size_t OFF_W = 0;
constexpr size_t OFF_MOD = OFF_W + SZ_WL * DEPTH;
constexpr size_t OFF_ROPE = OFF_MOD + (size_t)4 * 5 * 6144 * 4;
constexpr size_t OFF_X = OFF_ROPE + (size_t)2 * 1024 * 32 * 4;
constexpr size_t OFF_HM = OFF_X + (size_t)NTOK * DM * 4;
constexpr size_t OFF_Q = OFF_HM + (size_t)NTOK * DM * 2;
constexpr size_t OFF_GH = OFF_Q + (size_t)NTOK * 1536 * 2;
constexpr size_t OFF_ATT = OFF_GH + (size_t)NTOK * 3072 * 2;
constexpr size_t EL_KA = (size_t)4 * 4 * 1536 * 128, EL_KB = (size_t)4 * 2 * 1536 * 64;
constexpr size_t SZ_KVL = (2 * EL_KA + 4 * EL_KB) * 2;
constexpr size_t OFF_KVL = OFF_ATT + (size_t)NTOK * 1536 * 2;
constexpr size_t EL_KAC = (size_t)16 * 4 * 256 * 128, EL_KBC = (size_t)16 * 2 * 256 * 64;
constexpr size_t OFF_KVC = OFF_KVL + SZ_KVL * DEPTH;
constexpr size_t OFF_BAR = OFF_KVC + (2 * EL_KAC + 4 * EL_KBC) * 2;
constexpr size_t WS_END = OFF_BAR + 16384;

constexpr size_t O_YP = 0, O_YS = 4194304, O_AK = 8388608, O_AV = 16777216, O_BK = 25165824, O_BV = 27262976, O_CK = 29360128, O_CV = 31457280;

struct Params {
  const float* in[30];
  float* out;
  unsigned char* ws;
  float lam_init[4];
  int ph_lo, ph_hi;
};

DI unsigned pack2(float a, float b) { f2_t v = {a, b}; bf2_t r = __builtin_convertvector(v, bf2_t); return __builtin_bit_cast(unsigned, r); }
DI int tid_() { int t = threadIdx.x; asm volatile("" : "+v"(t)); return t; }
DI float4 ld_nt4(const float* p) { f32x4 t = __builtin_nontemporal_load((const f32x4*)p); return make_float4(t[0], t[1], t[2], t[3]); }
DI void st_nt4(float* p, float4 v) { f32x4 t = {v.x, v.y, v.z, v.w}; __builtin_nontemporal_store(t, (f32x4*)p); }
DI void st_nt2(float* p, float2 v) { f2_t t = {v.x, v.y}; __builtin_nontemporal_store(t, (f2_t*)p); }
DI float bf2f(u16 x) { return __uint_as_float(((unsigned)x) << 16); }
DI int crow(int reg, int h) { return (reg & 3) + 8 * (reg >> 2) + 4 * h; }
DI float wave_sum(float v) {
#pragma unroll
  for (int o = 32; o > 0; o >>= 1) v += __shfl_xor(v, o);
  return v;
}
DI float sigmoidf_(float x) { return __builtin_amdgcn_rcpf(1.f + __expf(-x)); }
DI float siluf_(float x) { return x * __builtin_amdgcn_rcpf(1.f + __expf(-x)); }
DI u16 bf16_1(float x) { return (u16)(pack2(x, 0.f) & 0xffffu); }

DI u16* Wt_in(unsigned char* ws, int l) { return (u16*)(ws + OFF_W + SZ_WL * l); }
DI u16* Wt_br(unsigned char* ws, int l) { return (u16*)(ws + OFF_W + SZ_WL * l + SZ_WIN); }
DI u16* Wt_out(unsigned char* ws, int l) { return (u16*)(ws + OFF_W + SZ_WL * l + SZ_WIN + SZ_WBR); }
DI u16* Wt_f1(unsigned char* ws, int l) { return (u16*)(ws + OFF_W + SZ_WL * l + SZ_WIN + SZ_WBR + SZ_WOUT); }
DI u16* Wt_f2(unsigned char* ws, int l) { return (u16*)(ws + OFF_W + SZ_WL * l + SZ_WIN + SZ_WBR + SZ_WOUT + SZ_WF1); }
DI u16* KVL(unsigned char* ws, int l, int which) {
  size_t off = 0;
  if (which >= 1) off += EL_KA;
  if (which >= 2) off += EL_KB;
  if (which >= 3) off += EL_KB;
  if (which >= 4) off += EL_KA;
  if (which >= 5) off += EL_KB;
  return (u16*)(ws + OFF_KVL + SZ_KVL * l) + off;
}
DI u16* KVC(unsigned char* ws, int which) {
  size_t off = 0;
  if (which >= 1) off += EL_KAC;
  if (which >= 2) off += EL_KBC;
  if (which >= 3) off += EL_KBC;
  if (which >= 4) off += EL_KAC;
  if (which >= 5) off += EL_KBC;
  return (u16*)(ws + OFF_KVC) + off;
}
DI const float* x_src(const Params& p, int l, int row) {
  if (l == 0) return row < NCTX ? p.in[0] + (size_t)row * DM : p.in[1] + (size_t)(row - NCTX) * DM;
  return (const float*)(p.ws + OFF_X) + (size_t)row * DM;
}
DI const float* mod_vec(const Params& p, int l, int row, int chunk) {
  int v = row < NCTX ? 4 : ((row - NCTX) >> 10);
  return (const float*)(p.ws + OFF_MOD) + ((size_t)(l * 5 + v) * 6144 + chunk * 1024);
}

template <int NT64>
DI void transpose_tile(const float* __restrict__ src, int ldsrc, int k0, int n0, u16* __restrict__ dst, int ldd, int mode, float* tile) {
  const int t = tid_() & 255;
  __syncthreads();
  {
    const int kk = t >> 4, c4 = (t & 15) * 4;
    float4 v[NT64 * 4];
#pragma unroll
    for (int q = 0; q < NT64; ++q)
#pragma unroll
      for (int i = 0; i < 4; ++i) { f32x4 t_ = __builtin_nontemporal_load((const f32x4*)(src + (size_t)(k0 + kk + 16 * i) * ldsrc + n0 + 64 * q + c4)); v[q * 4 + i] = make_float4(t_[0], t_[1], t_[2], t_[3]); }
#pragma unroll
    for (int q = 0; q < NT64; ++q)
#pragma unroll
      for (int i = 0; i < 4; ++i) {
        float* tp = tile + q * 4160 + (kk + 16 * i) * 65 + c4;
        tp[0] = v[q * 4 + i].x; tp[1] = v[q * 4 + i].y; tp[2] = v[q * 4 + i].z; tp[3] = v[q * 4 + i].w;
      }
  }
  __syncthreads();
  const int n = t >> 2, kc = (t & 3) * 16;
#pragma unroll
  for (int q = 0; q < NT64; ++q) {
    const float* tq = tile + q * 4160;
    const int n0q = n0 + 64 * q;
    unsigned w[8];
#pragma unroll
    for (int j = 0; j < 8; ++j) w[j] = pack2(tq[(kc + 2 * j) * 65 + n], tq[(kc + 2 * j + 1) * 65 + n]);
    int drow;
    if (mode != 1) drow = n0q + n;
    else {
      int isb = n0q >= DFF;
      int c0 = n0q - (isb ? DFF : 0);
      drow = (c0 >> 7) * 256 + ((c0 >> 6) & 1) * 128 + isb * 64 + n;
    }
    uint4* dp = (uint4*)(dst + (size_t)drow * ldd + k0 + kc);
    if (mode == 2) {
      dp[0] = make_uint4(w[0], w[1], w[4], w[5]);
      dp[1] = make_uint4(w[2], w[3], w[6], w[7]);
    } else {
      dp[0] = make_uint4(w[0], w[1], w[2], w[3]);
      dp[1] = make_uint4(w[4], w[5], w[6], w[7]);
    }
  }
}

DI void mod_task(const Params& p, int l, int cgp, float* sm) {
  float* sv = sm;
  float* red = sm + 5 * 1024;
  const int t = tid_() & 255;
  __syncthreads();
  for (int e = t; e < 5 * 1024; e += 256) {
    int v = e >> 10, k = e & 1023;
    float x = v < 4 ? p.in[8][v * 1024 + k] : p.in[9][k];
    sv[e] = siluf_(x);
  }
  __syncthreads();
  const int c4 = t & 31, ks = t >> 5;
  const float* w = p.in[10] + (size_t)l * 1024 * 6144 + cgp * 128 + c4 * 4;
  float acc[5][4];
#pragma unroll
  for (int v = 0; v < 5; ++v) { acc[v][0] = acc[v][1] = acc[v][2] = acc[v][3] = 0.f; }
#pragma unroll 8
  for (int k = ks * 128; k < ks * 128 + 128; ++k) {
    f32x4 wt_ = __builtin_nontemporal_load((const f32x4*)(w + (size_t)k * 6144));
    float4 wv = make_float4(wt_[0], wt_[1], wt_[2], wt_[3]);
#pragma unroll
    for (int v = 0; v < 5; ++v) {
      float s = sv[v * 1024 + k];
      acc[v][0] += s * wv.x; acc[v][1] += s * wv.y; acc[v][2] += s * wv.z; acc[v][3] += s * wv.w;
    }
  }
#pragma unroll
  for (int v = 0; v < 5; ++v)
#pragma unroll
    for (int j = 0; j < 4; ++j) red[(ks * 32 + c4) * 20 + v * 4 + j] = acc[v][j];
  __syncthreads();
  for (int o = t; o < 640; o += 256) {
    int cc = o / 20, r = o % 20, v = r >> 2, j = r & 3;
    float s = 0.f;
#pragma unroll
    for (int q = 0; q < 8; ++q) s += red[(q * 32 + cc) * 20 + r];
    int col = cgp * 128 + cc * 4 + j;
    s += p.in[11][l * 6144 + col];
    ((float*)(p.ws + OFF_MOD))[(size_t)(l * 5 + v) * 6144 + col] = s;
  }
}

constexpr int T_MOD = 192, T_ROPE = 32, T_WTL = 1072, T_WT = T_WTL * 4, T_CVA = 256, T_CVB = 128, T_CKA = 2048, T_CKB = 512;
constexpr int T_PRE = T_MOD + T_ROPE + T_WT + T_CVA + 2 * T_CVB + T_CKA + 2 * T_CKB;

DI void pre_phase(const Params& p, float* sm0) {
  const int t = tid_() & 255, half = tid_() >> 8;
  float* sm = sm0 + half * 16640;
  for (int pair = blockIdx.x; pair < T_PRE / 2; pair += gridDim.x) {
    int i = pair * 2 + half;
    if (i < T_MOD) { mod_task(p, i / 48, i % 48, sm); continue; }
    i -= T_MOD;
    if (i < T_ROPE) {
      float* cosT = (float*)(p.ws + OFF_ROPE);
      float* sinT = cosT + 1024 * 32;
#pragma unroll
      for (int q = 0; q < 4; ++q) {
        int e = i * 1024 + q * 256 + t;
        int pos = e >> 5, j = e & 31;
        int rr = pos >> 6, cc = pos & 63;
        float inv = exp2f(-(float)(j & 15) * (13.287712379549449f / 16.f));
        float ang = (float)(j < 16 ? rr : cc) * inv;
        cosT[e] = __cosf(ang);
        sinT[e] = __sinf(ang);
      }
      continue;
    }
    i -= T_ROPE;
    if (i < T_WT) {
      int l = i / T_WTL, j = i % T_WTL;
      if (j < 384) { transpose_tile<4>(p.in[14] + (size_t)l * 1024 * 6144, 6144, (j / 24) * 64, (j % 24) * 256, Wt_in(p.ws, l), 1024, 0, sm); continue; }
      j -= 384;
      if (j < 96) {
        int seg = j / 32, jj = j % 32;
        transpose_tile<4>((seg == 0 ? p.in[23] : (seg == 1 ? p.in[24] : p.in[25])) + (size_t)l * 512 * 1024, 1024, (jj / 4) * 64, (jj % 4) * 256, Wt_br(p.ws, l) + seg * 512, 1536, 0, sm);
        continue;
      }
      j -= 96;
      if (j < 64) { transpose_tile<4>(p.in[26] + (size_t)l * 1024 * 1024, 1024, (j / 4) * 64, (j % 4) * 256, Wt_out(p.ws, l), 1024, 0, sm); continue; }
      j -= 64;
      if (j < 352) { transpose_tile<4>(p.in[27] + (size_t)l * 1024 * 5632, 5632, (j / 22) * 64, (j % 22) * 256, Wt_f1(p.ws, l), 1024, 1, sm); continue; }
      j -= 352;
      transpose_tile<4>(p.in[28] + (size_t)l * 2816 * 1024, 1024, (j / 4) * 64, (j % 4) * 256, Wt_f2(p.ws, l), 2816, 0, sm);
      continue;
    }
    i -= T_WT;
    if (i < T_CVA) {
      int bl = i / 16, jj = i % 16, b = bl >> 2, l = bl & 3;
      transpose_tile<4>(p.in[3] + (size_t)bl * 512 * 512, 512, (jj / 2) * 64, (jj % 2) * 256, KVL(p.ws, l, 3) + (size_t)b * 512 * 1536, 1536, 2, sm);
      continue;
    }
    i -= T_CVA;
    if (i < 2 * T_CVB) {
      int wh = i / T_CVB, ii = i % T_CVB;
      int bl = ii / 8, jj = ii % 8, b = bl >> 2, l = bl & 3;
      transpose_tile<2>((wh ? p.in[7] : p.in[5]) + (size_t)bl * 512 * 128, 128, jj * 64, 0, KVL(p.ws, l, wh ? 5 : 4) + (size_t)b * 128 * 1536, 1536, 2, sm);
      continue;
    }
    i -= 2 * T_CVB;
    if (i < T_CKA) {
      size_t e = ((size_t)i * 256 + t) * 8;
      int d = e & 127, h = (e >> 7) & 3, pp = (e >> 9) & 511, l = (e >> 18) & 3, b = (int)(e >> 20);
      const float* sp = p.in[2] + e;
      float4 a = ld_nt4(sp), c = ld_nt4(sp + 4);
      u16* dp = KVL(p.ws, l, 0) + (((size_t)(b * 4 + h) * 1536 + pp) * 128 + d);
      *(uint4*)dp = make_uint4(pack2(a.x, a.y), pack2(a.z, a.w), pack2(c.x, c.y), pack2(c.z, c.w));
      continue;
    }
    i -= T_CKA;
    {
      int wh = i / T_CKB, ii = i % T_CKB;
      size_t e = ((size_t)ii * 256 + t) * 8;
      int d = e & 63, h = (e >> 6) & 1, pp = (e >> 7) & 511, l = (e >> 16) & 3, b = (int)(e >> 18);
      const float* sp = (wh ? p.in[6] : p.in[4]) + e;
      float4 a = ld_nt4(sp), c = ld_nt4(sp + 4);
      u16* dp = KVL(p.ws, l, wh ? 2 : 1) + (((size_t)(b * 2 + h) * 1536 + pp) * 64 + d);
      *(uint4*)dp = make_uint4(pack2(a.x, a.y), pack2(a.z, a.w), pack2(c.x, c.y), pack2(c.z, c.w));
    }
  }
}

DI void norm_phase(const Params& p, int l, int which) {
  const int lane = tid_() & 63;
  const int gw = blockIdx.x * 8 + (tid_() >> 6), nw = gridDim.x * 8;
  for (int row = gw; row < NTOK; row += nw) {
    float v[2][8];
    const bool from_input = (which == 0 && l == 0);
    if (from_input) {
      const float* x = row < NCTX ? p.in[0] + (size_t)row * DM : p.in[1] + (size_t)(row - NCTX) * DM;
#pragma unroll
      for (int c = 0; c < 2; ++c) {
        float4 a = *(const float4*)(x + 8 * lane + 512 * c), b = *(const float4*)(x + 8 * lane + 512 * c + 4);
        v[c][0] = a.x; v[c][1] = a.y; v[c][2] = a.z; v[c][3] = a.w; v[c][4] = b.x; v[c][5] = b.y; v[c][6] = b.z; v[c][7] = b.w;
      }
    } else {
      const u16* x = (const u16*)(p.ws + OFF_X) + (size_t)row * DM;
#pragma unroll
      for (int c = 0; c < 2; ++c) {
        uint4 a = *(const uint4*)(x + 8 * lane + 512 * c);
        v[c][0] = __uint_as_float(a.x << 16); v[c][1] = __uint_as_float(a.x & 0xffff0000u);
        v[c][2] = __uint_as_float(a.y << 16); v[c][3] = __uint_as_float(a.y & 0xffff0000u);
        v[c][4] = __uint_as_float(a.z << 16); v[c][5] = __uint_as_float(a.z & 0xffff0000u);
        v[c][6] = __uint_as_float(a.w << 16); v[c][7] = __uint_as_float(a.w & 0xffff0000u);
      }
    }
    float ss = 0.f;
#pragma unroll
    for (int c = 0; c < 2; ++c)
#pragma unroll
      for (int i = 0; i < 8; ++i) ss += v[c][i] * v[c][i];
    ss = wave_sum(ss);
    const float rs = rsqrtf(ss * (1.f / 1024.f) + 1e-6f);
    if (which == 2) {
      float* o = p.out + (row < NCTX ? O_YP + (size_t)row * DM : O_YS + (size_t)(row - NCTX) * DM);
#pragma unroll
      for (int c = 0; c < 2; ++c) {
        const int col = 8 * lane + 512 * c;
        float4 g0 = *(const float4*)(p.in[29] + col), g1 = *(const float4*)(p.in[29] + col + 4);
        st_nt4(o + col, make_float4(v[c][0] * rs * g0.x, v[c][1] * rs * g0.y, v[c][2] * rs * g0.z, v[c][3] * rs * g0.w));
        st_nt4(o + col + 4, make_float4(v[c][4] * rs * g1.x, v[c][5] * rs * g1.y, v[c][6] * rs * g1.z, v[c][7] * rs * g1.w));
      }
    } else {
      const float* gp = (which == 0 ? p.in[12] : p.in[13]) + l * 1024;
      const float* sh = mod_vec(p, l, row, which == 0 ? 0 : 3);
      const float* sc = mod_vec(p, l, row, which == 0 ? 1 : 4);
      u16* o = (u16*)(p.ws + OFF_HM) + (size_t)row * DM;
#pragma unroll
      for (int c = 0; c < 2; ++c) {
        const int col = 8 * lane + 512 * c;
        float gg[8], s1[8], s0[8];
        *(float4*)&gg[0] = *(const float4*)(gp + col); *(float4*)&gg[4] = *(const float4*)(gp + col + 4);
        *(float4*)&s1[0] = *(const float4*)(sc + col); *(float4*)&s1[4] = *(const float4*)(sc + col + 4);
        *(float4*)&s0[0] = *(const float4*)(sh + col); *(float4*)&s0[4] = *(const float4*)(sh + col + 4);
        float r[8];
#pragma unroll
        for (int i = 0; i < 8; ++i) r[i] = v[c][i] * rs * gg[i] * (1.f + s1[i]) + s0[i];
        *(uint4*)(o + col) = make_uint4(pack2(r[0], r[1]), pack2(r[2], r[3]), pack2(r[4], r[5]), pack2(r[6], r[7]));
      }
    }
  }
}

constexpr int SMEM_BYTES = 8 * 64 * 68 * 4;
enum { EPI_G1 = 0, EPI_G2 = 1, EPI_RES = 2, EPI_SWIGLU = 3 };

struct GemmArgs {
  const u16* A; int lda;
  const u16* Bt; int ldb;
  int K;
  int l;
  int res_chunk;
};

DI void g1_epilogue_wave(const Params& p, int l, int mrow0, int ncol0, const float* ct, int lane);

#define RAW_BARRIER() do { asm volatile("s_waitcnt lgkmcnt(0)" ::: "memory"); __builtin_amdgcn_s_barrier(); } while (0)

template <int EPI, int BN>
DI void gemm_tile(const Params& p, const GemmArgs& g, int m0, int n0, unsigned char* smem) {
  constexpr int NT = BN / 32;
  constexpr int NH = NT / 2;
  constexpr int NI = (256 + BN) / 128;
  constexpr int STAGE = (256 + BN) * 64;
  const int t = tid_(), lane = t & 63, w = t >> 6, wm = w >> 1, wn = w & 1, lc = lane & 15, lq = lane >> 4;
  f32x4 acc[4][NT];
  f32x4 tot[4][NT];
#pragma unroll
  for (int a = 0; a < 4; ++a)
#pragma unroll
    for (int b = 0; b < NT; ++b)
#pragma unroll
      for (int i = 0; i < 4; ++i) { acc[a][b][i] = 0.f; if (EPI == EPI_G2) tot[a][b][i] = 0.f; }

  const int nk = g.K >> 5;
  const int dl_rr = lane >> 2, dl_p = lane & 3;
  const u16* gsrc[NI];
#pragma unroll
  for (int i = 0; i < NI; ++i) {
    const int blk = i * 8 + w, kc = dl_p ^ (dl_rr >> 2);
    if (blk < 16) gsrc[i] = g.A + (size_t)(m0 + blk * 16 + dl_rr) * g.lda + kc * 8;
    else gsrc[i] = g.Bt + (size_t)(n0 + (blk - 16) * 16 + dl_rr) * g.ldb + kc * 8;
  }
  const int dma_off = w * 1024 + lane * 16;
  const unsigned smem_lds = (unsigned)(size_t)smem;
#define DMA_SLICE(J)                                                                                                   \
  {                                                                                                                    \
    unsigned char* bufp_ = smem + ((J) & 3) * STAGE + dma_off;                                                         \
    const size_t koff_ = (size_t)(J) * 32;                                                                             \
    _Pragma("unroll") for (int i_ = 0; i_ < NI; ++i_)                                                                  \
        __builtin_amdgcn_global_load_lds((const unsigned*)(gsrc[i_] + koff_), (LAS unsigned*)(bufp_ + i_ * 8192), 16, 0, 0); \
  }
  __syncthreads();
  DMA_SLICE(0) DMA_SLICE(1) DMA_SLICE(2)
  const unsigned frag_off = lc * 64 + (((lq ^ (lc >> 2)) & 3) << 4);
  const unsigned a_base = smem_lds + (wm * 4) * 1024 + frag_off;
  const unsigned b_base = smem_lds + 16384 + (wn * NT) * 1024 + frag_off;
  bf16x8 a0, a1, a2, a3, c0, c1, c2, c3, bl0, bl1, bl2, bl3, bh0, bh1, bh2, bh3;
#define RD4(ADDR, F0, F1, F2, F3)                                                                                      \
  asm volatile("ds_read_b128 %0, %4\n\tds_read_b128 %1, %4 offset:1024\n\tds_read_b128 %2, %4 offset:2048\n\t"         \
               "ds_read_b128 %3, %4 offset:3072"                                                                       \
               : "=&v"(F0), "=&v"(F1), "=&v"(F2), "=&v"(F3) : "v"(ADDR) : "memory");
#define RD2(ADDR, F0, F1)                                                                                              \
  asm volatile("ds_read_b128 %0, %2\n\tds_read_b128 %1, %2 offset:1024" : "=&v"(F0), "=&v"(F1) : "v"(ADDR) : "memory");
#define RD_B(ADDR, F0, F1, F2, F3) if (NH == 4) { RD4(ADDR, F0, F1, F2, F3) } else { RD2(ADDR, F0, F1) }
#define WT4(F0, F1, F2, F3) asm volatile("s_waitcnt lgkmcnt(0)" : "+v"(F0), "+v"(F1), "+v"(F2), "+v"(F3) :: "memory");
#define WT8(F0, F1, F2, F3, F4, F5, F6, F7)                                                                            \
  asm volatile("s_waitcnt lgkmcnt(0)" : "+v"(F0), "+v"(F1), "+v"(F2), "+v"(F3), "+v"(F4), "+v"(F5), "+v"(F6), "+v"(F7) :: "memory");
#define MF16(A, B, C) __builtin_amdgcn_mfma_f32_16x16x32_bf16((A), (B), (C), 0, 0, 0)
#define MM_HALF(A0, A1, A2, A3, B0, B1, B2, B3, NB)                                                                    \
  acc[0][(NB)] = MF16(A0, B0, acc[0][(NB)]); acc[1][(NB)] = MF16(A1, B0, acc[1][(NB)]);                                \
  acc[2][(NB)] = MF16(A2, B0, acc[2][(NB)]); acc[3][(NB)] = MF16(A3, B0, acc[3][(NB)]);                                \
  acc[0][(NB) + 1] = MF16(A0, B1, acc[0][(NB) + 1]); acc[1][(NB) + 1] = MF16(A1, B1, acc[1][(NB) + 1]);                \
  acc[2][(NB) + 1] = MF16(A2, B1, acc[2][(NB) + 1]); acc[3][(NB) + 1] = MF16(A3, B1, acc[3][(NB) + 1]);                \
  if (NH == 4) {                                                                                                       \
    acc[0][((NB) + 2) % NT] = MF16(A0, B2, acc[0][((NB) + 2) % NT]); acc[1][((NB) + 2) % NT] = MF16(A1, B2, acc[1][((NB) + 2) % NT]); \
    acc[2][((NB) + 2) % NT] = MF16(A2, B2, acc[2][((NB) + 2) % NT]); acc[3][((NB) + 2) % NT] = MF16(A3, B2, acc[3][((NB) + 2) % NT]); \
    acc[0][((NB) + 3) % NT] = MF16(A0, B3, acc[0][((NB) + 3) % NT]); acc[1][((NB) + 3) % NT] = MF16(A1, B3, acc[1][((NB) + 3) % NT]); \
    acc[2][((NB) + 3) % NT] = MF16(A2, B3, acc[2][((NB) + 3) % NT]); acc[3][((NB) + 3) % NT] = MF16(A3, B3, acc[3][((NB) + 3) % NT]); \
  }
#define SLICE_STEP(KT, A0, A1, A2, A3, N0, N1, N2, N3)                                                                 \
  {                                                                                                                    \
    if ((KT) + 2 < nk) { if (NI == 4) asm volatile("s_waitcnt vmcnt(4)" ::: "memory"); else asm volatile("s_waitcnt vmcnt(3)" ::: "memory"); } \
    else asm volatile("s_waitcnt vmcnt(0)" ::: "memory");                                                              \
    WT8(A0, A1, A2, A3, bl0, bl1, bl2, bl3)                                                                            \
    __builtin_amdgcn_s_barrier();                      \
    if ((KT) + 3 < nk) DMA_SLICE((KT) + 3)                                                                             \
    const unsigned so_ = ((KT) & 3) * STAGE;                                                                           \
    RD_B(b_base + so_ + NH * 1024, bh0, bh1, bh2, bh3)                                                                 \
    __builtin_amdgcn_sched_barrier(0);                                           \
    MM_HALF(A0, A1, A2, A3, bl0, bl1, bl2, bl3, 0)                                                                     \
    __builtin_amdgcn_sched_barrier(0);                                                                                 \
    WT4(bh0, bh1, bh2, bh3)                                                                                            \
    __builtin_amdgcn_s_barrier();     \
                                      \
      \
                                                                        \
    MM_PART(A0, A1, A2, A3, bh0, bh1, NH)                                                                              \
    __builtin_amdgcn_sched_barrier(0);                                                                                 \
    if ((KT) + 1 < nk) {                                                                                               \
      const unsigned sn_ = (((KT) + 1) & 3) * STAGE;                                                                   \
      RD4(a_base + sn_, N0, N1, N2, N3)                                                                                \
      RD_B(b_base + sn_, bl0, bl1, bl2, bl3)                                                                           \
    }                                                                                                                  \
    __builtin_amdgcn_sched_barrier(0);                                                                                 \
    MM_REST(A0, A1, A2, A3, bh0, bh1, bh2, bh3, NH)                                                                    \
    __builtin_amdgcn_sched_barrier(0);                                                                                 \
  }
#define MM_PART(A0, A1, A2, A3, B0, B1, NB)                                                                            \
  acc[0][(NB)] = MF16(A0, B0, acc[0][(NB)]); acc[1][(NB)] = MF16(A1, B0, acc[1][(NB)]);                                \
  acc[2][(NB)] = MF16(A2, B0, acc[2][(NB)]); acc[3][(NB)] = MF16(A3, B0, acc[3][(NB)]);                                \
  if (NH == 4) {                                                                                                       \
    acc[0][(NB) + 1] = MF16(A0, B1, acc[0][(NB) + 1]); acc[1][(NB) + 1] = MF16(A1, B1, acc[1][(NB) + 1]);              \
    acc[2][(NB) + 1] = MF16(A2, B1, acc[2][(NB) + 1]); acc[3][(NB) + 1] = MF16(A3, B1, acc[3][(NB) + 1]);              \
  }
#define MM_REST(A0, A1, A2, A3, B0, B1, B2, B3, NB)                                                                    \
  if (NH == 4) {                                                                                                       \
    acc[0][((NB) + 2) % NT] = MF16(A0, B2, acc[0][((NB) + 2) % NT]); acc[1][((NB) + 2) % NT] = MF16(A1, B2, acc[1][((NB) + 2) % NT]); \
    acc[2][((NB) + 2) % NT] = MF16(A2, B2, acc[2][((NB) + 2) % NT]); acc[3][((NB) + 2) % NT] = MF16(A3, B2, acc[3][((NB) + 2) % NT]); \
    acc[0][((NB) + 3) % NT] = MF16(A0, B3, acc[0][((NB) + 3) % NT]); acc[1][((NB) + 3) % NT] = MF16(A1, B3, acc[1][((NB) + 3) % NT]); \
    acc[2][((NB) + 3) % NT] = MF16(A2, B3, acc[2][((NB) + 3) % NT]); acc[3][((NB) + 3) % NT] = MF16(A3, B3, acc[3][((NB) + 3) % NT]); \
  } else {                                                                                                             \
    acc[0][(NB) + 1] = MF16(A0, B1, acc[0][(NB) + 1]); acc[1][(NB) + 1] = MF16(A1, B1, acc[1][(NB) + 1]);              \
    acc[2][(NB) + 1] = MF16(A2, B1, acc[2][(NB) + 1]); acc[3][(NB) + 1] = MF16(A3, B1, acc[3][(NB) + 1]);              \
  }
#ifndef PIPE_BN
#define PIPE_BN 256
#endif
#define SIMPLE_STEP(KT)                                                                                                \
  {                                                                                                                    \
    if ((KT) + 2 < nk) { if (NI == 4) asm volatile("s_waitcnt vmcnt(8)" ::: "memory"); else asm volatile("s_waitcnt vmcnt(6)" ::: "memory"); } \
    else if ((KT) + 1 < nk) { if (NI == 4) asm volatile("s_waitcnt vmcnt(4)" ::: "memory"); else asm volatile("s_waitcnt vmcnt(3)" ::: "memory"); } \
    else asm volatile("s_waitcnt vmcnt(0)" ::: "memory");                                                              \
    RAW_BARRIER();                                                                                                     \
    G2_PREFETCH(KT)                                                                                                    \
    if ((KT) + 3 < nk) DMA_SLICE((KT) + 3)                                                                             \
    const unsigned so_ = ((KT) & 3) * STAGE;                                                                           \
    RD4(a_base + so_, a0, a1, a2, a3)                                                                                  \
    RD_B(b_base + so_, bl0, bl1, bl2, bl3)                                                                             \
    RD_B(b_base + so_ + NH * 1024, bh0, bh1, bh2, bh3)                                                                 \
    WT8(a0, a1, a2, a3, bl0, bl1, bl2, bl3)                                                                            \
    WT4(bh0, bh1, bh2, bh3)                                                                                            \
    MM_HALF(a0, a1, a2, a3, bl0, bl1, bl2, bl3, 0)                                                                     \
    MM_HALF(a0, a1, a2, a3, bh0, bh1, bh2, bh3, NH)                                                                    \
  }
  u32x2 gqr[4][NT];
#pragma unroll
  for (int a = 0; a < 4; ++a)
#pragma unroll
    for (int b = 0; b < NT; ++b) gqr[a][b] = (u32x2){0u, 0u};
#define G2_PREFETCH(KT)                                                                                                \
  if (EPI == EPI_G2 && (((KT) & 15) == 15)) {                                                                          \
    const int seg_ = (KT) >> 4;                                                                                        \
    _Pragma("unroll") for (int a = 0; a < 4; ++a) _Pragma("unroll") for (int b = 0; b < NT; ++b) {                     \
      const int r16 = (m0 + wm * 64 + a * 16) >> 4, c16 = (seg_ * 1024 + n0 + wn * (BN / 2) + b * 16) >> 4;           \
      gqr[a][b] = __builtin_nontemporal_load((const u32x2*)((const u16*)(p.ws + OFF_GH) + ((size_t)(r16 * 192 + c16) * 64 + lane) * 4)); \
    }                                                                                                                  \
  }
  constexpr bool PIPE = true;
  c0 = c1 = c2 = c3 = a0 = a1 = a2 = a3 = bl0 = bl1 = bl2 = bl3 = bh0 = bh1 = bh2 = bh3 = (bf16x8)(0);
  if (PIPE) {
    if (NI == 4) asm volatile("s_waitcnt vmcnt(8)" ::: "memory"); else asm volatile("s_waitcnt vmcnt(6)" ::: "memory");
    RAW_BARRIER();
    RD4(a_base, a0, a1, a2, a3)
    RD_B(b_base, bl0, bl1, bl2, bl3)
    if (w >= 4) __builtin_amdgcn_s_barrier();
  }
  for (int kt = 0; kt < nk; kt += 2) {
    if (PIPE) {
      SLICE_STEP(kt, a0, a1, a2, a3, c0, c1, c2, c3)
      SLICE_STEP(kt + 1, c0, c1, c2, c3, a0, a1, a2, a3)
    } else {
      SIMPLE_STEP(kt)
      SIMPLE_STEP(kt + 1)
    }
    if (EPI == EPI_G2) {
      if (((kt + 1) & 15) == 15) {
        const int seg = (kt + 1) >> 4;
        if (PIPE) {
#pragma unroll
          for (int a = 0; a < 4; ++a)
#pragma unroll
            for (int b = 0; b < NT; ++b) {
              const int r16 = (m0 + wm * 64 + a * 16) >> 4, c16 = (seg * 1024 + n0 + wn * (BN / 2) + b * 16) >> 4;
              gqr[a][b] = __builtin_nontemporal_load((const u32x2*)((const u16*)(p.ws + OFF_GH) + ((size_t)(r16 * 192 + c16) * 64 + lane) * 4));
            }
          WT8(a0, a1, a2, a3, bl0, bl1, bl2, bl3)
        }
#pragma unroll
        for (int a = 0; a < 4; ++a)
#pragma unroll
          for (int b = 0; b < NT; ++b) {
            const int r16 = (m0 + wm * 64 + a * 16) >> 4, c16 = (seg * 1024 + n0 + wn * (BN / 2) + b * 16) >> 4;
            const u32x2 gq_ = gqr[a][b];
            const uint2 gq = make_uint2(gq_[0], gq_[1]);
            tot[a][b][0] += __uint_as_float(gq.x << 16) * acc[a][b][0];
            tot[a][b][1] += __uint_as_float(gq.x & 0xffff0000u) * acc[a][b][1];
            tot[a][b][2] += __uint_as_float(gq.y << 16) * acc[a][b][2];
            tot[a][b][3] += __uint_as_float(gq.y & 0xffff0000u) * acc[a][b][3];
            acc[a][b][0] = 0.f; acc[a][b][1] = 0.f; acc[a][b][2] = 0.f; acc[a][b][3] = 0.f;
          }
      }
    }
  }
  if (PIPE && w < 4) __builtin_amdgcn_s_barrier();
  __syncthreads();

  const int rbase = m0 + wm * 64, cbase = n0 + wn * (BN / 2);
  if (EPI == EPI_G1) {
    if (n0 >= 3072) {
#pragma unroll
      for (int a = 0; a < 4; ++a)
#pragma unroll
        for (int b = 0; b < NT; ++b) {
          const int r16 = (rbase + a * 16) >> 4, c16 = (cbase - 3072 + b * 16) >> 4;
          u16* gp = (u16*)(p.ws + OFF_GH) + ((size_t)(r16 * 192 + c16) * 64 + lane) * 4;
          *(uint2*)gp = make_uint2(pack2(sigmoidf_(acc[a][b][0]), sigmoidf_(acc[a][b][1])), pack2(sigmoidf_(acc[a][b][2]), sigmoidf_(acc[a][b][3])));
        }
    } else {
      float* ct = (float*)smem + w * (64 * 68);
#pragma unroll
      for (int hf = 0; hf < NT / 4; ++hf) {
#pragma unroll
        for (int a = 0; a < 4; ++a)
#pragma unroll
          for (int b = 0; b < 4; ++b)
#pragma unroll
            for (int i = 0; i < 4; ++i)
              ct[(a * 16 + 4 * lq + i) * 68 + b * 16 + lc] = acc[a][(hf * 4 + b) % NT][i];
        g1_epilogue_wave(p, g.l, rbase, cbase + hf * 64, ct, lane);
      }
    }
  } else if (EPI == EPI_G2) {
    u16* o = (u16*)(p.ws + OFF_HM);
    float* ct = (float*)smem + w * (64 * 68);
#pragma unroll
    for (int a = 0; a < 4; ++a)
#pragma unroll
      for (int b = 0; b < NT; ++b)
#pragma unroll
        for (int i = 0; i < 4; ++i) ct[(a * 16 + 4 * lq + i) * 68 + b * 16 + lc] = tot[a][b][i];
#pragma unroll 8
    for (int it = lane; it < 512; it += 64) {
      const int rl = it >> 3, c8 = (it & 7) * 8;
      float4 v0 = *(const float4*)(ct + rl * 68 + c8), v1 = *(const float4*)(ct + rl * 68 + c8 + 4);
      *(uint4*)(o + (size_t)(rbase + rl) * DM + cbase + c8) = make_uint4(pack2(v0.x, v0.y), pack2(v0.z, v0.w), pack2(v1.x, v1.y), pack2(v1.z, v1.w));
    }
  } else if (EPI == EPI_RES) {
    u16* xo = (u16*)(p.ws + OFF_X);
    const bool from_input = (g.res_chunk == 2) && g.l == 0;
    float* ct = (float*)smem + w * (64 * 68);
#pragma unroll
    for (int a = 0; a < 4; ++a)
#pragma unroll
      for (int b = 0; b < NT; ++b)
#pragma unroll
        for (int i = 0; i < 4; ++i) ct[(a * 16 + 4 * lq + i) * 68 + b * 16 + lc] = acc[a][b][i];
#pragma unroll 8
    for (int it = lane; it < 512; it += 64) {
      const int rl = it >> 3, c8 = (it & 7) * 8;
      const int row = rbase + rl, col = cbase + c8;
      float4 v0 = *(const float4*)(ct + rl * 68 + c8), v1 = *(const float4*)(ct + rl * 68 + c8 + 4);
      const float* gate = mod_vec(p, g.l, row, g.res_chunk) + col;
      float4 g0 = *(const float4*)gate, g1 = *(const float4*)(gate + 4);
      float x[8];
      if (from_input) {
        const float* xin = (row < NCTX ? p.in[0] + (size_t)row * DM : p.in[1] + (size_t)(row - NCTX) * DM) + col;
        float4 a0 = *(const float4*)xin, a1 = *(const float4*)(xin + 4);
        x[0] = a0.x; x[1] = a0.y; x[2] = a0.z; x[3] = a0.w; x[4] = a1.x; x[5] = a1.y; x[6] = a1.z; x[7] = a1.w;
      } else {
        uint4 xb = *(const uint4*)(xo + (size_t)row * DM + col);
        x[0] = __uint_as_float(xb.x << 16); x[1] = __uint_as_float(xb.x & 0xffff0000u);
        x[2] = __uint_as_float(xb.y << 16); x[3] = __uint_as_float(xb.y & 0xffff0000u);
        x[4] = __uint_as_float(xb.z << 16); x[5] = __uint_as_float(xb.z & 0xffff0000u);
        x[6] = __uint_as_float(xb.w << 16); x[7] = __uint_as_float(xb.w & 0xffff0000u);
      }
      x[0] += g0.x * v0.x; x[1] += g0.y * v0.y; x[2] += g0.z * v0.z; x[3] += g0.w * v0.w;
      x[4] += g1.x * v1.x; x[5] += g1.y * v1.y; x[6] += g1.z * v1.z; x[7] += g1.w * v1.w;
      *(uint4*)(xo + (size_t)row * DM + col) = make_uint4(pack2(x[0], x[1]), pack2(x[2], x[3]), pack2(x[4], x[5]), pack2(x[6], x[7]));
    }
  } else if (EPI == EPI_SWIGLU) {
    u16* o = (u16*)(p.ws + OFF_GH);
    float* ct = (float*)smem + w * (64 * 68);
#pragma unroll
    for (int a = 0; a < 4; ++a)
#pragma unroll
      for (int b = 0; b < NT / 2; ++b)
#pragma unroll
        for (int i = 0; i < 4; ++i) ct[(a * 16 + 4 * lq + i) * 68 + b * 16 + lc] = siluf_(acc[a][b][i]) * acc[a][(b + NT / 2) % NT][i];
    const int colb0 = (n0 >> 8) * 128 + wn * 64;
#pragma unroll 8
    for (int it = lane; it < 512; it += 64) {
      const int rl = it >> 3, c8 = (it & 7) * 8;
      float4 v0 = *(const float4*)(ct + rl * 68 + c8), v1 = *(const float4*)(ct + rl * 68 + c8 + 4);
      *(uint4*)(o + (size_t)(rbase + rl) * DFF + colb0 + c8) = make_uint4(pack2(v0.x, v0.y), pack2(v0.z, v0.w), pack2(v1.x, v1.y), pack2(v1.z, v1.w));
    }
  }
}

DI void g1_epilogue_wave(const Params& p, int l, int mrow0, int ncol0, const float* ct, int lane) {
  const bool ctx = mrow0 < NCTX;
  int kind;
  int br;
  int nrel;
  const int n0 = ncol0;
  if (n0 < 512) { kind = 0; br = 0; nrel = n0; }
  else if (n0 < 1024) { kind = 1; br = 0; nrel = n0 - 512; }
  else if (n0 < 1536) { kind = 2; br = 0; nrel = n0 - 1024; }
  else if (n0 < 2048) { kind = 0; br = 1; nrel = n0 - 1536; }
  else if (n0 < 2176) { kind = 1; br = 1; nrel = n0 - 2048; }
  else if (n0 < 2304) { kind = 2; br = 1; nrel = n0 - 2176; }
  else if (n0 < 2816) { kind = 0; br = 2; nrel = n0 - 2304; }
  else if (n0 < 2944) { kind = 1; br = 2; nrel = n0 - 2816; }
  else { kind = 2; br = 2; nrel = n0 - 2944; }

  if (kind < 2) {
    const int j = lane & 7, grp = lane >> 3;
    const float* cosT = (const float*)(p.ws + OFF_ROPE);
    const float* sinT = cosT + 1024 * 32;
    const float* gn = (kind == 0 ? p.in[20] : p.in[21]) + l * 64;
    for (int rl = grp; rl < 64; rl += 8) {
      const int row = mrow0 + rl;
      const float* cp = ct + rl * 68;
      float4 lo = *(const float4*)(cp + 4 * j), hi = *(const float4*)(cp + 32 + 4 * j);
      if (br == 1) {
        float ss = lo.x * lo.x + lo.y * lo.y + lo.z * lo.z + lo.w * lo.w + hi.x * hi.x + hi.y * hi.y + hi.z * hi.z + hi.w * hi.w;
        ss += __shfl_xor(ss, 1); ss += __shfl_xor(ss, 2); ss += __shfl_xor(ss, 4);
        float rs = rsqrtf(ss * (1.f / 64.f) + 1e-6f);
        float4 g0 = *(const float4*)(gn + 4 * j), g1 = *(const float4*)(gn + 32 + 4 * j);
        lo.x *= rs * g0.x; lo.y *= rs * g0.y; lo.z *= rs * g0.z; lo.w *= rs * g0.w;
        hi.x *= rs * g1.x; hi.y *= rs * g1.y; hi.z *= rs * g1.z; hi.w *= rs * g1.w;
      }
      if (!ctx) {
        const int pos = (row - NCTX) & 1023;
        float4 c = *(const float4*)(cosT + pos * 32 + 4 * j), sn = *(const float4*)(sinT + pos * 32 + 4 * j);
        float4 nlo = make_float4(lo.x * c.x - hi.x * sn.x, lo.y * c.y - hi.y * sn.y, lo.z * c.z - hi.z * sn.z, lo.w * c.w - hi.w * sn.w);
        float4 nhi = make_float4(hi.x * c.x + lo.x * sn.x, hi.y * c.y + lo.y * sn.y, hi.z * c.z + lo.z * sn.z, hi.w * c.w + lo.w * sn.w);
        lo = nlo; hi = nhi;
      }
      const int nc = nrel;
      if (kind == 0) {
        u16* q = (u16*)(p.ws + OFF_Q) + (size_t)row * 1536 + br * 512 + nc;
        *(uint2*)(q + 4 * j) = make_uint2(pack2(lo.x * 0.125f, lo.y * 0.125f), pack2(lo.z * 0.125f, lo.w * 0.125f));
        *(uint2*)(q + 32 + 4 * j) = make_uint2(pack2(hi.x * 0.125f, hi.y * 0.125f), pack2(hi.z * 0.125f, hi.w * 0.125f));
      } else {
        const int hd = (br == 0) ? 128 : 64, nh = (br == 0) ? 4 : 2;
        const int head = nc / hd, d = nc % hd;
        u16* kd;
        if (ctx) {
          const int b = row >> 8, key = row & 255;
          kd = KVC(p.ws, br) + ((size_t)(b * nh + head) * 256 + key) * hd + d;
          float* od = p.out + (br == 0 ? O_AK : (br == 1 ? O_BK : O_CK)) + ((size_t)((b * 4 + l) * 256 + key) * nh + head) * hd + d;
          st_nt4(od + 4 * j, lo);
          st_nt4(od + 32 + 4 * j, hi);
        } else {
          const int b = (row - NCTX) >> 10, pos = (row - NCTX) & 1023;
          kd = KVL(p.ws, l, br) + ((size_t)(b * nh + head) * 1536 + 512 + pos) * hd + d;
        }
        *(uint2*)(kd + 4 * j) = make_uint2(pack2(lo.x, lo.y), pack2(lo.z, lo.w));
        *(uint2*)(kd + 32 + 4 * j) = make_uint2(pack2(hi.x, hi.y), pack2(hi.z, hi.w));
      }
    }
  } else {
    const int nrows = (br == 0) ? 512 : 128;
    for (int it = lane; it < 256; it += 64) {
      const int gq = it & 3, c = it >> 2;
      const int row0 = mrow0 + gq * 16;
      float v[16];
#pragma unroll
      for (int i = 0; i < 16; ++i) v[i] = ct[(gq * 16 + i) * 68 + c];
      u16* vd;
      if (ctx) {
        const int b = row0 >> 8, key = row0 & 255;
        vd = KVC(p.ws, 3 + br) + ((size_t)b * nrows + nrel + c) * 256 + key;
      } else {
        const int b = (row0 - NCTX) >> 10, pos = (row0 - NCTX) & 1023;
        vd = KVL(p.ws, l, 3 + br) + ((size_t)b * nrows + nrel + c) * 1536 + 512 + pos;
      }
      *(uint4*)vd = make_uint4(pack2(v[0], v[1]), pack2(v[2], v[3]), pack2(v[8], v[9]), pack2(v[10], v[11]));
      *(uint4*)(vd + 8) = make_uint4(pack2(v[4], v[5]), pack2(v[6], v[7]), pack2(v[12], v[13]), pack2(v[14], v[15]));
    }
    if (ctx) {
      float* ob = p.out + (br == 0 ? O_AV : (br == 1 ? O_BV : O_CV));
      for (int it = lane; it < 1024; it += 64) {
        const int rl = it >> 4, c4 = (it & 15) * 4;
        const int row = mrow0 + rl, b = row >> 8, key = row & 255;
        float4 v = *(const float4*)(ct + rl * 68 + c4);
        st_nt4(ob + (size_t)((b * 4 + l) * 256 + key) * nrows + nrel + c4, v);
      }
    }
  }
}

template <int EPI, int BN>
DI void gemm_phase(const Params& p, const GemmArgs& g, int ntn, unsigned char* smem) {
  if (gridDim.x == 256) {
    const int xcd = blockIdx.x & 7, j = blockIdx.x >> 3;
    for (int il = j; il < 4 * ntn; il += 32) {
      const int mt = 4 * xcd + (il & 3), nt = il >> 2;
      gemm_tile<EPI, BN>(p, g, mt * 256, nt * BN, smem);
    }
  } else {
    const int ntiles = 32 * ntn;
    for (int tile = blockIdx.x; tile < ntiles; tile += gridDim.x) {
      const int mt = tile / ntn, nt = tile % ntn;
      gemm_tile<EPI, BN>(p, g, mt * 256, nt * BN, smem);
    }
  }
}

constexpr float LOG2E = 1.4426950408889634f;
constexpr int N_ATT_ITEMS = 768;
constexpr int VT_PITCH = 144;

DI void load_q(bf16x8 (&qf)[4], const u16* Q, int row, int coloff, int h) {
  const u16* qp = Q + (size_t)row * 1536 + coloff + 8 * h;
#pragma unroll
  for (int s = 0; s < 4; ++s) qf[s] = __builtin_nontemporal_load((const bf16x8*)(qp + 16 * s));
}

template <int DV, int KD>
DI void attn_item(f32x16 (&o)[DV / 32], unsigned char* smem, const u16* __restrict__ Kg, const u16* __restrict__ Vg, int nkeys,
                  int n_tiles, int band_t0, const bf16x8 (&qf)[4], int koff, bool has_band, int qpos, float m_init, float l_init) {
  constexpr int KPITCH = KD * 2 + 16;
  constexpr int KBYTES = 64 * KPITCH;
  constexpr int VBYTES = DV * VT_PITCH;
  constexpr int BUF = KBYTES + VBYTES;
  constexpr int KCH = KD / 8;
  constexpr int NK = KD / 64;
  constexpr int NV = DV / 64;
  const int t = tid_(), lane = t & 63, r = lane & 31, h = lane >> 5;
  const int krow = t / KCH, kkc = t % KCH;
  const int vrow = t >> 3, vkc = t & 7;
  const u16* kgp = Kg + (size_t)krow * KD + kkc * 8;
  const u16* vgp = Vg + (size_t)vrow * nkeys + vkc * 8;
  const int klds = krow * KPITCH + kkc * 16;
  const int vlds = KBYTES + vrow * VT_PITCH + vkc * 16;
  uint4 k0, k1, v0, v1;
  k1 = v1 = make_uint4(0, 0, 0, 0);
#define ATT_TILE(i) ((i) < 8 || !has_band ? (i) : 8 + band_t0 + (i) - 8)
#define ATT_GLOAD(TI)                                                                   \
  {                                                                                     \
    const size_t key0_ = (size_t)(TI) * 64;                                             \
    k0 = *(const uint4*)(kgp + key0_ * KD);                                             \
    if (NK == 2) k1 = *(const uint4*)(kgp + (key0_ + 32) * KD);                         \
    v0 = *(const uint4*)(vgp + key0_);                                                  \
    if (NV == 2) v1 = *(const uint4*)(vgp + key0_ + (size_t)64 * nkeys);                \
  }
#define ATT_LSTORE(DST)                                                                 \
  {                                                                                     \
    *(uint4*)((DST) + klds) = k0;                                                       \
    if (NK == 2) *(uint4*)((DST) + klds + 32 * KPITCH) = k1;                            \
    *(uint4*)((DST) + vlds) = v0;                                                       \
    if (NV == 2) *(uint4*)((DST) + vlds + 64 * VT_PITCH) = v1;                          \
  }
  float m = m_init, l = l_init;
#pragma unroll
  for (int dt = 0; dt < DV / 32; ++dt)
#pragma unroll
    for (int i = 0; i < 16; ++i) o[dt][i] = 0.f;

  ATT_GLOAD(ATT_TILE(0))
  __syncthreads();
  ATT_LSTORE(smem)
  __syncthreads();
  for (int it = 0; it < n_tiles; ++it) {
    const int cur = it & 1;
    const int tile = ATT_TILE(it);
    if (it + 1 < n_tiles) ATT_GLOAD(ATT_TILE(it + 1))
    const unsigned char* kb = smem + cur * BUF + r * KPITCH + (koff + 8 * h) * 2;
    const unsigned char* vb = smem + cur * BUF + KBYTES + r * VT_PITCH + 16 * h;
    f32x16 S0, S1;
#pragma unroll
    for (int i = 0; i < 16; ++i) { S0[i] = 0.f; S1[i] = 0.f; }
#pragma unroll
    for (int s = 0; s < 4; ++s) {
      bf16x8 ka = *(const bf16x8*)(kb + 32 * s);
      bf16x8 kc = *(const bf16x8*)(kb + 32 * KPITCH + 32 * s);
      S0 = MFMA32(ka, qf[s], S0);
      S1 = MFMA32(kc, qf[s], S1);
    }
    if (has_band && it >= 8) {
      const int kbase = (tile - 8) * 64 - qpos;
#pragma unroll
      for (int i = 0; i < 16; ++i) {
        int d0 = kbase + crow(i, h), d1 = d0 + 32;
        if (d0 < -128 || d0 > 128) S0[i] = -1e30f;
        if (d1 < -128 || d1 > 128) S1[i] = -1e30f;
      }
    }
    float mx = fmaxf(S0[0], S1[0]);
#pragma unroll
    for (int i = 1; i < 16; ++i) mx = __builtin_fmaxf(__builtin_fmaxf(mx, S0[i]), S1[i]);
    mx = fmaxf(mx, __shfl_xor(mx, 32));
    const float mn = fmaxf(m, mx);
    const float mb = mn * LOG2E;
    float ps;
    {
      const f2_t sc2 = {LOG2E, LOG2E}, nb2 = {-mb, -mb};
      f2_t ps2 = {0.f, 0.f};
#pragma unroll
      for (int i = 0; i < 8; ++i) {
        f2_t a = {S0[2 * i], S0[2 * i + 1]}, b = {S1[2 * i], S1[2 * i + 1]};
        a = __builtin_elementwise_fma(a, sc2, nb2);
        b = __builtin_elementwise_fma(b, sc2, nb2);
        a.x = __builtin_amdgcn_exp2f(a.x); a.y = __builtin_amdgcn_exp2f(a.y);
        b.x = __builtin_amdgcn_exp2f(b.x); b.y = __builtin_amdgcn_exp2f(b.y);
        S0[2 * i] = a.x; S0[2 * i + 1] = a.y; S1[2 * i] = b.x; S1[2 * i + 1] = b.y;
        ps2 += a; ps2 += b;
      }
      ps = ps2.x + ps2.y;
    }
    if (__any(mn != m)) {
      const float alpha = __builtin_amdgcn_exp2f((m - mn) * LOG2E);
      l *= alpha;
#pragma unroll
      for (int dt = 0; dt < DV / 32; ++dt)
#pragma unroll
        for (int i = 0; i < 16; ++i) o[dt][i] *= alpha;
      m = mn;
    }
    l += ps;
    bf16x8 pf0, pf1, pf2, pf3;
    {
      uint4 u;
      u = make_uint4(pack2(S0[0], S0[1]), pack2(S0[2], S0[3]), pack2(S0[4], S0[5]), pack2(S0[6], S0[7])); pf0 = __builtin_bit_cast(bf16x8, u);
      u = make_uint4(pack2(S0[8], S0[9]), pack2(S0[10], S0[11]), pack2(S0[12], S0[13]), pack2(S0[14], S0[15])); pf1 = __builtin_bit_cast(bf16x8, u);
      u = make_uint4(pack2(S1[0], S1[1]), pack2(S1[2], S1[3]), pack2(S1[4], S1[5]), pack2(S1[6], S1[7])); pf2 = __builtin_bit_cast(bf16x8, u);
      u = make_uint4(pack2(S1[8], S1[9]), pack2(S1[10], S1[11]), pack2(S1[12], S1[13]), pack2(S1[14], S1[15])); pf3 = __builtin_bit_cast(bf16x8, u);
    }
#pragma unroll
    for (int dt = 0; dt < DV / 32; ++dt) {
      const unsigned char* vp = vb + dt * 32 * VT_PITCH;
      o[dt] = MFMA32(*(const bf16x8*)(vp), pf0, o[dt]);
      o[dt] = MFMA32(*(const bf16x8*)(vp + 32), pf1, o[dt]);
      o[dt] = MFMA32(*(const bf16x8*)(vp + 64), pf2, o[dt]);
      o[dt] = MFMA32(*(const bf16x8*)(vp + 96), pf3, o[dt]);
    }
    if (it + 1 < n_tiles) {
      unsigned char* dst = smem + (cur ^ 1) * BUF;
      ATT_LSTORE(dst)
    }
    __syncthreads();
  }
  const float lt = l + __shfl_xor(l, 32);
  const float inv = 1.f / lt;
#pragma unroll
  for (int dt = 0; dt < DV / 32; ++dt)
#pragma unroll
    for (int i = 0; i < 16; ++i) o[dt][i] *= inv;
}

DI void attn_phase(const Params& p, int l, int ph, unsigned char* smem) {
  __shared__ int s_item;
  const int t = tid_(), lane = t & 63, wv = t >> 6, r = lane & 31, h = lane >> 5;
  const u16* Q = (const u16*)(p.ws + OFF_Q);
  u16* AO = (u16*)(p.ws + OFF_ATT);
  unsigned* ctr = (unsigned*)(p.ws + OFF_BAR + 14336) + ph;
  float lam;
  {
    float a = p.in[15][l * 64 + lane] * p.in[16][l * 64 + lane];
    float b = p.in[17][l * 64 + lane] * p.in[18][l * 64 + lane];
    a = wave_sum(a); b = wave_sum(b);
    lam = __expf(a) - __expf(b) + p.lam_init[l];
  }
  const float one_m_li = 1.f - p.lam_init[l];
  const bool static_first = gridDim.x == 256;
  int round = 0;
  for (;;) {
    __syncthreads();
    if (t == 0) {
      const int xcd = blockIdx.x & 7, j = blockIdx.x >> 3;
      if (round == 0 && static_first) {
        if (j < 16) { const int g = 2 * xcd + (j >> 3); s_item = (g >> 2) * 32 + (g & 3) * 8 + (j & 7); }
        else s_item = 128 + (xcd >> 1) * 32 + (xcd & 1) * 16 + (j - 16);
      } else if (round == 1 && static_first && j >= 16) {
        s_item = 256 + (xcd >> 1) * 32 + (xcd & 1) * 16 + (j - 16);
      } else {
        s_item = (static_first ? 384 : 0) + (int)atomicAdd(ctr, 1u);
      }
    }
    ++round;
    __syncthreads();
    const int it = s_item;
    if (it >= N_ATT_ITEMS) break;
    const int cls = it >> 7, i = it & 127;
    const int lat = cls < 3, br = cls % 3;
    const int nkeys = lat ? 1536 : 256;
    if (br == 0) {
      int b, hd, qb;
      if (lat) { b = i >> 5; hd = (i >> 3) & 3; qb = i & 7; } else { b = i >> 3; hd = (i >> 1) & 3; qb = i & 1; }
      const int pass = wv >> 2;
      const int row = (lat ? NCTX + b * 1024 : b * 256) + qb * 128 + (wv & 3) * 32 + r;
      const u16* Kb = (lat ? KVL(p.ws, l, 0) : KVC(p.ws, 0)) + (size_t)(b * 4 + hd) * nkeys * 128;
      const u16* Vb = (lat ? KVL(p.ws, l, 3) : KVC(p.ws, 3)) + (size_t)(b * 4 + hd) * 128 * nkeys;
      bf16x8 qf[4];
      load_q(qf, Q, row, hd * 128 + pass * 64, h);
      f32x16 o[4];
      attn_item<128, 128>(o, smem, Kb, Vb, nkeys, nkeys / 64, 0, qf, pass * 64, false, 0, -1e30f, 0.f);
      float* stash = (float*)smem + (wv & 3) * 4096;
      if (pass == 1) {
#pragma unroll
        for (int dt = 0; dt < 4; ++dt)
#pragma unroll
          for (int q = 0; q < 16; ++q) stash[(dt * 16 + q) * 64 + lane] = o[dt][q];
      }
      __syncthreads();
      if (pass == 0) {
        float ss = 0.f;
#pragma unroll
        for (int dt = 0; dt < 4; ++dt)
#pragma unroll
          for (int q = 0; q < 16; ++q) {
            float v = o[dt][q] - lam * stash[(dt * 16 + q) * 64 + lane];
            o[dt][q] = v;
            ss += v * v;
          }
        ss += __shfl_xor(ss, 32);
        const float rs = rsqrtf(ss * (1.f / 128.f) + 1e-6f) * one_m_li;
        const float* sg = p.in[19] + l * 128;
        u16* tl = (u16*)(smem + 65536 + wv * 8704);
#pragma unroll
        for (int dt = 0; dt < 4; ++dt)
#pragma unroll
          for (int g4 = 0; g4 < 4; ++g4) {
            const int d = dt * 32 + 8 * g4 + 4 * h;
            float4 gg = *(const float4*)(sg + d);
            unsigned w0 = pack2(o[dt][4 * g4] * rs * gg.x, o[dt][4 * g4 + 1] * rs * gg.y);
            unsigned w1 = pack2(o[dt][4 * g4 + 2] * rs * gg.z, o[dt][4 * g4 + 3] * rs * gg.w);
            *(uint2*)(tl + r * 136 + d) = make_uint2(w0, w1);
          }
        u16* ob = AO + (size_t)(row - r) * 1536 + hd * 128;
#pragma unroll
        for (int q = 0; q < 8; ++q) {
          const int itx = lane + 64 * q, rr = itx >> 4, c8 = (itx & 15) * 8;
          *(uint4*)(ob + (size_t)rr * 1536 + c8) = *(const uint4*)(tl + rr * 136 + c8);
        }
      }
    } else {
      int b, kvh, qg;
      if (lat) { b = i >> 5; kvh = (i >> 4) & 1; qg = i & 15; } else { b = i >> 3; kvh = (i >> 2) & 1; qg = i & 3; }
      const int hd = kvh * 4 + (wv & 3), qsub = wv >> 2;
      const int row = (lat ? NCTX + b * 1024 : b * 256) + qg * 64 + qsub * 32 + r;
      const u16* Kb = (lat ? KVL(p.ws, l, br) : KVC(p.ws, br)) + (size_t)(b * 2 + kvh) * nkeys * 64;
      const u16* Vb = (lat ? KVL(p.ws, l, 3 + br) : KVC(p.ws, 3 + br)) + (size_t)(b * 2 + kvh) * 64 * nkeys;
      bf16x8 qf[4];
      load_q(qf, Q, row, br * 512 + hd * 64, h);
      f32x16 o[2];
      const bool band = (br == 2) && lat;
      int n_tiles = nkeys / 64, t0 = 0;
      if (band) {
        const int q0 = qg * 64;
        t0 = (q0 - 128) < 0 ? 0 : (q0 - 128) >> 6;
        int t1 = (q0 + 191) >> 6; if (t1 > 15) t1 = 15;
        n_tiles = 8 + (t1 - t0 + 1);
      }
      const float m0 = (br == 2) ? p.in[22][l * 8 + hd] : -1e30f;
      const float l0 = (br == 2 && h == 0) ? 1.f : 0.f;
      attn_item<64, 64>(o, smem, Kb, Vb, nkeys, n_tiles, t0, qf, 0, band, qg * 64 + qsub * 32 + r, m0, l0);
      u16* tl = (u16*)(smem + 65536 + wv * 8704);
#pragma unroll
      for (int dt = 0; dt < 2; ++dt)
#pragma unroll
        for (int g4 = 0; g4 < 4; ++g4) {
          const int d = dt * 32 + 8 * g4 + 4 * h;
          unsigned w0 = pack2(o[dt][4 * g4], o[dt][4 * g4 + 1]);
          unsigned w1 = pack2(o[dt][4 * g4 + 2], o[dt][4 * g4 + 3]);
          *(uint2*)(tl + r * 72 + d) = make_uint2(w0, w1);
        }
      u16* ob = AO + (size_t)(row - r) * 1536 + br * 512 + hd * 64;
#pragma unroll
      for (int q = 0; q < 4; ++q) {
        const int itx = lane + 64 * q, rr = itx >> 3, c8 = (itx & 7) * 8;
        *(uint4*)(ob + (size_t)rr * 1536 + c8) = *(const uint4*)(tl + rr * 72 + c8);
      }
    }
  }
}

#define XB_TMO      128
#define XB_XCNT(j)  (256  + 64 * (j))
#define XB_XSUB(j)  (1280 + 64 * (j))
#define XB_XGEN(j)  (2304 + 64 * (j))
#define XB_TOP      3328
#define XB_TOPGEN   3392
#define XCD_BAR_WORDS 3456
#define XB_SPIN_CAP (1u << 22)
DI unsigned xb_ld(unsigned* p) { return __hip_atomic_load(p, __ATOMIC_RELAXED, __HIP_MEMORY_SCOPE_AGENT); }
DI unsigned xb_add(unsigned* p, unsigned v) { return __hip_atomic_fetch_add(p, v, __ATOMIC_RELAXED, __HIP_MEMORY_SCOPE_AGENT); }
DI unsigned xb_xcc_id() { return (unsigned)__builtin_amdgcn_s_getreg((3 << 11) | 20) & 0xFu; }
#define XB_SPIN(cond, bar) do { unsigned _sp = 0; while (cond) { __builtin_amdgcn_s_sleep(1); \
    if ((++_sp & 255u) == 0u) { if (xb_ld(&(bar)[XB_TMO])) break; if (_sp > XB_SPIN_CAP) { atomicAdd(&(bar)[XB_TMO], 1u); break; } } } } while (0)
struct XcdBarrier { unsigned* bar; unsigned x; volatile LAS unsigned* st; };
DI XcdBarrier xcd_barrier_post(unsigned* bar, volatile LAS unsigned* st) {
  XcdBarrier b; b.bar = bar; b.x = xb_xcc_id(); b.st = st;
  if (threadIdx.x == 0) (void)xb_add(&bar[XB_XCNT(b.x)], 1u);
  return b;
}
DI void xcd_barrier_complete(unsigned* bar, unsigned x, unsigned& nloc, unsigned& nx) {
  const unsigned G = gridDim.x * gridDim.y * gridDim.z;
  unsigned sum, cnt, mine, sp = 0u;
  for (;;) {
    sum = 0u; cnt = 0u; mine = 0u;
#pragma unroll
    for (unsigned j = 0; j < 16; ++j) { const unsigned c = xb_ld(&bar[XB_XCNT(j)]); sum += c; cnt += (c > 0u) ? 1u : 0u; mine = (j == x) ? c : mine; }
    if (sum == G) break;
    __builtin_amdgcn_s_sleep(1);
    if ((++sp & 255u) == 0u) { if (xb_ld(&bar[XB_TMO])) break; if (sp > XB_SPIN_CAP) { atomicAdd(&bar[XB_TMO], 1u); break; } }
  }
  nloc = mine > 0u ? mine : 1u; nx = cnt > 0u ? cnt : 1u;
}
DI void xcd_barrier(const XcdBarrier& b) {
  asm volatile("s_waitcnt vmcnt(0)" ::: "memory");
  __syncthreads();
  if (threadIdx.x == 0) {
    unsigned* bar = b.bar;
    __builtin_amdgcn_s_waitcnt(0);
    unsigned nloc = b.st[0], nx = b.st[1];
    if (nloc == 0u) { xcd_barrier_complete(bar, b.x, nloc, nx); b.st[0] = nloc; b.st[1] = nx; }
    const unsigned old = xb_add(&bar[XB_XSUB(b.x)], 1u);
    const unsigned gen = old / nloc;
    if (old + 1u == (gen + 1u) * nloc) {
      __builtin_amdgcn_fence(__ATOMIC_RELEASE, "agent");
      asm volatile("s_waitcnt vmcnt(0)" ::: "memory");
      const unsigned og = xb_add(&bar[XB_TOP], 1u);
      const unsigned tg = og / nx;
      if (og + 1u == (tg + 1u) * nx) xb_add(&bar[XB_TOPGEN], 1u);
      else XB_SPIN(xb_ld(&bar[XB_TOPGEN]) == tg, bar);
      __builtin_amdgcn_fence(__ATOMIC_ACQUIRE, "agent");
      xb_add(&bar[XB_XGEN(b.x)], 1u);
      asm volatile("s_waitcnt vmcnt(0)" ::: "memory");
    } else {
      XB_SPIN(xb_ld(&bar[XB_XGEN(b.x)]) == gen, bar);
      __builtin_amdgcn_fence(__ATOMIC_ACQUIRE, "agent");
      asm volatile("s_waitcnt vmcnt(0)" ::: "memory");
    }
  }
  __syncthreads();
}

__global__ void __launch_bounds__(512, 2) fwd_megakernel(Params p) {
  __shared__ __attribute__((aligned(16))) unsigned char smem[SMEM_BYTES];
  __shared__ uint4 xb_words;
  cg::grid_group grid = cg::this_grid();
  if (threadIdx.x == 0) xb_words = make_uint4(0u, 0u, 0u, 0u);
  __syncthreads();
  XcdBarrier xb = xcd_barrier_post((unsigned*)(p.ws + OFF_BAR), (volatile LAS unsigned*)&xb_words);
  for (int ph = p.ph_lo; ph < p.ph_hi; ++ph) {
    if (ph > p.ph_lo) {
      if (p.ph_hi > 4096) grid.sync();
      xcd_barrier(xb);
    }
    if (ph == 0) { pre_phase(p, (float*)smem); continue; }
    if (ph == NPH - 1) { norm_phase(p, 0, 2); continue; }
    const int l = (ph - 1) / SEQ_N, sub = (int)((SEQ_PACK >> (4 * ((ph - 1) % SEQ_N))) & 15ull);
    GemmArgs g;
    g.l = l; g.res_chunk = 0;
    switch (sub) {
      case 0: norm_phase(p, l, 0); break;
#ifndef DIS1
      case 1:
        g.A = (const u16*)(p.ws + OFF_HM); g.lda = DM; g.Bt = Wt_in(p.ws, l); g.ldb = DM; g.K = DM;
        gemm_phase<EPI_G1, 256>(p, g, DIN / 256, smem);
        break;
#endif
#ifndef DIS2
      case 2: attn_phase(p, l, ph, smem); break;
#endif
#ifndef DIS3
      case 3:
        g.A = (const u16*)(p.ws + OFF_ATT); g.lda = 1536; g.Bt = Wt_br(p.ws, l); g.ldb = 1536; g.K = 1536;
        gemm_phase<EPI_G2, 128>(p, g, DM / 128, smem);
        break;
#endif
      case 4:
        g.A = (const u16*)(p.ws + OFF_HM); g.lda = DM; g.Bt = Wt_out(p.ws, l); g.ldb = DM; g.K = DM; g.res_chunk = 2;
        gemm_phase<EPI_RES, 128>(p, g, DM / 128, smem);
        break;
      case 5: norm_phase(p, l, 1); break;
      case 6:
        g.A = (const u16*)(p.ws + OFF_HM); g.lda = DM; g.Bt = Wt_f1(p.ws, l); g.ldb = DM; g.K = DM;
        gemm_phase<EPI_SWIGLU, 256>(p, g, 2 * DFF / 256, smem);
        break;
      default:
        g.A = (const u16*)(p.ws + OFF_GH); g.lda = DFF; g.Bt = Wt_f2(p.ws, l); g.ldb = DFF; g.K = DFF; g.res_chunk = 5;
        gemm_phase<EPI_RES, 128>(p, g, DM / 128, smem);
        break;
    }
  }
}

extern "C" void kernel_launch(void* const* d_in, const int* in_sizes, int n_in, void* d_out, int out_size, void* d_ws, size_t ws_size,
                              hipStream_t stream) {
  static int grid_blocks = 0;
  if (!grid_blocks) {
    int dev = 0, cus = 0, per_cu = 0;
    hipGetDevice(&dev);
    hipDeviceGetAttribute(&cus, hipDeviceAttributeMultiprocessorCount, dev);
    hipOccupancyMaxActiveBlocksPerMultiprocessor(&per_cu, fwd_megakernel, 512, 0);
    if (per_cu < 1) per_cu = 1;
    if (per_cu > 1) per_cu = 1;
    grid_blocks = cus * per_cu;
    if (ws_size < WS_END) fprintf(stderr, "kernel_launch: workspace too small: %zu < %zu\n", ws_size, (size_t)WS_END);
  }
  Params p{};
  for (int i = 0; i < 30; ++i) p.in[i] = (const float*)d_in[i];
  p.out = (float*)d_out;
  p.ws = (unsigned char*)d_ws;
  for (int l = 0; l < 4; ++l) p.lam_init[l] = (float)(0.8 - 0.6 * exp(-0.3 * l));
  hipMemsetAsync((unsigned char*)d_ws + OFF_BAR, 0, 16384, stream);
#if ONE_LAUNCH
  p.ph_lo = 0; p.ph_hi = NPH;
  void* args[] = {&p};
  hipError_t e = hipLaunchCooperativeKernel((void*)fwd_megakernel, dim3(grid_blocks), dim3(512), args, 0, stream);
  if (e != hipSuccess) fprintf(stderr, "cooperative launch failed: %s (grid %d)\n", hipGetErrorString(e), grid_blocks);
#else
  for (int ph = 0; ph < NPH; ++ph) {
    p.ph_lo = ph; p.ph_hi = ph + 1;
    hipLaunchKernelGGL(fwd_megakernel, dim3(grid_blocks), dim3(512), 0, stream, p);
  }
#endif
}
```

```cpp
#include <hip/hip_runtime.h>
#include <hip/hip_cooperative_groups.h>
#include <cstdio>
#include <cstdint>
#include <cmath>
namespace cg = cooperative_groups;

#ifndef ONE_LAUNCH
#define ONE_LAUNCH 1
#endif

typedef unsigned short u16;
typedef __attribute__((ext_vector_type(8))) short bf16x8;
typedef __attribute__((ext_vector_type(4))) short s16x4;
typedef __attribute__((ext_vector_type(16))) float f32x16;
typedef __attribute__((ext_vector_type(4))) float f32x4;
typedef __attribute__((ext_vector_type(2))) unsigned u32x2;
typedef __attribute__((ext_vector_type(4))) unsigned u32x4;
typedef __attribute__((ext_vector_type(2))) __bf16 bf2_t;
typedef __attribute__((ext_vector_type(2))) float f2_t;
#define DI __device__ __forceinline__
#define LAS __attribute__((address_space(3)))
#define MFMA32(a, b, c) __builtin_amdgcn_mfma_f32_32x32x16_bf16((a), (b), (c), 0, 0, 0)

constexpr int DM = 1024, NTOK = 8192, NCTX = 4096;
constexpr int DIN = 6144, DFF = 2816, DEPTH = 4;
#ifndef SEQ_PACK
#define SEQ_PACK 0x76543210ull
#define SEQ_N 8
#endif
constexpr int NPH = 2 + SEQ_N * DEPTH;

constexpr size_t SZ_WIN = (size_t)DIN * DM * 2, SZ_WBR = (size_t)DM * 1536 * 2, SZ_WOUT = (size_t)DM * DM * 2;
constexpr size_t SZ_WF1 = (size_t)2 * DFF * DM * 2, SZ_WF2 = (size_t)DM * DFF * 2;
constexpr size_t SZ_WL = SZ_WIN + SZ_WBR + SZ_WOUT + SZ_WF1 + SZ_WF2;
constexpr size_t OFF_W = 0;
constexpr size_t OFF_MOD = OFF_W + SZ_WL * DEPTH;
constexpr size_t OFF_ROPE = OFF_MOD + (size_t)4 * 5 * 6144 * 4;
constexpr size_t OFF_X = OFF_ROPE + (size_t)2 * 1024 * 32 * 4;
constexpr size_t OFF_HM = OFF_X + (size_t)NTOK * DM * 4;
constexpr size_t OFF_Q = OFF_HM + (size_t)NTOK * DM * 2;
constexpr size_t OFF_GH = OFF_Q + (size_t)NTOK * 1536 * 2;
constexpr size_t OFF_ATT = OFF_GH + (size_t)NTOK * 3072 * 2;
constexpr size_t EL_KA = (size_t)4 * 4 * 1536 * 128, EL_KB = (size_t)4 * 2 * 1536 * 64;
constexpr size_t SZ_KVL = (2 * EL_KA + 4 * EL_KB) * 2;
constexpr size_t OFF_KVL = OFF_ATT + (size_t)NTOK * 1536 * 2;
constexpr size_t EL_KAC = (size_t)16 * 4 * 256 * 128, EL_KBC = (size_t)16 * 2 * 256 * 64;
constexpr size_t OFF_KVC = OFF_KVL + SZ_KVL * DEPTH;
constexpr size_t OFF_BAR = OFF_KVC + (2 * EL_KAC + 4 * EL_KBC) * 2;
constexpr size_t WS_END = OFF_BAR + 16384;

constexpr size_t O_YP = 0, O_YS = 4194304, O_AK = 8388608, O_AV = 16777216, O_BK = 25165824, O_BV = 27262976, O_CK = 29360128, O_CV = 31457280;

struct Params {
  const float* in[30];
  float* out;
  unsigned char* ws;
  float lam_init[4];
  int ph_lo, ph_hi;
};

DI unsigned pack2(float a, float b) { f2_t v = {a, b}; bf2_t r = __builtin_convertvector(v, bf2_t); return __builtin_bit_cast(unsigned, r); }
DI int tid_() { int t = threadIdx.x; asm volatile("" : "+v"(t)); return t; }
DI float4 ld_nt4(const float* p) { f32x4 t = __builtin_nontemporal_load((const f32x4*)p); return make_float4(t[0], t[1], t[2], t[3]); }
DI void st_nt4(float* p, float4 v) { f32x4 t = {v.x, v.y, v.z, v.w}; __builtin_nontemporal_store(t, (f32x4*)p); }
DI void st_nt2(float* p, float2 v) { f2_t t = {v.x, v.y}; __builtin_nontemporal_store(t, (f2_t*)p); }
DI float bf2f(u16 x) { return __uint_as_float(((unsigned)x) << 16); }
DI int crow(int reg, int h) { return (reg & 3) + 8 * (reg >> 2) + 4 * h; }
DI float wave_sum(float v) {
#pragma unroll
  for (int o = 32; o > 0; o >>= 1) v += __shfl_xor(v, o);
  return v;
}
DI float sigmoidf_(float x) { return __builtin_amdgcn_rcpf(1.f + __expf(-x)); }
DI float siluf_(float x) { return x * __builtin_amdgcn_rcpf(1.f + __expf(-x)); }
DI u16 bf16_1(float x) { return (u16)(pack2(x, 0.f) & 0xffffu); }

DI u16* Wt_in(unsigned char* ws, int l) { return (u16*)(ws + OFF_W + SZ_WL * l); }
DI u16* Wt_br(unsigned char* ws, int l) { return (u16*)(ws + OFF_W + SZ_WL * l + SZ_WIN); }
DI u16* Wt_out(unsigned char* ws, int l) { return (u16*)(ws + OFF_W + SZ_WL * l + SZ_WIN + SZ_WBR); }
DI u16* Wt_f1(unsigned char* ws, int l) { return (u16*)(ws + OFF_W + SZ_WL * l + SZ_WIN + SZ_WBR + SZ_WOUT); }
DI u16* Wt_f2(unsigned char* ws, int l) { return (u16*)(ws + OFF_W + SZ_WL * l + SZ_WIN + SZ_WBR + SZ_WOUT + SZ_WF1); }
DI u16* KVL(unsigned char* ws, int l, int which) {
  size_t off = 0;
  if (which >= 1) off += EL_KA;
  if (which >= 2) off += EL_KB;
  if (which >= 3) off += EL_KB;
  if (which >= 4) off += EL_KA;
  if (which >= 5) off += EL_KB;
  return (u16*)(ws + OFF_KVL + SZ_KVL * l) + off;
}
DI u16* KVC(unsigned char* ws, int which) {
  size_t off = 0;
  if (which >= 1) off += EL_KAC;
  if (which >= 2) off += EL_KBC;
  if (which >= 3) off += EL_KBC;
  if (which >= 4) off += EL_KAC;
  if (which >= 5) off += EL_KBC;
  return (u16*)(ws + OFF_KVC) + off;
}
DI const float* x_src(const Params& p, int l, int row) {
  if (l == 0) return row < NCTX ? p.in[0] + (size_t)row * DM : p.in[1] + (size_t)(row - NCTX) * DM;
  return (const float*)(p.ws + OFF_X) + (size_t)row * DM;
}
DI const float* mod_vec(const Params& p, int l, int row, int chunk) {
  int v = row < NCTX ? 4 : ((row - NCTX) >> 10);
  return (const float*)(p.ws + OFF_MOD) + ((size_t)(l * 5 + v) * 6144 + chunk * 1024);
}

template <int NT64>
DI void transpose_tile(const float* __restrict__ src, int ldsrc, int k0, int n0, u16* __restrict__ dst, int ldd, int mode, float* tile) {
  const int t = tid_() & 255;
  __syncthreads();
  {
    const int kk = t >> 4, c4 = (t & 15) * 4;
    float4 v[NT64 * 4];
#pragma unroll
    for (int q = 0; q < NT64; ++q)
#pragma unroll
      for (int i = 0; i < 4; ++i) { f32x4 t_ = __builtin_nontemporal_load((const f32x4*)(src + (size_t)(k0 + kk + 16 * i) * ldsrc + n0 + 64 * q + c4)); v[q * 4 + i] = make_float4(t_[0], t_[1], t_[2], t_[3]); }
#pragma unroll
    for (int q = 0; q < NT64; ++q)
#pragma unroll
      for (int i = 0; i < 4; ++i) {
        float* tp = tile + q * 4160 + (kk + 16 * i) * 65 + c4;
        tp[0] = v[q * 4 + i].x; tp[1] = v[q * 4 + i].y; tp[2] = v[q * 4 + i].z; tp[3] = v[q * 4 + i].w;
      }
  }
  __syncthreads();
  const int n = t >> 2, kc = (t & 3) * 16;
#pragma unroll
  for (int q = 0; q < NT64; ++q) {
    const float* tq = tile + q * 4160;
    const int n0q = n0 + 64 * q;
    unsigned w[8];
#pragma unroll
    for (int j = 0; j < 8; ++j) w[j] = pack2(tq[(kc + 2 * j) * 65 + n], tq[(kc + 2 * j + 1) * 65 + n]);
    int drow;
    if (mode != 1) drow = n0q + n;
    else {
      int isb = n0q >= DFF;
      int c0 = n0q - (isb ? DFF : 0);
      drow = (c0 >> 7) * 256 + ((c0 >> 6) & 1) * 128 + isb * 64 + n;
    }
    uint4* dp = (uint4*)(dst + (size_t)drow * ldd + k0 + kc);
    if (mode == 2) {
      dp[0] = make_uint4(w[0], w[1], w[4], w[5]);
      dp[1] = make_uint4(w[2], w[3], w[6], w[7]);
    } else {
      dp[0] = make_uint4(w[0], w[1], w[2], w[3]);
      dp[1] = make_uint4(w[4], w[5], w[6], w[7]);
    }
  }
}

DI void mod_task(const Params& p, int l, int cgp, float* sm) {
  float* sv = sm;
  float* red = sm + 5 * 1024;
  const int t = tid_() & 255;
  __syncthreads();
  for (int e = t; e < 5 * 1024; e += 256) {
    int v = e >> 10, k = e & 1023;
    float x = v < 4 ? p.in[8][v * 1024 + k] : p.in[9][k];
    sv[e] = siluf_(x);
  }
  __syncthreads();
  const int c4 = t & 31, ks = t >> 5;
  const float* w = p.in[10] + (size_t)l * 1024 * 6144 + cgp * 128 + c4 * 4;
  float acc[5][4];
#pragma unroll
  for (int v = 0; v < 5; ++v) { acc[v][0] = acc[v][1] = acc[v][2] = acc[v][3] = 0.f; }
#pragma unroll 8
  for (int k = ks * 128; k < ks * 128 + 128; ++k) {
    f32x4 wt_ = __builtin_nontemporal_load((const f32x4*)(w + (size_t)k * 6144));
    float4 wv = make_float4(wt_[0], wt_[1], wt_[2], wt_[3]);
#pragma unroll
    for (int v = 0; v < 5; ++v) {
      float s = sv[v * 1024 + k];
      acc[v][0] += s * wv.x; acc[v][1] += s * wv.y; acc[v][2] += s * wv.z; acc[v][3] += s * wv.w;
    }
  }
#pragma unroll
  for (int v = 0; v < 5; ++v)
#pragma unroll
    for (int j = 0; j < 4; ++j) red[(ks * 32 + c4) * 20 + v * 4 + j] = acc[v][j];
  __syncthreads();
  for (int o = t; o < 640; o += 256) {
    int cc = o / 20, r = o % 20, v = r >> 2, j = r & 3;
    float s = 0.f;
#pragma unroll
    for (int q = 0; q < 8; ++q) s += red[(q * 32 + cc) * 20 + r];
    int col = cgp * 128 + cc * 4 + j;
    s += p.in[11][l * 6144 + col];
    ((float*)(p.ws + OFF_MOD))[(size_t)(l * 5 + v) * 6144 + col] = s;
  }
}

constexpr int T_MOD = 192, T_ROPE = 32, T_WTL = 1072, T_WT = T_WTL * 4, T_CVA = 256, T_CVB = 128, T_CKA = 2048, T_CKB = 512;
constexpr int T_PRE = T_MOD + T_ROPE + T_WT + T_CVA + 2 * T_CVB + T_CKA + 2 * T_CKB;

DI void pre_phase(const Params& p, float* sm0) {
  const int t = tid_() & 255, half = tid_() >> 8;
  float* sm = sm0 + half * 16640;
  for (int pair = blockIdx.x; pair < T_PRE / 2; pair += gridDim.x) {
    int i = pair * 2 + half;
    if (i < T_MOD) { mod_task(p, i / 48, i % 48, sm); continue; }
    i -= T_MOD;
    if (i < T_ROPE) {
      float* cosT = (float*)(p.ws + OFF_ROPE);
      float* sinT = cosT + 1024 * 32;
#pragma unroll
      for (int q = 0; q < 4; ++q) {
        int e = i * 1024 + q * 256 + t;
        int pos = e >> 5, j = e & 31;
        int rr = pos >> 6, cc = pos & 63;
        float inv = exp2f(-(float)(j & 15) * (13.287712379549449f / 16.f));
        float ang = (float)(j < 16 ? rr : cc) * inv;
        cosT[e] = __cosf(ang);
        sinT[e] = __sinf(ang);
      }
      continue;
    }
    i -= T_ROPE;
    if (i < T_WT) {
      int l = i / T_WTL, j = i % T_WTL;
      if (j < 384) { transpose_tile<4>(p.in[14] + (size_t)l * 1024 * 6144, 6144, (j / 24) * 64, (j % 24) * 256, Wt_in(p.ws, l), 1024, 0, sm); continue; }
      j -= 384;
      if (j < 96) {
        int seg = j / 32, jj = j % 32;
        transpose_tile<4>((seg == 0 ? p.in[23] : (seg == 1 ? p.in[24] : p.in[25])) + (size_t)l * 512 * 1024, 1024, (jj / 4) * 64, (jj % 4) * 256, Wt_br(p.ws, l) + seg * 512, 1536, 0, sm);
        continue;
      }
      j -= 96;
      if (j < 64) { transpose_tile<4>(p.in[26] + (size_t)l * 1024 * 1024, 1024, (j / 4) * 64, (j % 4) * 256, Wt_out(p.ws, l), 1024, 0, sm); continue; }
      j -= 64;
      if (j < 352) { transpose_tile<4>(p.in[27] + (size_t)l * 1024 * 5632, 5632, (j / 22) * 64, (j % 22) * 256, Wt_f1(p.ws, l), 1024, 1, sm); continue; }
      j -= 352;
      transpose_tile<4>(p.in[28] + (size_t)l * 2816 * 1024, 1024, (j / 4) * 64, (j % 4) * 256, Wt_f2(p.ws, l), 2816, 0, sm);
      continue;
    }
    i -= T_WT;
    if (i < T_CVA) {
      int bl = i / 16, jj = i % 16, b = bl >> 2, l = bl & 3;
      transpose_tile<4>(p.in[3] + (size_t)bl * 512 * 512, 512, (jj / 2) * 64, (jj % 2) * 256, KVL(p.ws, l, 3) + (size_t)b * 512 * 1536, 1536, 2, sm);
      continue;
    }
    i -= T_CVA;
    if (i < 2 * T_CVB) {
      int wh = i / T_CVB, ii = i % T_CVB;
      int bl = ii / 8, jj = ii % 8, b = bl >> 2, l = bl & 3;
      transpose_tile<2>((wh ? p.in[7] : p.in[5]) + (size_t)bl * 512 * 128, 128, jj * 64, 0, KVL(p.ws, l, wh ? 5 : 4) + (size_t)b * 128 * 1536, 1536, 2, sm);
      continue;
    }
    i -= 2 * T_CVB;
    if (i < T_CKA) {
      size_t e = ((size_t)i * 256 + t) * 8;
      int d = e & 127, h = (e >> 7) & 3, pp = (e >> 9) & 511, l = (e >> 18) & 3, b = (int)(e >> 20);
      const float* sp = p.in[2] + e;
      float4 a = ld_nt4(sp), c = ld_nt4(sp + 4);
      u16* dp = KVL(p.ws, l, 0) + (((size_t)(b * 4 + h) * 1536 + pp) * 128 + d);
      *(uint4*)dp = make_uint4(pack2(a.x, a.y), pack2(a.z, a.w), pack2(c.x, c.y), pack2(c.z, c.w));
      continue;
    }
    i -= T_CKA;
    {
      int wh = i / T_CKB, ii = i % T_CKB;
      size_t e = ((size_t)ii * 256 + t) * 8;
      int d = e & 63, h = (e >> 6) & 1, pp = (e >> 7) & 511, l = (e >> 16) & 3, b = (int)(e >> 18);
      const float* sp = (wh ? p.in[6] : p.in[4]) + e;
      float4 a = ld_nt4(sp), c = ld_nt4(sp + 4);
      u16* dp = KVL(p.ws, l, wh ? 2 : 1) + (((size_t)(b * 2 + h) * 1536 + pp) * 64 + d);
      *(uint4*)dp = make_uint4(pack2(a.x, a.y), pack2(a.z, a.w), pack2(c.x, c.y), pack2(c.z, c.w));
    }
  }
}

DI void norm_phase(const Params& p, int l, int which) {
  const int lane = tid_() & 63;
  const int gw = blockIdx.x * 8 + (tid_() >> 6), nw = gridDim.x * 8;
  for (int row = gw; row < NTOK; row += nw) {
    float v[2][8];
    const bool from_input = (which == 0 && l == 0);
    if (from_input) {
      const float* x = row < NCTX ? p.in[0] + (size_t)row * DM : p.in[1] + (size_t)(row - NCTX) * DM;
#pragma unroll
      for (int c = 0; c < 2; ++c) {
        float4 a = *(const float4*)(x + 8 * lane + 512 * c), b = *(const float4*)(x + 8 * lane + 512 * c + 4);
        v[c][0] = a.x; v[c][1] = a.y; v[c][2] = a.z; v[c][3] = a.w; v[c][4] = b.x; v[c][5] = b.y; v[c][6] = b.z; v[c][7] = b.w;
      }
    } else {
      const u16* x = (const u16*)(p.ws + OFF_X) + (size_t)row * DM;
#pragma unroll
      for (int c = 0; c < 2; ++c) {
        uint4 a = *(const uint4*)(x + 8 * lane + 512 * c);
        v[c][0] = __uint_as_float(a.x << 16); v[c][1] = __uint_as_float(a.x & 0xffff0000u);
        v[c][2] = __uint_as_float(a.y << 16); v[c][3] = __uint_as_float(a.y & 0xffff0000u);
        v[c][4] = __uint_as_float(a.z << 16); v[c][5] = __uint_as_float(a.z & 0xffff0000u);
        v[c][6] = __uint_as_float(a.w << 16); v[c][7] = __uint_as_float(a.w & 0xffff0000u);
      }
    }
    float ss = 0.f;
#pragma unroll
    for (int c = 0; c < 2; ++c)
#pragma unroll
      for (int i = 0; i < 8; ++i) ss += v[c][i] * v[c][i];
    ss = wave_sum(ss);
    const float rs = rsqrtf(ss * (1.f / 1024.f) + 1e-6f);
    if (which == 2) {
      float* o = p.out + (row < NCTX ? O_YP + (size_t)row * DM : O_YS + (size_t)(row - NCTX) * DM);
#pragma unroll
      for (int c = 0; c < 2; ++c) {
        const int col = 8 * lane + 512 * c;
        float4 g0 = *(const float4*)(p.in[29] + col), g1 = *(const float4*)(p.in[29] + col + 4);
        st_nt4(o + col, make_float4(v[c][0] * rs * g0.x, v[c][1] * rs * g0.y, v[c][2] * rs * g0.z, v[c][3] * rs * g0.w));
        st_nt4(o + col + 4, make_float4(v[c][4] * rs * g1.x, v[c][5] * rs * g1.y, v[c][6] * rs * g1.z, v[c][7] * rs * g1.w));
      }
    } else {
      const float* gp = (which == 0 ? p.in[12] : p.in[13]) + l * 1024;
      const float* sh = mod_vec(p, l, row, which == 0 ? 0 : 3);
      const float* sc = mod_vec(p, l, row, which == 0 ? 1 : 4);
      u16* o = (u16*)(p.ws + OFF_HM) + (size_t)row * DM;
#pragma unroll
      for (int c = 0; c < 2; ++c) {
        const int col = 8 * lane + 512 * c;
        float gg[8], s1[8], s0[8];
        *(float4*)&gg[0] = *(const float4*)(gp + col); *(float4*)&gg[4] = *(const float4*)(gp + col + 4);
        *(float4*)&s1[0] = *(const float4*)(sc + col); *(float4*)&s1[4] = *(const float4*)(sc + col + 4);
        *(float4*)&s0[0] = *(const float4*)(sh + col); *(float4*)&s0[4] = *(const float4*)(sh + col + 4);
        float r[8];
#pragma unroll
        for (int i = 0; i < 8; ++i) r[i] = v[c][i] * rs * gg[i] * (1.f + s1[i]) + s0[i];
        *(uint4*)(o + col) = make_uint4(pack2(r[0], r[1]), pack2(r[2], r[3]), pack2(r[4], r[5]), pack2(r[6], r[7]));
      }
    }
  }
}

constexpr int SMEM_BYTES = 8 * 64 * 68 * 4;
enum { EPI_G1 = 0, EPI_G2 = 1, EPI_RES = 2, EPI_SWIGLU = 3 };

struct GemmArgs {
  const u16* A; int lda;
  const u16* Bt; int ldb;
  int K;
  int l;
  int res_chunk;
};

DI void g1_epilogue_wave(const Params& p, int l, int mrow0, int ncol0, const float* ct, int lane);

#define RAW_BARRIER() do { asm volatile("s_waitcnt lgkmcnt(0)" ::: "memory"); __builtin_amdgcn_s_barrier(); } while (0)

template <int EPI, int BN>
DI void gemm_tile(const Params& p, const GemmArgs& g, int m0, int n0, unsigned char* smem) {
  constexpr int NT = BN / 32;
  constexpr int NH = NT / 2;
  constexpr int NI = (256 + BN) / 128;
  constexpr int STAGE = (256 + BN) * 64;
  const int t = tid_(), lane = t & 63, w = t >> 6, wm = w >> 1, wn = w & 1, lc = lane & 15, lq = lane >> 4;
  f32x4 acc[4][NT];
  f32x4 tot[4][NT];
#pragma unroll
  for (int a = 0; a < 4; ++a)
#pragma unroll
    for (int b = 0; b < NT; ++b)
#pragma unroll
      for (int i = 0; i < 4; ++i) { acc[a][b][i] = 0.f; if (EPI == EPI_G2) tot[a][b][i] = 0.f; }

  const int nk = g.K >> 5;
  const int dl_rr = lane >> 2, dl_p = lane & 3;
  const u16* gsrc[NI];
#pragma unroll
  for (int i = 0; i < NI; ++i) {
    const int blk = i * 8 + w, kc = dl_p ^ (dl_rr >> 2);
    if (blk < 16) gsrc[i] = g.A + (size_t)(m0 + blk * 16 + dl_rr) * g.lda + kc * 8;
    else gsrc[i] = g.Bt + (size_t)(n0 + (blk - 16) * 16 + dl_rr) * g.ldb + kc * 8;
  }
  const int dma_off = w * 1024 + lane * 16;
  const unsigned smem_lds = (unsigned)(size_t)smem;
#define DMA_SLICE(J)                                                                                                   \
  {                                                                                                                    \
    unsigned char* bufp_ = smem + ((J) & 3) * STAGE + dma_off;                                                         \
    const size_t koff_ = (size_t)(J) * 32;                                                                             \
    _Pragma("unroll") for (int i_ = 0; i_ < NI; ++i_)                                                                  \
        __builtin_amdgcn_global_load_lds((const unsigned*)(gsrc[i_] + koff_), (LAS unsigned*)(bufp_ + i_ * 8192), 16, 0, 0); \
  }
  __syncthreads();
  DMA_SLICE(0) DMA_SLICE(1) DMA_SLICE(2)
  const unsigned frag_off = lc * 64 + (((lq ^ (lc >> 2)) & 3) << 4);
  const unsigned a_base = smem_lds + (wm * 4) * 1024 + frag_off;
  const unsigned b_base = smem_lds + 16384 + (wn * NT) * 1024 + frag_off;
  bf16x8 a0, a1, a2, a3, c0, c1, c2, c3, bl0, bl1, bl2, bl3, bh0, bh1, bh2, bh3;
#define RD4(ADDR, F0, F1, F2, F3)                                                                                      \
  asm volatile("ds_read_b128 %0, %4\n\tds_read_b128 %1, %4 offset:1024\n\tds_read_b128 %2, %4 offset:2048\n\t"         \
               "ds_read_b128 %3, %4 offset:3072"                                                                       \
               : "=&v"(F0), "=&v"(F1), "=&v"(F2), "=&v"(F3) : "v"(ADDR) : "memory");
#define RD2(ADDR, F0, F1)                                                                                              \
  asm volatile("ds_read_b128 %0, %2\n\tds_read_b128 %1, %2 offset:1024" : "=&v"(F0), "=&v"(F1) : "v"(ADDR) : "memory");
#define RD_B(ADDR, F0, F1, F2, F3) if (NH == 4) { RD4(ADDR, F0, F1, F2, F3) } else { RD2(ADDR, F0, F1) }
#define WT4(F0, F1, F2, F3) asm volatile("s_waitcnt lgkmcnt(0)" : "+v"(F0), "+v"(F1), "+v"(F2), "+v"(F3) :: "memory");
#define WT8(F0, F1, F2, F3, F4, F5, F6, F7)                                                                            \
  asm volatile("s_waitcnt lgkmcnt(0)" : "+v"(F0), "+v"(F1), "+v"(F2), "+v"(F3), "+v"(F4), "+v"(F5), "+v"(F6), "+v"(F7) :: "memory");
#define MF16(A, B, C) __builtin_amdgcn_mfma_f32_16x16x32_bf16((A), (B), (C), 0, 0, 0)
#define MM_HALF(A0, A1, A2, A3, B0, B1, B2, B3, NB)                                                                    \
  acc[0][(NB)] = MF16(A0, B0, acc[0][(NB)]); acc[1][(NB)] = MF16(A1, B0, acc[1][(NB)]);                                \
  acc[2][(NB)] = MF16(A2, B0, acc[2][(NB)]); acc[3][(NB)] = MF16(A3, B0, acc[3][(NB)]);                                \
  acc[0][(NB) + 1] = MF16(A0, B1, acc[0][(NB) + 1]); acc[1][(NB) + 1] = MF16(A1, B1, acc[1][(NB) + 1]);                \
  acc[2][(NB) + 1] = MF16(A2, B1, acc[2][(NB) + 1]); acc[3][(NB) + 1] = MF16(A3, B1, acc[3][(NB) + 1]);                \
  if (NH == 4) {                                                                                                       \
    acc[0][((NB) + 2) % NT] = MF16(A0, B2, acc[0][((NB) + 2) % NT]); acc[1][((NB) + 2) % NT] = MF16(A1, B2, acc[1][((NB) + 2) % NT]); \
    acc[2][((NB) + 2) % NT] = MF16(A2, B2, acc[2][((NB) + 2) % NT]); acc[3][((NB) + 2) % NT] = MF16(A3, B2, acc[3][((NB) + 2) % NT]); \
    acc[0][((NB) + 3) % NT] = MF16(A0, B3, acc[0][((NB) + 3) % NT]); acc[1][((NB) + 3) % NT] = MF16(A1, B3, acc[1][((NB) + 3) % NT]); \
    acc[2][((NB) + 3) % NT] = MF16(A2, B3, acc[2][((NB) + 3) % NT]); acc[3][((NB) + 3) % NT] = MF16(A3, B3, acc[3][((NB) + 3) % NT]); \
  }
#define SLICE_STEP(KT, A0, A1, A2, A3, N0, N1, N2, N3)                                                                 \
  {                                                                                                                    \
    if ((KT) + 2 < nk) { if (NI == 4) asm volatile("s_waitcnt vmcnt(4)" ::: "memory"); else asm volatile("s_waitcnt vmcnt(3)" ::: "memory"); } \
    else asm volatile("s_waitcnt vmcnt(0)" ::: "memory");                                                              \
    WT8(A0, A1, A2, A3, bl0, bl1, bl2, bl3)                                                                            \
    __builtin_amdgcn_s_barrier();                      \
    if ((KT) + 3 < nk) DMA_SLICE((KT) + 3)                                                                             \
    const unsigned so_ = ((KT) & 3) * STAGE;                                                                           \
    RD_B(b_base + so_ + NH * 1024, bh0, bh1, bh2, bh3)                                                                 \
    __builtin_amdgcn_sched_barrier(0);                                           \
    MM_HALF(A0, A1, A2, A3, bl0, bl1, bl2, bl3, 0)                                                                     \
    __builtin_amdgcn_sched_barrier(0);                                                                                 \
    WT4(bh0, bh1, bh2, bh3)                                                                                            \
    __builtin_amdgcn_s_barrier();     \
                                      \
      \
                                                                        \
    MM_PART(A0, A1, A2, A3, bh0, bh1, NH)                                                                              \
    __builtin_amdgcn_sched_barrier(0);                                                                                 \
    if ((KT) + 1 < nk) {                                                                                               \
      const unsigned sn_ = (((KT) + 1) & 3) * STAGE;                                                                   \
      RD4(a_base + sn_, N0, N1, N2, N3)                                                                                \
      RD_B(b_base + sn_, bl0, bl1, bl2, bl3)                                                                           \
    }                                                                                                                  \
    __builtin_amdgcn_sched_barrier(0);                                                                                 \
    MM_REST(A0, A1, A2, A3, bh0, bh1, bh2, bh3, NH)                                                                    \
    __builtin_amdgcn_sched_barrier(0);                                                                                 \
  }
#define MM_PART(A0, A1, A2, A3, B0, B1, NB)                                                                            \
  acc[0][(NB)] = MF16(A0, B0, acc[0][(NB)]); acc[1][(NB)] = MF16(A1, B0, acc[1][(NB)]);                                \
  acc[2][(NB)] = MF16(A2, B0, acc[2][(NB)]); acc[3][(NB)] = MF16(A3, B0, acc[3][(NB)]);                                \
  if (NH == 4) {                                                                                                       \
    acc[0][(NB) + 1] = MF16(A0, B1, acc[0][(NB) + 1]); acc[1][(NB) + 1] = MF16(A1, B1, acc[1][(NB) + 1]);              \
    acc[2][(NB) + 1] = MF16(A2, B1, acc[2][(NB) + 1]); acc[3][(NB) + 1] = MF16(A3, B1, acc[3][(NB) + 1]);              \
  }
#define MM_REST(A0, A1, A2, A3, B0, B1, B2, B3, NB)                                                                    \
  if (NH == 4) {                                                                                                       \
    acc[0][((NB) + 2) % NT] = MF16(A0, B2, acc[0][((NB) + 2) % NT]); acc[1][((NB) + 2) % NT] = MF16(A1, B2, acc[1][((NB) + 2) % NT]); \
    acc[2][((NB) + 2) % NT] = MF16(A2, B2, acc[2][((NB) + 2) % NT]); acc[3][((NB) + 2) % NT] = MF16(A3, B2, acc[3][((NB) + 2) % NT]); \
    acc[0][((NB) + 3) % NT] = MF16(A0, B3, acc[0][((NB) + 3) % NT]); acc[1][((NB) + 3) % NT] = MF16(A1, B3, acc[1][((NB) + 3) % NT]); \
    acc[2][((NB) + 3) % NT] = MF16(A2, B3, acc[2][((NB) + 3) % NT]); acc[3][((NB) + 3) % NT] = MF16(A3, B3, acc[3][((NB) + 3) % NT]); \
  } else {                                                                                                             \
    acc[0][(NB) + 1] = MF16(A0, B1, acc[0][(NB) + 1]); acc[1][(NB) + 1] = MF16(A1, B1, acc[1][(NB) + 1]);              \
    acc[2][(NB) + 1] = MF16(A2, B1, acc[2][(NB) + 1]); acc[3][(NB) + 1] = MF16(A3, B1, acc[3][(NB) + 1]);              \
  }
#ifndef PIPE_BN
#define PIPE_BN 256
#endif
#define SIMPLE_STEP(KT)                                                                                                \
  {                                                                                                                    \
    if ((KT) + 2 < nk) { if (NI == 4) asm volatile("s_waitcnt vmcnt(8)" ::: "memory"); else asm volatile("s_waitcnt vmcnt(6)" ::: "memory"); } \
    else if ((KT) + 1 < nk) { if (NI == 4) asm volatile("s_waitcnt vmcnt(4)" ::: "memory"); else asm volatile("s_waitcnt vmcnt(3)" ::: "memory"); } \
    else asm volatile("s_waitcnt vmcnt(0)" ::: "memory");                                                              \
    RAW_BARRIER();                                                                                                     \
    G2_PREFETCH(KT)                                                                                                    \
    if ((KT) + 3 < nk) DMA_SLICE((KT) + 3)                                                                             \
    const unsigned so_ = ((KT) & 3) * STAGE;                                                                           \
    RD4(a_base + so_, a0, a1, a2, a3)                                                                                  \
    RD_B(b_base + so_, bl0, bl1, bl2, bl3)                                                                             \
    RD_B(b_base + so_ + NH * 1024, bh0, bh1, bh2, bh3)                                                                 \
    WT8(a0, a1, a2, a3, bl0, bl1, bl2, bl3)                                                                            \
    WT4(bh0, bh1, bh2, bh3)                                                                                            \
    MM_HALF(a0, a1, a2, a3, bl0, bl1, bl2, bl3, 0)                                                                     \
    MM_HALF(a0, a1, a2, a3, bh0, bh1, bh2, bh3, NH)                                                                    \
  }
  u32x2 gqr[4][NT];
#pragma unroll
  for (int a = 0; a < 4; ++a)
#pragma unroll
    for (int b = 0; b < NT; ++b) gqr[a][b] = (u32x2){0u, 0u};
#define G2_PREFETCH(KT)                                                                                                \
  if (EPI == EPI_G2 && (((KT) & 15) == 15)) {                                                                          \
    const int seg_ = (KT) >> 4;                                                                                        \
    _Pragma("unroll") for (int a = 0; a < 4; ++a) _Pragma("unroll") for (int b = 0; b < NT; ++b) {                     \
      const int r16 = (m0 + wm * 64 + a * 16) >> 4, c16 = (seg_ * 1024 + n0 + wn * (BN / 2) + b * 16) >> 4;           \
      gqr[a][b] = __builtin_nontemporal_load((const u32x2*)((const u16*)(p.ws + OFF_GH) + ((size_t)(r16 * 192 + c16) * 64 + lane) * 4)); \
    }                                                                                                                  \
  }
  constexpr bool PIPE = true;
  c0 = c1 = c2 = c3 = a0 = a1 = a2 = a3 = bl0 = bl1 = bl2 = bl3 = bh0 = bh1 = bh2 = bh3 = (bf16x8)(0);
  if (PIPE) {
    if (NI == 4) asm volatile("s_waitcnt vmcnt(8)" ::: "memory"); else asm volatile("s_waitcnt vmcnt(6)" ::: "memory");
    RAW_BARRIER();
    RD4(a_base, a0, a1, a2, a3)
    RD_B(b_base, bl0, bl1, bl2, bl3)
    if (w >= 4) __builtin_amdgcn_s_barrier();
  }
  for (int kt = 0; kt < nk; kt += 2) {
    if (PIPE) {
      SLICE_STEP(kt, a0, a1, a2, a3, c0, c1, c2, c3)
      SLICE_STEP(kt + 1, c0, c1, c2, c3, a0, a1, a2, a3)
    } else {
      SIMPLE_STEP(kt)
      SIMPLE_STEP(kt + 1)
    }
    if (EPI == EPI_G2) {
      if (((kt + 1) & 15) == 15) {
        const int seg = (kt + 1) >> 4;
        if (PIPE) {
#pragma unroll
          for (int a = 0; a < 4; ++a)
#pragma unroll
            for (int b = 0; b < NT; ++b) {
              const int r16 = (m0 + wm * 64 + a * 16) >> 4, c16 = (seg * 1024 + n0 + wn * (BN / 2) + b * 16) >> 4;
              gqr[a][b] = __builtin_nontemporal_load((const u32x2*)((const u16*)(p.ws + OFF_GH) + ((size_t)(r16 * 192 + c16) * 64 + lane) * 4));
            }
          WT8(a0, a1, a2, a3, bl0, bl1, bl2, bl3)
        }
#pragma unroll
        for (int a = 0; a < 4; ++a)
#pragma unroll
          for (int b = 0; b < NT; ++b) {
            const int r16 = (m0 + wm * 64 + a * 16) >> 4, c16 = (seg * 1024 + n0 + wn * (BN / 2) + b * 16) >> 4;
            const u32x2 gq_ = gqr[a][b];
            const uint2 gq = make_uint2(gq_[0], gq_[1]);
            tot[a][b][0] += __uint_as_float(gq.x << 16) * acc[a][b][0];
            tot[a][b][1] += __uint_as_float(gq.x & 0xffff0000u) * acc[a][b][1];
            tot[a][b][2] += __uint_as_float(gq.y << 16) * acc[a][b][2];
            tot[a][b][3] += __uint_as_float(gq.y & 0xffff0000u) * acc[a][b][3];
            acc[a][b][0] = 0.f; acc[a][b][1] = 0.f; acc[a][b][2] = 0.f; acc[a][b][3] = 0.f;
          }
      }
    }
  }
  if (PIPE && w < 4) __builtin_amdgcn_s_barrier();
  __syncthreads();

  const int rbase = m0 + wm * 64, cbase = n0 + wn * (BN / 2);
  if (EPI == EPI_G1) {
    if (n0 >= 3072) {
#pragma unroll
      for (int a = 0; a < 4; ++a)
#pragma unroll
        for (int b = 0; b < NT; ++b) {
          const int r16 = (rbase + a * 16) >> 4, c16 = (cbase - 3072 + b * 16) >> 4;
          u16* gp = (u16*)(p.ws + OFF_GH) + ((size_t)(r16 * 192 + c16) * 64 + lane) * 4;
          *(uint2*)gp = make_uint2(pack2(sigmoidf_(acc[a][b][0]), sigmoidf_(acc[a][b][1])), pack2(sigmoidf_(acc[a][b][2]), sigmoidf_(acc[a][b][3])));
        }
    } else {
      float* ct = (float*)smem + w * (64 * 68);
#pragma unroll
      for (int hf = 0; hf < NT / 4; ++hf) {
#pragma unroll
        for (int a = 0; a < 4; ++a)
#pragma unroll
          for (int b = 0; b < 4; ++b)
#pragma unroll
            for (int i = 0; i < 4; ++i)
              ct[(a * 16 + 4 * lq + i) * 68 + b * 16 + lc] = acc[a][(hf * 4 + b) % NT][i];
        g1_epilogue_wave(p, g.l, rbase, cbase + hf * 64, ct, lane);
      }
    }
  } else if (EPI == EPI_G2) {
    u16* o = (u16*)(p.ws + OFF_HM);
    float* ct = (float*)smem + w * (64 * 68);
#pragma unroll
    for (int a = 0; a < 4; ++a)
#pragma unroll
      for (int b = 0; b < NT; ++b)
#pragma unroll
        for (int i = 0; i < 4; ++i) ct[(a * 16 + 4 * lq + i) * 68 + b * 16 + lc] = tot[a][b][i];
#pragma unroll 8
    for (int it = lane; it < 512; it += 64) {
      const int rl = it >> 3, c8 = (it & 7) * 8;
      float4 v0 = *(const float4*)(ct + rl * 68 + c8), v1 = *(const float4*)(ct + rl * 68 + c8 + 4);
      *(uint4*)(o + (size_t)(rbase + rl) * DM + cbase + c8) = make_uint4(pack2(v0.x, v0.y), pack2(v0.z, v0.w), pack2(v1.x, v1.y), pack2(v1.z, v1.w));
    }
  } else if (EPI == EPI_RES) {
    u16* xo = (u16*)(p.ws + OFF_X);
    const bool from_input = (g.res_chunk == 2) && g.l == 0;
    float* ct = (float*)smem + w * (64 * 68);
#pragma unroll
    for (int a = 0; a < 4; ++a)
#pragma unroll
      for (int b = 0; b < NT; ++b)
#pragma unroll
        for (int i = 0; i < 4; ++i) ct[(a * 16 + 4 * lq + i) * 68 + b * 16 + lc] = acc[a][b][i];
#pragma unroll 8
    for (int it = lane; it < 512; it += 64) {
      const int rl = it >> 3, c8 = (it & 7) * 8;
      const int row = rbase + rl, col = cbase + c8;
      float4 v0 = *(const float4*)(ct + rl * 68 + c8), v1 = *(const float4*)(ct + rl * 68 + c8 + 4);
      const float* gate = mod_vec(p, g.l, row, g.res_chunk) + col;
      float4 g0 = *(const float4*)gate, g1 = *(const float4*)(gate + 4);
      float x[8];
      if (from_input) {
        const float* xin = (row < NCTX ? p.in[0] + (size_t)row * DM : p.in[1] + (size_t)(row - NCTX) * DM) + col;
        float4 a0 = *(const float4*)xin, a1 = *(const float4*)(xin + 4);
        x[0] = a0.x; x[1] = a0.y; x[2] = a0.z; x[3] = a0.w; x[4] = a1.x; x[5] = a1.y; x[6] = a1.z; x[7] = a1.w;
      } else {
        uint4 xb = *(const uint4*)(xo + (size_t)row * DM + col);
        x[0] = __uint_as_float(xb.x << 16); x[1] = __uint_as_float(xb.x & 0xffff0000u);
        x[2] = __uint_as_float(xb.y << 16); x[3] = __uint_as_float(xb.y & 0xffff0000u);
        x[4] = __uint_as_float(xb.z << 16); x[5] = __uint_as_float(xb.z & 0xffff0000u);
        x[6] = __uint_as_float(xb.w << 16); x[7] = __uint_as_float(xb.w & 0xffff0000u);
      }
      x[0] += g0.x * v0.x; x[1] += g0.y * v0.y; x[2] += g0.z * v0.z; x[3] += g0.w * v0.w;
      x[4] += g1.x * v1.x; x[5] += g1.y * v1.y; x[6] += g1.z * v1.z; x[7] += g1.w * v1.w;
      *(uint4*)(xo + (size_t)row * DM + col) = make_uint4(pack2(x[0], x[1]), pack2(x[2], x[3]), pack2(x[4], x[5]), pack2(x[6], x[7]));
    }
  } else if (EPI == EPI_SWIGLU) {
    u16* o = (u16*)(p.ws + OFF_GH);
    float* ct = (float*)smem + w * (64 * 68);
#pragma unroll
    for (int a = 0; a < 4; ++a)
#pragma unroll
      for (int b = 0; b < NT / 2; ++b)
#pragma unroll
        for (int i = 0; i < 4; ++i) ct[(a * 16 + 4 * lq + i) * 68 + b * 16 + lc] = siluf_(acc[a][b][i]) * acc[a][(b + NT / 2) % NT][i];
    const int colb0 = (n0 >> 8) * 128 + wn * 64;
#pragma unroll 8
    for (int it = lane; it < 512; it += 64) {
      const int rl = it >> 3, c8 = (it & 7) * 8;
      float4 v0 = *(const float4*)(ct + rl * 68 + c8), v1 = *(const float4*)(ct + rl * 68 + c8 + 4);
      *(uint4*)(o + (size_t)(rbase + rl) * DFF + colb0 + c8) = make_uint4(pack2(v0.x, v0.y), pack2(v0.z, v0.w), pack2(v1.x, v1.y), pack2(v1.z, v1.w));
    }
  }
}

DI void g1_epilogue_wave(const Params& p, int l, int mrow0, int ncol0, const float* ct, int lane) {
  const bool ctx = mrow0 < NCTX;
  int kind;
  int br;
  int nrel;
  const int n0 = ncol0;
  if (n0 < 512) { kind = 0; br = 0; nrel = n0; }
  else if (n0 < 1024) { kind = 1; br = 0; nrel = n0 - 512; }
  else if (n0 < 1536) { kind = 2; br = 0; nrel = n0 - 1024; }
  else if (n0 < 2048) { kind = 0; br = 1; nrel = n0 - 1536; }
  else if (n0 < 2176) { kind = 1; br = 1; nrel = n0 - 2048; }
  else if (n0 < 2304) { kind = 2; br = 1; nrel = n0 - 2176; }
  else if (n0 < 2816) { kind = 0; br = 2; nrel = n0 - 2304; }
  else if (n0 < 2944) { kind = 1; br = 2; nrel = n0 - 2816; }
  else { kind = 2; br = 2; nrel = n0 - 2944; }

  if (kind < 2) {
    const int j = lane & 7, grp = lane >> 3;
    const float* cosT = (const float*)(p.ws + OFF_ROPE);
    const float* sinT = cosT + 1024 * 32;
    const float* gn = (kind == 0 ? p.in[20] : p.in[21]) + l * 64;
    for (int rl = grp; rl < 64; rl += 8) {
      const int row = mrow0 + rl;
      const float* cp = ct + rl * 68;
      float4 lo = *(const float4*)(cp + 4 * j), hi = *(const float4*)(cp + 32 + 4 * j);
      if (br == 1) {
        float ss = lo.x * lo.x + lo.y * lo.y + lo.z * lo.z + lo.w * lo.w + hi.x * hi.x + hi.y * hi.y + hi.z * hi.z + hi.w * hi.w;
        ss += __shfl_xor(ss, 1); ss += __shfl_xor(ss, 2); ss += __shfl_xor(ss, 4);
        float rs = rsqrtf(ss * (1.f / 64.f) + 1e-6f);
        float4 g0 = *(const float4*)(gn + 4 * j), g1 = *(const float4*)(gn + 32 + 4 * j);
        lo.x *= rs * g0.x; lo.y *= rs * g0.y; lo.z *= rs * g0.z; lo.w *= rs * g0.w;
        hi.x *= rs * g1.x; hi.y *= rs * g1.y; hi.z *= rs * g1.z; hi.w *= rs * g1.w;
      }
      if (!ctx) {
        const int pos = (row - NCTX) & 1023;
        float4 c = *(const float4*)(cosT + pos * 32 + 4 * j), sn = *(const float4*)(sinT + pos * 32 + 4 * j);
        float4 nlo = make_float4(lo.x * c.x - hi.x * sn.x, lo.y * c.y - hi.y * sn.y, lo.z * c.z - hi.z * sn.z, lo.w * c.w - hi.w * sn.w);
        float4 nhi = make_float4(hi.x * c.x + lo.x * sn.x, hi.y * c.y + lo.y * sn.y, hi.z * c.z + lo.z * sn.z, hi.w * c.w + lo.w * sn.w);
        lo = nlo; hi = nhi;
      }
      const int nc = nrel;
      if (kind == 0) {
        u16* q = (u16*)(p.ws + OFF_Q) + (size_t)row * 1536 + br * 512 + nc;
        *(uint2*)(q + 4 * j) = make_uint2(pack2(lo.x * 0.125f, lo.y * 0.125f), pack2(lo.z * 0.125f, lo.w * 0.125f));
        *(uint2*)(q + 32 + 4 * j) = make_uint2(pack2(hi.x * 0.125f, hi.y * 0.125f), pack2(hi.z * 0.125f, hi.w * 0.125f));
      } else {
        const int hd = (br == 0) ? 128 : 64, nh = (br == 0) ? 4 : 2;
        const int head = nc / hd, d = nc % hd;
        u16* kd;
        if (ctx) {
          const int b = row >> 8, key = row & 255;
          kd = KVC(p.ws, br) + ((size_t)(b * nh + head) * 256 + key) * hd + d;
          float* od = p.out + (br == 0 ? O_AK : (br == 1 ? O_BK : O_CK)) + ((size_t)((b * 4 + l) * 256 + key) * nh + head) * hd + d;
          st_nt4(od + 4 * j, lo);
          st_nt4(od + 32 + 4 * j, hi);
        } else {
          const int b = (row - NCTX) >> 10, pos = (row - NCTX) & 1023;
          kd = KVL(p.ws, l, br) + ((size_t)(b * nh + head) * 1536 + 512 + pos) * hd + d;
        }
        *(uint2*)(kd + 4 * j) = make_uint2(pack2(lo.x, lo.y), pack2(lo.z, lo.w));
        *(uint2*)(kd + 32 + 4 * j) = make_uint2(pack2(hi.x, hi.y), pack2(hi.z, hi.w));
      }
    }
  } else {
    const int nrows = (br == 0) ? 512 : 128;
    for (int it = lane; it < 256; it += 64) {
      const int gq = it & 3, c = it >> 2;
      const int row0 = mrow0 + gq * 16;
      float v[16];
#pragma unroll
      for (int i = 0; i < 16; ++i) v[i] = ct[(gq * 16 + i) * 68 + c];
      u16* vd;
      if (ctx) {
        const int b = row0 >> 8, key = row0 & 255;
        vd = KVC(p.ws, 3 + br) + ((size_t)b * nrows + nrel + c) * 256 + key;
      } else {
        const int b = (row0 - NCTX) >> 10, pos = (row0 - NCTX) & 1023;
        vd = KVL(p.ws, l, 3 + br) + ((size_t)b * nrows + nrel + c) * 1536 + 512 + pos;
      }
      *(uint4*)vd = make_uint4(pack2(v[0], v[1]), pack2(v[2], v[3]), pack2(v[8], v[9]), pack2(v[10], v[11]));
      *(uint4*)(vd + 8) = make_uint4(pack2(v[4], v[5]), pack2(v[6], v[7]), pack2(v[12], v[13]), pack2(v[14], v[15]));
    }
    if (ctx) {
      float* ob = p.out + (br == 0 ? O_AV : (br == 1 ? O_BV : O_CV));
      for (int it = lane; it < 1024; it += 64) {
        const int rl = it >> 4, c4 = (it & 15) * 4;
        const int row = mrow0 + rl, b = row >> 8, key = row & 255;
        float4 v = *(const float4*)(ct + rl * 68 + c4);
        st_nt4(ob + (size_t)((b * 4 + l) * 256 + key) * nrows + nrel + c4, v);
      }
    }
  }
}

template <int EPI, int BN>
DI void gemm_phase(const Params& p, const GemmArgs& g, int ntn, unsigned char* smem) {
  if (gridDim.x == 256) {
    const int xcd = blockIdx.x & 7, j = blockIdx.x >> 3;
    for (int il = j; il < 4 * ntn; il += 32) {
      const int mt = 4 * xcd + (il & 3), nt = il >> 2;
      gemm_tile<EPI, BN>(p, g, mt * 256, nt * BN, smem);
    }
  } else {
    const int ntiles = 32 * ntn;
    for (int tile = blockIdx.x; tile < ntiles; tile += gridDim.x) {
      const int mt = tile / ntn, nt = tile % ntn;
      gemm_tile<EPI, BN>(p, g, mt * 256, nt * BN, smem);
    }
  }
}

constexpr float LOG2E = 1.4426950408889634f;
constexpr int N_ATT_ITEMS = 768;
constexpr int VT_PITCH = 144;

DI void load_q(bf16x8 (&qf)[4], const u16* Q, int row, int coloff, int h) {
  const u16* qp = Q + (size_t)row * 1536 + coloff + 8 * h;
#pragma unroll
  for (int s = 0; s < 4; ++s) qf[s] = __builtin_nontemporal_load((const bf16x8*)(qp + 16 * s));
}

template <int DV, int KD>
DI void attn_item(f32x16 (&o)[DV / 32], unsigned char* smem, const u16* __restrict__ Kg, const u16* __restrict__ Vg, int nkeys,
                  int n_tiles, int band_t0, const bf16x8 (&qf)[4], int koff, bool has_band, int qpos, float m_init, float l_init) {
  constexpr int KPITCH = KD * 2 + 16;
  constexpr int KBYTES = 64 * KPITCH;
  constexpr int VBYTES = DV * VT_PITCH;
  constexpr int BUF = KBYTES + VBYTES;
  constexpr int KCH = KD / 8;
  constexpr int NK = KD / 64;
  constexpr int NV = DV / 64;
  const int t = tid_(), lane = t & 63, r = lane & 31, h = lane >> 5;
  const int krow = t / KCH, kkc = t % KCH;
  const int vrow = t >> 3, vkc = t & 7;
  const u16* kgp = Kg + (size_t)krow * KD + kkc * 8;
  const u16* vgp = Vg + (size_t)vrow * nkeys + vkc * 8;
  const int klds = krow * KPITCH + kkc * 16;
  const int vlds = KBYTES + vrow * VT_PITCH + vkc * 16;
  uint4 k0, k1, v0, v1;
  k1 = v1 = make_uint4(0, 0, 0, 0);
#define ATT_TILE(i) ((i) < 8 || !has_band ? (i) : 8 + band_t0 + (i) - 8)
#define ATT_GLOAD(TI)                                                                   \
  {                                                                                     \
    const size_t key0_ = (size_t)(TI) * 64;                                             \
    k0 = *(const uint4*)(kgp + key0_ * KD);                                             \
    if (NK == 2) k1 = *(const uint4*)(kgp + (key0_ + 32) * KD);                         \
    v0 = *(const uint4*)(vgp + key0_);                                                  \
    if (NV == 2) v1 = *(const uint4*)(vgp + key0_ + (size_t)64 * nkeys);                \
  }
#define ATT_LSTORE(DST)                                                                 \
  {                                                                                     \
    *(uint4*)((DST) + klds) = k0;                                                       \
    if (NK == 2) *(uint4*)((DST) + klds + 32 * KPITCH) = k1;                            \
    *(uint4*)((DST) + vlds) = v0;                                                       \
    if (NV == 2) *(uint4*)((DST) + vlds + 64 * VT_PITCH) = v1;                          \
  }
  float m = m_init, l = l_init;
#pragma unroll
  for (int dt = 0; dt < DV / 32; ++dt)
#pragma unroll
    for (int i = 0; i < 16; ++i) o[dt][i] = 0.f;

  ATT_GLOAD(ATT_TILE(0))
  __syncthreads();
  ATT_LSTORE(smem)
  __syncthreads();
  for (int it = 0; it < n_tiles; ++it) {
    const int cur = it & 1;
    const int tile = ATT_TILE(it);
    if (it + 1 < n_tiles) ATT_GLOAD(ATT_TILE(it + 1))
    const unsigned char* kb = smem + cur * BUF + r * KPITCH + (koff + 8 * h) * 2;
    const unsigned char* vb = smem + cur * BUF + KBYTES + r * VT_PITCH + 16 * h;
    f32x16 S0, S1;
#pragma unroll
    for (int i = 0; i < 16; ++i) { S0[i] = 0.f; S1[i] = 0.f; }
#pragma unroll
    for (int s = 0; s < 4; ++s) {
      bf16x8 ka = *(const bf16x8*)(kb + 32 * s);
      bf16x8 kc = *(const bf16x8*)(kb + 32 * KPITCH + 32 * s);
      S0 = MFMA32(ka, qf[s], S0);
      S1 = MFMA32(kc, qf[s], S1);
    }
    if (has_band && it >= 8) {
      const int kbase = (tile - 8) * 64 - qpos;
#pragma unroll
      for (int i = 0; i < 16; ++i) {
        int d0 = kbase + crow(i, h), d1 = d0 + 32;
        if (d0 < -128 || d0 > 128) S0[i] = -1e30f;
        if (d1 < -128 || d1 > 128) S1[i] = -1e30f;
      }
    }
    float mx = fmaxf(S0[0], S1[0]);
#pragma unroll
    for (int i = 1; i < 16; ++i) mx = __builtin_fmaxf(__builtin_fmaxf(mx, S0[i]), S1[i]);
    mx = fmaxf(mx, __shfl_xor(mx, 32));
    const float mn = fmaxf(m, mx);
    const float mb = mn * LOG2E;
    float ps;
    {
      const f2_t sc2 = {LOG2E, LOG2E}, nb2 = {-mb, -mb};
      f2_t ps2 = {0.f, 0.f};
#pragma unroll
      for (int i = 0; i < 8; ++i) {
        f2_t a = {S0[2 * i], S0[2 * i + 1]}, b = {S1[2 * i], S1[2 * i + 1]};
        a = __builtin_elementwise_fma(a, sc2, nb2);
        b = __builtin_elementwise_fma(b, sc2, nb2);
        a.x = __builtin_amdgcn_exp2f(a.x); a.y = __builtin_amdgcn_exp2f(a.y);
        b.x = __builtin_amdgcn_exp2f(b.x); b.y = __builtin_amdgcn_exp2f(b.y);
        S0[2 * i] = a.x; S0[2 * i + 1] = a.y; S1[2 * i] = b.x; S1[2 * i + 1] = b.y;
        ps2 += a; ps2 += b;
      }
      ps = ps2.x + ps2.y;
    }
    if (__any(mn != m)) {
      const float alpha = __builtin_amdgcn_exp2f((m - mn) * LOG2E);
      l *= alpha;
#pragma unroll
      for (int dt = 0; dt < DV / 32; ++dt)
#pragma unroll
        for (int i = 0; i < 16; ++i) o[dt][i] *= alpha;
      m = mn;
    }
    l += ps;
    bf16x8 pf0, pf1, pf2, pf3;
    {
      uint4 u;
      u = make_uint4(pack2(S0[0], S0[1]), pack2(S0[2], S0[3]), pack2(S0[4], S0[5]), pack2(S0[6], S0[7])); pf0 = __builtin_bit_cast(bf16x8, u);
      u = make_uint4(pack2(S0[8], S0[9]), pack2(S0[10], S0[11]), pack2(S0[12], S0[13]), pack2(S0[14], S0[15])); pf1 = __builtin_bit_cast(bf16x8, u);
      u = make_uint4(pack2(S1[0], S1[1]), pack2(S1[2], S1[3]), pack2(S1[4], S1[5]), pack2(S1[6], S1[7])); pf2 = __builtin_bit_cast(bf16x8, u);
      u = make_uint4(pack2(S1[8], S1[9]), pack2(S1[10], S1[11]), pack2(S1[12], S1[13]), pack2(S1[14], S1[15])); pf3 = __builtin_bit_cast(bf16x8, u);
    }
#pragma unroll
    for (int dt = 0; dt < DV / 32; ++dt) {
      const unsigned char* vp = vb + dt * 32 * VT_PITCH;
      o[dt] = MFMA32(*(const bf16x8*)(vp), pf0, o[dt]);
      o[dt] = MFMA32(*(const bf16x8*)(vp + 32), pf1, o[dt]);
      o[dt] = MFMA32(*(const bf16x8*)(vp + 64), pf2, o[dt]);
      o[dt] = MFMA32(*(const bf16x8*)(vp + 96), pf3, o[dt]);
    }
    if (it + 1 < n_tiles) {
      unsigned char* dst = smem + (cur ^ 1) * BUF;
      ATT_LSTORE(dst)
    }
    __syncthreads();
  }
  const float lt = l + __shfl_xor(l, 32);
  const float inv = 1.f / lt;
#pragma unroll
  for (int dt = 0; dt < DV / 32; ++dt)
#pragma unroll
    for (int i = 0; i < 16; ++i) o[dt][i] *= inv;
}

DI void attn_phase(const Params& p, int l, int ph, unsigned char* smem) {
  __shared__ int s_item;
  const int t = tid_(), lane = t & 63, wv = t >> 6, r = lane & 31, h = lane >> 5;
  const u16* Q = (const u16*)(p.ws + OFF_Q);
  u16* AO = (u16*)(p.ws + OFF_ATT);
  unsigned* ctr = (unsigned*)(p.ws + OFF_BAR + 14336) + ph;
  float lam;
  {
    float a = p.in[15][l * 64 + lane] * p.in[16][l * 64 + lane];
    float b = p.in[17][l * 64 + lane] * p.in[18][l * 64 + lane];
    a = wave_sum(a); b = wave_sum(b);
    lam = __expf(a) - __expf(b) + p.lam_init[l];
  }
  const float one_m_li = 1.f - p.lam_init[l];
  const bool static_first = gridDim.x == 256;
  int round = 0;
  for (;;) {
    __syncthreads();
    if (t == 0) {
      const int xcd = blockIdx.x & 7, j = blockIdx.x >> 3;
      if (round == 0 && static_first) {
        if (j < 16) { const int g = 2 * xcd + (j >> 3); s_item = (g >> 2) * 32 + (g & 3) * 8 + (j & 7); }
        else s_item = 128 + (xcd >> 1) * 32 + (xcd & 1) * 16 + (j - 16);
      } else if (round == 1 && static_first && j >= 16) {
        s_item = 256 + (xcd >> 1) * 32 + (xcd & 1) * 16 + (j - 16);
      } else if (round == 1 && static_first) {
        s_item = 384 + (2 * xcd + (j >> 3)) * 8 + (j & 7);
      } else {
        s_item = (static_first ? 512 : 0) + (int)atomicAdd(ctr, 1u);
      }
    }
    ++round;
    __syncthreads();
    const int it = s_item;
    if (it >= N_ATT_ITEMS) break;
    const int cls = it >> 7, i = it & 127;
    const int lat = cls < 3, br = cls % 3;
    const int nkeys = lat ? 1536 : 256;
    if (br == 0) {
      int b, hd, qb;
      if (lat) { b = i >> 5; hd = (i >> 3) & 3; qb = i & 7; } else { b = i >> 3; hd = (i >> 1) & 3; qb = i & 1; }
      const int pass = wv >> 2;
      const int row = (lat ? NCTX + b * 1024 : b * 256) + qb * 128 + (wv & 3) * 32 + r;
      const u16* Kb = (lat ? KVL(p.ws, l, 0) : KVC(p.ws, 0)) + (size_t)(b * 4 + hd) * nkeys * 128;
      const u16* Vb = (lat ? KVL(p.ws, l, 3) : KVC(p.ws, 3)) + (size_t)(b * 4 + hd) * 128 * nkeys;
      bf16x8 qf[4];
      load_q(qf, Q, row, hd * 128 + pass * 64, h);
      f32x16 o[4];
      attn_item<128, 128>(o, smem, Kb, Vb, nkeys, nkeys / 64, 0, qf, pass * 64, false, 0, -1e30f, 0.f);
      float* stash = (float*)smem + (wv & 3) * 4096;
      if (pass == 1) {
#pragma unroll
        for (int dt = 0; dt < 4; ++dt)
#pragma unroll
          for (int q = 0; q < 16; ++q) stash[(dt * 16 + q) * 64 + lane] = o[dt][q];
      }
      __syncthreads();
      if (pass == 0) {
        float ss = 0.f;
#pragma unroll
        for (int dt = 0; dt < 4; ++dt)
#pragma unroll
          for (int q = 0; q < 16; ++q) {
            float v = o[dt][q] - lam * stash[(dt * 16 + q) * 64 + lane];
            o[dt][q] = v;
            ss += v * v;
          }
        ss += __shfl_xor(ss, 32);
        const float rs = rsqrtf(ss * (1.f / 128.f) + 1e-6f) * one_m_li;
        const float* sg = p.in[19] + l * 128;
        u16* tl = (u16*)(smem + 65536 + wv * 8704);
#pragma unroll
        for (int dt = 0; dt < 4; ++dt)
#pragma unroll
          for (int g4 = 0; g4 < 4; ++g4) {
            const int d = dt * 32 + 8 * g4 + 4 * h;
            float4 gg = *(const float4*)(sg + d);
            unsigned w0 = pack2(o[dt][4 * g4] * rs * gg.x, o[dt][4 * g4 + 1] * rs * gg.y);
            unsigned w1 = pack2(o[dt][4 * g4 + 2] * rs * gg.z, o[dt][4 * g4 + 3] * rs * gg.w);
            *(uint2*)(tl + r * 136 + d) = make_uint2(w0, w1);
          }
        u16* ob = AO + (size_t)(row - r) * 1536 + hd * 128;
#pragma unroll
        for (int q = 0; q < 8; ++q) {
          const int itx = lane + 64 * q, rr = itx >> 4, c8 = (itx & 15) * 8;
          *(uint4*)(ob + (size_t)rr * 1536 + c8) = *(const uint4*)(tl + rr * 136 + c8);
        }
      }
    } else {
      int b, kvh, qg;
      if (lat) { b = i >> 5; kvh = (i >> 4) & 1; qg = i & 15; } else { b = i >> 3; kvh = (i >> 2) & 1; qg = i & 3; }
      const int hd = kvh * 4 + (wv & 3), qsub = wv >> 2;
      const int row = (lat ? NCTX + b * 1024 : b * 256) + qg * 64 + qsub * 32 + r;
      const u16* Kb = (lat ? KVL(p.ws, l, br) : KVC(p.ws, br)) + (size_t)(b * 2 + kvh) * nkeys * 64;
      const u16* Vb = (lat ? KVL(p.ws, l, 3 + br) : KVC(p.ws, 3 + br)) + (size_t)(b * 2 + kvh) * 64 * nkeys;
      bf16x8 qf[4];
      load_q(qf, Q, row, br * 512 + hd * 64, h);
      f32x16 o[2];
      const bool band = (br == 2) && lat;
      int n_tiles = nkeys / 64, t0 = 0;
      if (band) {
        const int q0 = qg * 64;
        t0 = (q0 - 128) < 0 ? 0 : (q0 - 128) >> 6;
        int t1 = (q0 + 191) >> 6; if (t1 > 15) t1 = 15;
        n_tiles = 8 + (t1 - t0 + 1);
      }
      const float m0 = (br == 2) ? p.in[22][l * 8 + hd] : -1e30f;
      const float l0 = (br == 2 && h == 0) ? 1.f : 0.f;
      attn_item<64, 64>(o, smem, Kb, Vb, nkeys, n_tiles, t0, qf, 0, band, qg * 64 + qsub * 32 + r, m0, l0);
      u16* tl = (u16*)(smem + 65536 + wv * 8704);
#pragma unroll
      for (int dt = 0; dt < 2; ++dt)
#pragma unroll
        for (int g4 = 0; g4 < 4; ++g4) {
          const int d = dt * 32 + 8 * g4 + 4 * h;
          unsigned w0 = pack2(o[dt][4 * g4], o[dt][4 * g4 + 1]);
          unsigned w1 = pack2(o[dt][4 * g4 + 2], o[dt][4 * g4 + 3]);
          *(uint2*)(tl + r * 72 + d) = make_uint2(w0, w1);
        }
      u16* ob = AO + (size_t)(row - r) * 1536 + br * 512 + hd * 64;
#pragma unroll
      for (int q = 0; q < 4; ++q) {
        const int itx = lane + 64 * q, rr = itx >> 3, c8 = (itx & 7) * 8;
        *(uint4*)(ob + (size_t)rr * 1536 + c8) = *(const uint4*)(tl + rr * 72 + c8);
      }
    }
  }
}

#define XB_TMO      128
#define XB_XCNT(j)  (256  + 64 * (j))
#define XB_XSUB(j)  (1280 + 64 * (j))
#define XB_XGEN(j)  (2304 + 64 * (j))
#define XB_TOP      3328
#define XB_TOPGEN   3392
#define XCD_BAR_WORDS 3456
#define XB_SPIN_CAP (1u << 22)
DI unsigned xb_ld(unsigned* p) { return __hip_atomic_load(p, __ATOMIC_RELAXED, __HIP_MEMORY_SCOPE_AGENT); }
DI unsigned xb_add(unsigned* p, unsigned v) { return __hip_atomic_fetch_add(p, v, __ATOMIC_RELAXED, __HIP_MEMORY_SCOPE_AGENT); }
DI unsigned xb_xcc_id() { return (unsigned)__builtin_amdgcn_s_getreg((3 << 11) | 20) & 0xFu; }
#define XB_SPIN(cond, bar) do { unsigned _sp = 0; while (cond) { __builtin_amdgcn_s_sleep(1); \
    if ((++_sp & 255u) == 0u) { if (xb_ld(&(bar)[XB_TMO])) break; if (_sp > XB_SPIN_CAP) { atomicAdd(&(bar)[XB_TMO], 1u); break; } } } } while (0)
struct XcdBarrier { unsigned* bar; unsigned x; volatile LAS unsigned* st; };
DI XcdBarrier xcd_barrier_post(unsigned* bar, volatile LAS unsigned* st) {
  XcdBarrier b; b.bar = bar; b.x = xb_xcc_id(); b.st = st;
  if (threadIdx.x == 0) (void)xb_add(&bar[XB_XCNT(b.x)], 1u);
  return b;
}
DI void xcd_barrier_complete(unsigned* bar, unsigned x, unsigned& nloc, unsigned& nx) {
  const unsigned G = gridDim.x * gridDim.y * gridDim.z;
  unsigned sum, cnt, mine, sp = 0u;
  for (;;) {
    sum = 0u; cnt = 0u; mine = 0u;
#pragma unroll
    for (unsigned j = 0; j < 16; ++j) { const unsigned c = xb_ld(&bar[XB_XCNT(j)]); sum += c; cnt += (c > 0u) ? 1u : 0u; mine = (j == x) ? c : mine; }
    if (sum == G) break;
    __builtin_amdgcn_s_sleep(1);
    if ((++sp & 255u) == 0u) { if (xb_ld(&bar[XB_TMO])) break; if (sp > XB_SPIN_CAP) { atomicAdd(&bar[XB_TMO], 1u); break; } }
  }
  nloc = mine > 0u ? mine : 1u; nx = cnt > 0u ? cnt : 1u;
}
DI void xcd_barrier(const XcdBarrier& b) {
  asm volatile("s_waitcnt vmcnt(0)" ::: "memory");
  __syncthreads();
  if (threadIdx.x == 0) {
    unsigned* bar = b.bar;
    __builtin_amdgcn_s_waitcnt(0);
    unsigned nloc = b.st[0], nx = b.st[1];
    if (nloc == 0u) { xcd_barrier_complete(bar, b.x, nloc, nx); b.st[0] = nloc; b.st[1] = nx; }
    const unsigned old = xb_add(&bar[XB_XSUB(b.x)], 1u);
    const unsigned gen = old / nloc;
    if (old + 1u == (gen + 1u) * nloc) {
      __builtin_amdgcn_fence(__ATOMIC_RELEASE, "agent");
      asm volatile("s_waitcnt vmcnt(0)" ::: "memory");
      const unsigned og = xb_add(&bar[XB_TOP], 1u);
      const unsigned tg = og / nx;
      if (og + 1u == (tg + 1u) * nx) xb_add(&bar[XB_TOPGEN], 1u);
      else XB_SPIN(xb_ld(&bar[XB_TOPGEN]) == tg, bar);
      __builtin_amdgcn_fence(__ATOMIC_ACQUIRE, "agent");
      xb_add(&bar[XB_XGEN(b.x)], 1u);
      asm volatile("s_waitcnt vmcnt(0)" ::: "memory");
    } else {
      XB_SPIN(xb_ld(&bar[XB_XGEN(b.x)]) == gen, bar);
      __builtin_amdgcn_fence(__ATOMIC_ACQUIRE, "agent");
      asm volatile("s_waitcnt vmcnt(0)" ::: "memory");
    }
  }
  __syncthreads();
}

__global__ void __launch_bounds__(512, 2) fwd_megakernel(Params p) {
  __shared__ __attribute__((aligned(16))) unsigned char smem[SMEM_BYTES];
  __shared__ uint4 xb_words;
  cg::grid_group grid = cg::this_grid();
  if (threadIdx.x == 0) xb_words = make_uint4(0u, 0u, 0u, 0u);
  __syncthreads();
  XcdBarrier xb = xcd_barrier_post((unsigned*)(p.ws + OFF_BAR), (volatile LAS unsigned*)&xb_words);
  for (int ph = p.ph_lo; ph < p.ph_hi; ++ph) {
    if (ph > p.ph_lo) {
      if (p.ph_hi > 4096) grid.sync();
      xcd_barrier(xb);
    }
    if (ph == 0) { pre_phase(p, (float*)smem); continue; }
    if (ph == NPH - 1) { norm_phase(p, 0, 2); continue; }
    const int l = (ph - 1) / SEQ_N, sub = (int)((SEQ_PACK >> (4 * ((ph - 1) % SEQ_N))) & 15ull);
    GemmArgs g;
    g.l = l; g.res_chunk = 0;
    switch (sub) {
      case 0: norm_phase(p, l, 0); break;
#ifndef DIS1
      case 1:
        g.A = (const u16*)(p.ws + OFF_HM); g.lda = DM; g.Bt = Wt_in(p.ws, l); g.ldb = DM; g.K = DM;
        gemm_phase<EPI_G1, 256>(p, g, DIN / 256, smem);
        break;
#endif
#ifndef DIS2
      case 2: attn_phase(p, l, ph, smem); break;
#endif
#ifndef DIS3
      case 3:
        g.A = (const u16*)(p.ws + OFF_ATT); g.lda = 1536; g.Bt = Wt_br(p.ws, l); g.ldb = 1536; g.K = 1536;
        gemm_phase<EPI_G2, 128>(p, g, DM / 128, smem);
        break;
#endif
      case 4:
        g.A = (const u16*)(p.ws + OFF_HM); g.lda = DM; g.Bt = Wt_out(p.ws, l); g.ldb = DM; g.K = DM; g.res_chunk = 2;
        gemm_phase<EPI_RES, 128>(p, g, DM / 128, smem);
        break;
      case 5: norm_phase(p, l, 1); break;
      case 6:
        g.A = (const u16*)(p.ws + OFF_HM); g.lda = DM; g.Bt = Wt_f1(p.ws, l); g.ldb = DM; g.K = DM;
        gemm_phase<EPI_SWIGLU, 256>(p, g, 2 * DFF / 256, smem);
        break;
      default:
        g.A = (const u16*)(p.ws + OFF_GH); g.lda = DFF; g.Bt = Wt_f2(p.ws, l); g.ldb = DFF; g.K = DFF; g.res_chunk = 5;
        gemm_phase<EPI_RES, 128>(p, g, DM / 128, smem);
        break;
    }
  }
}

extern "C" void kernel_launch(void* const* d_in, const int* in_sizes, int n_in, void* d_out, int out_size, void* d_ws, size_t ws_size,
                              hipStream_t stream) {
  static int grid_blocks = 0;
  if (!grid_blocks) {
    int dev = 0, cus = 0, per_cu = 0;
    hipGetDevice(&dev);
    hipDeviceGetAttribute(&cus, hipDeviceAttributeMultiprocessorCount, dev);
    hipOccupancyMaxActiveBlocksPerMultiprocessor(&per_cu, fwd_megakernel, 512, 0);
    if (per_cu < 1) per_cu = 1;
    if (per_cu > 1) per_cu = 1;
    grid_blocks = cus * per_cu;
    if (ws_size < WS_END) fprintf(stderr, "kernel_launch: workspace too small: %zu < %zu\n", ws_size, (size_t)WS_END);
  }
  Params p{};
  for (int i = 0; i < 30; ++i) p.in[i] = (const float*)d_in[i];
  p.out = (float*)d_out;
  p.ws = (unsigned char*)d_ws;
  for (int l = 0; l < 4; ++l) p.lam_init[l] = (float)(0.8 - 0.6 * exp(-0.3 * l));
  hipMemsetAsync((unsigned char*)d_ws + OFF_BAR, 0, 16384, stream);
#if ONE_LAUNCH
  p.ph_lo = 0; p.ph_hi = NPH;
  void* args[] = {&p};
  hipError_t e = hipLaunchCooperativeKernel((void*)fwd_megakernel, dim3(grid_blocks), dim3(512), args, 0, stream);
  if (e != hipSuccess) fprintf(stderr, "cooperative launch failed: %s (grid %d)\n", hipGetErrorString(e), grid_blocks);
#else
  for (int ph = 0; ph < NPH; ++ph) {
    p.ph_lo = ph; p.ph_hi = ph + 1;
    hipLaunchKernelGGL(fwd_megakernel, dim3(grid_blocks), dim3(512), 0, stream, p);
  }
#endif
}
```

```cpp
#include <hip/hip_runtime.h>
#include <hip/hip_cooperative_groups.h>
#include <cstdio>
#include <cstdint>
#include <cmath>
namespace cg = cooperative_groups;

#ifndef ONE_LAUNCH
#define ONE_LAUNCH 1
#endif

typedef unsigned short u16;
typedef __attribute__((ext_vector_type(8))) short bf16x8;
typedef __attribute__((ext_vector_type(4))) short s16x4;
typedef __attribute__((ext_vector_type(16))) float f32x16;
typedef __attribute__((ext_vector_type(4))) float f32x4;
typedef __attribute__((ext_vector_type(2))) unsigned u32x2;
typedef __attribute__((ext_vector_type(4))) unsigned u32x4;
typedef __attribute__((ext_vector_type(2))) __bf16 bf2_t;
typedef __attribute__((ext_vector_type(2))) float f2_t;
#define DI __device__ __forceinline__
#define LAS __attribute__((address_space(3)))
#define MFMA32(a, b, c) __builtin_amdgcn_mfma_f32_32x32x16_bf16((a), (b), (c), 0, 0, 0)

constexpr int DM = 1024, NTOK = 8192, NCTX = 4096;
constexpr int DIN = 6144, DFF = 2816, DEPTH = 4;
#ifndef SEQ_PACK
#define SEQ_PACK 0x76543210ull
#define SEQ_N 8
#endif
constexpr int NPH = 2 + SEQ_N * DEPTH;

constexpr size_t SZ_WIN = (size_t)DIN * DM * 2, SZ_WBR = (size_t)DM * 1536 * 2, SZ_WOUT = (size_t)DM * DM * 2;
constexpr size_t SZ_WF1 = (size_t)2 * DFF * DM * 2, SZ_WF2 = (size_t)DM * DFF * 2;
constexpr size_t SZ_WL = SZ_WIN + SZ_WBR + SZ_WOUT + SZ_WF1 + SZ_WF2;
constexpr size_t OFF_W = 0;
constexpr size_t OFF_MOD = OFF_W + SZ_WL * DEPTH;
constexpr size_t OFF_ROPE = OFF_MOD + (size_t)4 * 5 * 6144 * 4;
constexpr size_t OFF_X = OFF_ROPE + (size_t)2 * 1024 * 32 * 4;
constexpr size_t OFF_HM = OFF_X + (size_t)NTOK * DM * 4;
constexpr size_t OFF_Q = OFF_HM + (size_t)NTOK * DM * 2;
constexpr size_t OFF_GH = OFF_Q + (size_t)NTOK * 1536 * 2;
constexpr size_t OFF_ATT = OFF_GH + (size_t)NTOK * 3072 * 2;
constexpr size_t EL_KA = (size_t)4 * 4 * 1536 * 128, EL_KB = (size_t)4 * 2 * 1536 * 64;
constexpr size_t SZ_KVL = (2 * EL_KA + 4 * EL_KB) * 2;
constexpr size_t OFF_KVL = OFF_ATT + (size_t)NTOK * 1536 * 2;
constexpr size_t EL_KAC = (size_t)16 * 4 * 256 * 128, EL_KBC = (size_t)16 * 2 * 256 * 64;
constexpr size_t OFF_KVC = OFF_KVL + SZ_KVL * DEPTH;
constexpr size_t OFF_BAR = OFF_KVC + (2 * EL_KAC + 4 * EL_KBC) * 2;
constexpr size_t WS_END = OFF_BAR + 16384;

constexpr size_t O_YP = 0, O_YS = 4194304, O_AK = 8388608, O_AV = 16777216, O_BK = 25165824, O_BV = 27262976, O_CK = 29360128, O_CV = 31457280;

struct Params {
  const float* in[30];
  float* out;
  unsigned char* ws;
  float lam_init[4];
  int ph_lo, ph_hi;
};

DI unsigned pack2(float a, float b) { f2_t v = {a, b}; bf2_t r = __builtin_convertvector(v, bf2_t); return __builtin_bit_cast(unsigned, r); }
DI int tid_() { int t = threadIdx.x; asm volatile("" : "+v"(t)); return t; }
DI float4 ld_nt4(const float* p) { f32x4 t = __builtin_nontemporal_load((const f32x4*)p); return make_float4(t[0], t[1], t[2], t[3]); }
DI void st_nt4(float* p, float4 v) { f32x4 t = {v.x, v.y, v.z, v.w}; __builtin_nontemporal_store(t, (f32x4*)p); }
DI void st_nt2(float* p, float2 v) { f2_t t = {v.x, v.y}; __builtin_nontemporal_store(t, (f2_t*)p); }
DI float bf2f(u16 x) { return __uint_as_float(((unsigned)x) << 16); }
DI int crow(int reg, int h) { return (reg & 3) + 8 * (reg >> 2) + 4 * h; }
DI float wave_sum(float v) {
#pragma unroll
  for (int o = 32; o > 0; o >>= 1) v += __shfl_xor(v, o);
  return v;
}
DI float sigmoidf_(float x) { return __builtin_amdgcn_rcpf(1.f + __expf(-x)); }
DI float siluf_(float x) { return x * __builtin_amdgcn_rcpf(1.f + __expf(-x)); }
DI u16 bf16_1(float x) { return (u16)(pack2(x, 0.f) & 0xffffu); }

DI u16* Wt_in(unsigned char* ws, int l) { return (u16*)(ws + OFF_W + SZ_WL * l); }
DI u16* Wt_br(unsigned char* ws, int l) { return (u16*)(ws + OFF_W + SZ_WL * l + SZ_WIN); }
DI u16* Wt_out(unsigned char* ws, int l) { return (u16*)(ws + OFF_W + SZ_WL * l + SZ_WIN + SZ_WBR); }
DI u16* Wt_f1(unsigned char* ws, int l) { return (u16*)(ws + OFF_W + SZ_WL * l + SZ_WIN + SZ_WBR + SZ_WOUT); }
DI u16* Wt_f2(unsigned char* ws, int l) { return (u16*)(ws + OFF_W + SZ_WL * l + SZ_WIN + SZ_WBR + SZ_WOUT + SZ_WF1); }
DI u16* KVL(unsigned char* ws, int l, int which) {
  size_t off = 0;
  if (which >= 1) off += EL_KA;
  if (which >= 2) off += EL_KB;
  if (which >= 3) off += EL_KB;
  if (which >= 4) off += EL_KA;
  if (which >= 5) off += EL_KB;
  return (u16*)(ws + OFF_KVL + SZ_KVL * l) + off;
}
DI u16* KVC(unsigned char* ws, int which) {
  size_t off = 0;
  if (which >= 1) off += EL_KAC;
  if (which >= 2) off += EL_KBC;
  if (which >= 3) off += EL_KBC;
  if (which >= 4) off += EL_KAC;
  if (which >= 5) off += EL_KBC;
  return (u16*)(ws + OFF_KVC) + off;
}
DI const float* x_src(const Params& p, int l, int row) {
  if (l == 0) return row < NCTX ? p.in[0] + (size_t)row * DM : p.in[1] + (size_t)(row - NCTX) * DM;
  return (const float*)(p.ws + OFF_X) + (size_t)row * DM;
}
DI const float* mod_vec(const Params& p, int l, int row, int chunk) {
  int v = row < NCTX ? 4 : ((row - NCTX) >> 10);
  return (const float*)(p.ws + OFF_MOD) + ((size_t)(l * 5 + v) * 6144 + chunk * 1024);
}

template <int NT64>
DI void transpose_tile(const float* __restrict__ src, int ldsrc, int k0, int n0, u16* __restrict__ dst, int ldd, int mode, float* tile) {
  const int t = tid_() & 255;
  __syncthreads();
  {
    const int kk = t >> 4, c4 = (t & 15) * 4;
    float4 v[NT64 * 4];
#pragma unroll
    for (int q = 0; q < NT64; ++q)
#pragma unroll
      for (int i = 0; i < 4; ++i) { f32x4 t_ = __builtin_nontemporal_load((const f32x4*)(src + (size_t)(k0 + kk + 16 * i) * ldsrc + n0 + 64 * q + c4)); v[q * 4 + i] = make_float4(t_[0], t_[1], t_[2], t_[3]); }
#pragma unroll
    for (int q = 0; q < NT64; ++q)
#pragma unroll
      for (int i = 0; i < 4; ++i) {
        float* tp = tile + q * 4160 + (kk + 16 * i) * 65 + c4;
        tp[0] = v[q * 4 + i].x; tp[1] = v[q * 4 + i].y; tp[2] = v[q * 4 + i].z; tp[3] = v[q * 4 + i].w;
      }
  }
  __syncthreads();
  const int n = t >> 2, kc = (t & 3) * 16;
#pragma unroll
  for (int q = 0; q < NT64; ++q) {
    const float* tq = tile + q * 4160;
    const int n0q = n0 + 64 * q;
    unsigned w[8];
#pragma unroll
    for (int j = 0; j < 8; ++j) w[j] = pack2(tq[(kc + 2 * j) * 65 + n], tq[(kc + 2 * j + 1) * 65 + n]);
    int drow;
    if (mode != 1) drow = n0q + n;
    else {
      int isb = n0q >= DFF;
      int c0 = n0q - (isb ? DFF : 0);
      drow = (c0 >> 7) * 256 + ((c0 >> 6) & 1) * 128 + isb * 64 + n;
    }
    uint4* dp = (uint4*)(dst + (size_t)drow * ldd + k0 + kc);
    if (mode == 2) {
      dp[0] = make_uint4(w[0], w[1], w[4], w[5]);
      dp[1] = make_uint4(w[2], w[3], w[6], w[7]);
    } else {
      dp[0] = make_uint4(w[0], w[1], w[2], w[3]);
      dp[1] = make_uint4(w[4], w[5], w[6], w[7]);
    }
  }
}

DI void mod_task(const Params& p, int l, int cgp, float* sm) {
  float* sv = sm;
  float* red = sm + 5 * 1024;
  const int t = tid_() & 255;
  __syncthreads();
  for (int e = t; e < 5 * 1024; e += 256) {
    int v = e >> 10, k = e & 1023;
    float x = v < 4 ? p.in[8][v * 1024 + k] : p.in[9][k];
    sv[e] = siluf_(x);
  }
  __syncthreads();
  const int c4 = t & 31, ks = t >> 5;
  const float* w = p.in[10] + (size_t)l * 1024 * 6144 + cgp * 128 + c4 * 4;
  float acc[5][4];
#pragma unroll
  for (int v = 0; v < 5; ++v) { acc[v][0] = acc[v][1] = acc[v][2] = acc[v][3] = 0.f; }
#pragma unroll 8
  for (int k = ks * 128; k < ks * 128 + 128; ++k) {
    f32x4 wt_ = __builtin_nontemporal_load((const f32x4*)(w + (size_t)k * 6144));
    float4 wv = make_float4(wt_[0], wt_[1], wt_[2], wt_[3]);
#pragma unroll
    for (int v = 0; v < 5; ++v) {
      float s = sv[v * 1024 + k];
      acc[v][0] += s * wv.x; acc[v][1] += s * wv.y; acc[v][2] += s * wv.z; acc[v][3] += s * wv.w;
    }
  }
#pragma unroll
  for (int v = 0; v < 5; ++v)
#pragma unroll
    for (int j = 0; j < 4; ++j) red[(ks * 32 + c4) * 20 + v * 4 + j] = acc[v][j];
  __syncthreads();
  for (int o = t; o < 640; o += 256) {
    int cc = o / 20, r = o % 20, v = r >> 2, j = r & 3;
    float s = 0.f;
#pragma unroll
    for (int q = 0; q < 8; ++q) s += red[(q * 32 + cc) * 20 + r];
    int col = cgp * 128 + cc * 4 + j;
    s += p.in[11][l * 6144 + col];
    ((float*)(p.ws + OFF_MOD))[(size_t)(l * 5 + v) * 6144 + col] = s;
  }
}

constexpr int T_MOD = 192, T_ROPE = 32, T_WTL = 1072, T_WT = T_WTL * 4, T_CVA = 256, T_CVB = 128, T_CKA = 2048, T_CKB = 512;
constexpr int T_PRE = T_MOD + T_ROPE + T_WT + T_CVA + 2 * T_CVB + T_CKA + 2 * T_CKB;

DI void pre_phase(const Params& p, float* sm0) {
  const int t = tid_() & 255, half = tid_() >> 8;
  float* sm = sm0 + half * 16640;
  for (int pair = blockIdx.x; pair < T_PRE / 2; pair += gridDim.x) {
    int i = pair * 2 + half;
    if (i < T_MOD) { mod_task(p, i / 48, i % 48, sm); continue; }
    i -= T_MOD;
    if (i < T_ROPE) {
      float* cosT = (float*)(p.ws + OFF_ROPE);
      float* sinT = cosT + 1024 * 32;
#pragma unroll
      for (int q = 0; q < 4; ++q) {
        int e = i * 1024 + q * 256 + t;
        int pos = e >> 5, j = e & 31;
        int rr = pos >> 6, cc = pos & 63;
        float inv = exp2f(-(float)(j & 15) * (13.287712379549449f / 16.f));
        float ang = (float)(j < 16 ? rr : cc) * inv;
        cosT[e] = __cosf(ang);
        sinT[e] = __sinf(ang);
      }
      continue;
    }
    i -= T_ROPE;
    if (i < T_WT) {
      int l = i / T_WTL, j = i % T_WTL;
      if (j < 384) { transpose_tile<4>(p.in[14] + (size_t)l * 1024 * 6144, 6144, (j / 24) * 64, (j % 24) * 256, Wt_in(p.ws, l), 1024, 0, sm); continue; }
      j -= 384;
      if (j < 96) {
        int seg = j / 32, jj = j % 32;
        transpose_tile<4>((seg == 0 ? p.in[23] : (seg == 1 ? p.in[24] : p.in[25])) + (size_t)l * 512 * 1024, 1024, (jj / 4) * 64, (jj % 4) * 256, Wt_br(p.ws, l) + seg * 512, 1536, 0, sm);
        continue;
      }
      j -= 96;
      if (j < 64) { transpose_tile<4>(p.in[26] + (size_t)l * 1024 * 1024, 1024, (j / 4) * 64, (j % 4) * 256, Wt_out(p.ws, l), 1024, 0, sm); continue; }
      j -= 64;
      if (j < 352) { transpose_tile<4>(p.in[27] + (size_t)l * 1024 * 5632, 5632, (j / 22) * 64, (j % 22) * 256, Wt_f1(p.ws, l), 1024, 1, sm); continue; }
      j -= 352;
      transpose_tile<4>(p.in[28] + (size_t)l * 2816 * 1024, 1024, (j / 4) * 64, (j % 4) * 256, Wt_f2(p.ws, l), 2816, 0, sm);
      continue;
    }
    i -= T_WT;
    if (i < T_CVA) {
      int bl = i / 16, jj = i % 16, b = bl >> 2, l = bl & 3;
      transpose_tile<4>(p.in[3] + (size_t)bl * 512 * 512, 512, (jj / 2) * 64, (jj % 2) * 256, KVL(p.ws, l, 3) + (size_t)b * 512 * 1536, 1536, 2, sm);
      continue;
    }
    i -= T_CVA;
    if (i < 2 * T_CVB) {
      int wh = i / T_CVB, ii = i % T_CVB;
      int bl = ii / 8, jj = ii % 8, b = bl >> 2, l = bl & 3;
      transpose_tile<2>((wh ? p.in[7] : p.in[5]) + (size_t)bl * 512 * 128, 128, jj * 64, 0, KVL(p.ws, l, wh ? 5 : 4) + (size_t)b * 128 * 1536, 1536, 2, sm);
      continue;
    }
    i -= 2 * T_CVB;
    if (i < T_CKA) {
      size_t e = ((size_t)i * 256 + t) * 8;
      int d = e & 127, h = (e >> 7) & 3, pp = (e >> 9) & 511, l = (e >> 18) & 3, b = (int)(e >> 20);
      const float* sp = p.in[2] + e;
      float4 a = ld_nt4(sp), c = ld_nt4(sp + 4);
      u16* dp = KVL(p.ws, l, 0) + (((size_t)(b * 4 + h) * 1536 + pp) * 128 + d);
      *(uint4*)dp = make_uint4(pack2(a.x, a.y), pack2(a.z, a.w), pack2(c.x, c.y), pack2(c.z, c.w));
      continue;
    }
    i -= T_CKA;
    {
      int wh = i / T_CKB, ii = i % T_CKB;
      size_t e = ((size_t)ii * 256 + t) * 8;
      int d = e & 63, h = (e >> 6) & 1, pp = (e >> 7) & 511, l = (e >> 16) & 3, b = (int)(e >> 18);
      const float* sp = (wh ? p.in[6] : p.in[4]) + e;
      float4 a = ld_nt4(sp), c = ld_nt4(sp + 4);
      u16* dp = KVL(p.ws, l, wh ? 2 : 1) + (((size_t)(b * 2 + h) * 1536 + pp) * 64 + d);
      *(uint4*)dp = make_uint4(pack2(a.x, a.y), pack2(a.z, a.w), pack2(c.x, c.y), pack2(c.z, c.w));
    }
  }
}

DI void norm_phase(const Params& p, int l, int which) {
  const int lane = tid_() & 63;
  const int gw = blockIdx.x * 8 + (tid_() >> 6), nw = gridDim.x * 8;
  for (int row = gw; row < NTOK; row += nw) {
    float v[2][8];
    const bool from_input = (which == 0 && l == 0);
    if (from_input) {
      const float* x = row < NCTX ? p.in[0] + (size_t)row * DM : p.in[1] + (size_t)(row - NCTX) * DM;
#pragma unroll
      for (int c = 0; c < 2; ++c) {
        float4 a = ld_nt4(x + 8 * lane + 512 * c), b = ld_nt4(x + 8 * lane + 512 * c + 4);
        v[c][0] = a.x; v[c][1] = a.y; v[c][2] = a.z; v[c][3] = a.w; v[c][4] = b.x; v[c][5] = b.y; v[c][6] = b.z; v[c][7] = b.w;
      }
    } else {
      const u16* x = (const u16*)(p.ws + OFF_X) + (size_t)row * DM;
#pragma unroll
      for (int c = 0; c < 2; ++c) {
        uint4 a = *(const uint4*)(x + 8 * lane + 512 * c);
        v[c][0] = __uint_as_float(a.x << 16); v[c][1] = __uint_as_float(a.x & 0xffff0000u);
        v[c][2] = __uint_as_float(a.y << 16); v[c][3] = __uint_as_float(a.y & 0xffff0000u);
        v[c][4] = __uint_as_float(a.z << 16); v[c][5] = __uint_as_float(a.z & 0xffff0000u);
        v[c][6] = __uint_as_float(a.w << 16); v[c][7] = __uint_as_float(a.w & 0xffff0000u);
      }
    }
    float ss = 0.f;
#pragma unroll
    for (int c = 0; c < 2; ++c)
#pragma unroll
      for (int i = 0; i < 8; ++i) ss += v[c][i] * v[c][i];
    ss = wave_sum(ss);
    const float rs = rsqrtf(ss * (1.f / 1024.f) + 1e-6f);
    if (which == 2) {
      float* o = p.out + (row < NCTX ? O_YP + (size_t)row * DM : O_YS + (size_t)(row - NCTX) * DM);
#pragma unroll
      for (int c = 0; c < 2; ++c) {
        const int col = 8 * lane + 512 * c;
        float4 g0 = *(const float4*)(p.in[29] + col), g1 = *(const float4*)(p.in[29] + col + 4);
        st_nt4(o + col, make_float4(v[c][0] * rs * g0.x, v[c][1] * rs * g0.y, v[c][2] * rs * g0.z, v[c][3] * rs * g0.w));
        st_nt4(o + col + 4, make_float4(v[c][4] * rs * g1.x, v[c][5] * rs * g1.y, v[c][6] * rs * g1.z, v[c][7] * rs * g1.w));
      }
    } else {
      const float* gp = (which == 0 ? p.in[12] : p.in[13]) + l * 1024;
      const float* sh = mod_vec(p, l, row, which == 0 ? 0 : 3);
      const float* sc = mod_vec(p, l, row, which == 0 ? 1 : 4);
      u16* o = (u16*)(p.ws + OFF_HM) + (size_t)row * DM;
#pragma unroll
      for (int c = 0; c < 2; ++c) {
        const int col = 8 * lane + 512 * c;
        float gg[8], s1[8], s0[8];
        *(float4*)&gg[0] = *(const float4*)(gp + col); *(float4*)&gg[4] = *(const float4*)(gp + col + 4);
        *(float4*)&s1[0] = *(const float4*)(sc + col); *(float4*)&s1[4] = *(const float4*)(sc + col + 4);
        *(float4*)&s0[0] = *(const float4*)(sh + col); *(float4*)&s0[4] = *(const float4*)(sh + col + 4);
        float r[8];
#pragma unroll
        for (int i = 0; i < 8; ++i) r[i] = v[c][i] * rs * gg[i] * (1.f + s1[i]) + s0[i];
        *(uint4*)(o + col) = make_uint4(pack2(r[0], r[1]), pack2(r[2], r[3]), pack2(r[4], r[5]), pack2(r[6], r[7]));
      }
    }
  }
}

constexpr int SMEM_BYTES = 8 * 64 * 68 * 4;
enum { EPI_G1 = 0, EPI_G2 = 1, EPI_RES = 2, EPI_SWIGLU = 3 };

struct GemmArgs {
  const u16* A; int lda;
  const u16* Bt; int ldb;
  int K;
  int l;
  int res_chunk;
};

DI void g1_epilogue_wave(const Params& p, int l, int mrow0, int ncol0, const float* ct, int lane);

#define RAW_BARRIER() do { asm volatile("s_waitcnt lgkmcnt(0)" ::: "memory"); __builtin_amdgcn_s_barrier(); } while (0)

template <int EPI, int BN>
DI void gemm_tile(const Params& p, const GemmArgs& g, int m0, int n0, unsigned char* smem) {
  constexpr int NT = BN / 32;
  constexpr int NH = NT / 2;
  constexpr int NI = (256 + BN) / 128;
  constexpr int STAGE = (256 + BN) * 64;
  const int t = tid_(), lane = t & 63, w = t >> 6, wm = w >> 1, wn = w & 1, lc = lane & 15, lq = lane >> 4;
  f32x4 acc[4][NT];
  f32x4 tot[4][NT];
#pragma unroll
  for (int a = 0; a < 4; ++a)
#pragma unroll
    for (int b = 0; b < NT; ++b)
#pragma unroll
      for (int i = 0; i < 4; ++i) { acc[a][b][i] = 0.f; if (EPI == EPI_G2) tot[a][b][i] = 0.f; }

  const int nk = g.K >> 5;
  const int dl_rr = lane >> 2, dl_p = lane & 3;
  const u16* gsrc[NI];
#pragma unroll
  for (int i = 0; i < NI; ++i) {
    const int blk = i * 8 + w, kc = dl_p ^ (dl_rr >> 2);
    if (blk < 16) gsrc[i] = g.A + (size_t)(m0 + blk * 16 + dl_rr) * g.lda + kc * 8;
    else gsrc[i] = g.Bt + (size_t)(n0 + (blk - 16) * 16 + dl_rr) * g.ldb + kc * 8;
  }
  const int dma_off = w * 1024 + lane * 16;
  const unsigned smem_lds = (unsigned)(size_t)smem;
#define DMA_SLICE(J)                                                                                                   \
  {                                                                                                                    \
    unsigned char* bufp_ = smem + ((J) & 3) * STAGE + dma_off;                                                         \
    const size_t koff_ = (size_t)(J) * 32;                                                                             \
    _Pragma("unroll") for (int i_ = 0; i_ < NI; ++i_)                                                                  \
        __builtin_amdgcn_global_load_lds((const unsigned*)(gsrc[i_] + koff_), (LAS unsigned*)(bufp_ + i_ * 8192), 16, 0, 0); \
  }
  __syncthreads();
  DMA_SLICE(0) DMA_SLICE(1) DMA_SLICE(2)
  const unsigned frag_off = lc * 64 + (((lq ^ (lc >> 2)) & 3) << 4);
  const unsigned a_base = smem_lds + (wm * 4) * 1024 + frag_off;
  const unsigned b_base = smem_lds + 16384 + (wn * NT) * 1024 + frag_off;
  bf16x8 a0, a1, a2, a3, c0, c1, c2, c3, bl0, bl1, bl2, bl3, bh0, bh1, bh2, bh3;
#define RD4(ADDR, F0, F1, F2, F3)                                                                                      \
  asm volatile("ds_read_b128 %0, %4\n\tds_read_b128 %1, %4 offset:1024\n\tds_read_b128 %2, %4 offset:2048\n\t"         \
               "ds_read_b128 %3, %4 offset:3072"                                                                       \
               : "=&v"(F0), "=&v"(F1), "=&v"(F2), "=&v"(F3) : "v"(ADDR) : "memory");
#define RD2(ADDR, F0, F1)                                                                                              \
  asm volatile("ds_read_b128 %0, %2\n\tds_read_b128 %1, %2 offset:1024" : "=&v"(F0), "=&v"(F1) : "v"(ADDR) : "memory");
#define RD_B(ADDR, F0, F1, F2, F3) if (NH == 4) { RD4(ADDR, F0, F1, F2, F3) } else { RD2(ADDR, F0, F1) }
#define WT4(F0, F1, F2, F3) asm volatile("s_waitcnt lgkmcnt(0)" : "+v"(F0), "+v"(F1), "+v"(F2), "+v"(F3) :: "memory");
#define WT8(F0, F1, F2, F3, F4, F5, F6, F7)                                                                            \
  asm volatile("s_waitcnt lgkmcnt(0)" : "+v"(F0), "+v"(F1), "+v"(F2), "+v"(F3), "+v"(F4), "+v"(F5), "+v"(F6), "+v"(F7) :: "memory");
#define MF16(A, B, C) __builtin_amdgcn_mfma_f32_16x16x32_bf16((A), (B), (C), 0, 0, 0)
#define MM_HALF(A0, A1, A2, A3, B0, B1, B2, B3, NB)                                                                    \
  acc[0][(NB)] = MF16(A0, B0, acc[0][(NB)]); acc[1][(NB)] = MF16(A1, B0, acc[1][(NB)]);                                \
  acc[2][(NB)] = MF16(A2, B0, acc[2][(NB)]); acc[3][(NB)] = MF16(A3, B0, acc[3][(NB)]);                                \
  acc[0][(NB) + 1] = MF16(A0, B1, acc[0][(NB) + 1]); acc[1][(NB) + 1] = MF16(A1, B1, acc[1][(NB) + 1]);                \
  acc[2][(NB) + 1] = MF16(A2, B1, acc[2][(NB) + 1]); acc[3][(NB) + 1] = MF16(A3, B1, acc[3][(NB) + 1]);                \
  if (NH == 4) {                                                                                                       \
    acc[0][((NB) + 2) % NT] = MF16(A0, B2, acc[0][((NB) + 2) % NT]); acc[1][((NB) + 2) % NT] = MF16(A1, B2, acc[1][((NB) + 2) % NT]); \
    acc[2][((NB) + 2) % NT] = MF16(A2, B2, acc[2][((NB) + 2) % NT]); acc[3][((NB) + 2) % NT] = MF16(A3, B2, acc[3][((NB) + 2) % NT]); \
    acc[0][((NB) + 3) % NT] = MF16(A0, B3, acc[0][((NB) + 3) % NT]); acc[1][((NB) + 3) % NT] = MF16(A1, B3, acc[1][((NB) + 3) % NT]); \
    acc[2][((NB) + 3) % NT] = MF16(A2, B3, acc[2][((NB) + 3) % NT]); acc[3][((NB) + 3) % NT] = MF16(A3, B3, acc[3][((NB) + 3) % NT]); \
  }
#define SLICE_STEP(KT, A0, A1, A2, A3, N0, N1, N2, N3)                                                                 \
  {                                                                                                                    \
    if ((KT) + 2 < nk) { if (NI == 4) asm volatile("s_waitcnt vmcnt(4)" ::: "memory"); else asm volatile("s_waitcnt vmcnt(3)" ::: "memory"); } \
    else asm volatile("s_waitcnt vmcnt(0)" ::: "memory");                                                              \
    WT8(A0, A1, A2, A3, bl0, bl1, bl2, bl3)                                                                            \
    __builtin_amdgcn_s_barrier();                      \
    if ((KT) + 3 < nk) DMA_SLICE((KT) + 3)                                                                             \
    const unsigned so_ = ((KT) & 3) * STAGE;                                                                           \
    RD_B(b_base + so_ + NH * 1024, bh0, bh1, bh2, bh3)                                                                 \
    __builtin_amdgcn_sched_barrier(0);                                           \
    MM_HALF(A0, A1, A2, A3, bl0, bl1, bl2, bl3, 0)                                                                     \
    __builtin_amdgcn_sched_barrier(0);                                                                                 \
    WT4(bh0, bh1, bh2, bh3)                                                                                            \
    __builtin_amdgcn_s_barrier();     \
                                      \
      \
                                                                        \
    MM_PART(A0, A1, A2, A3, bh0, bh1, NH)                                                                              \
    __builtin_amdgcn_sched_barrier(0);                                                                                 \
    if ((KT) + 1 < nk) {                                                                                               \
      const unsigned sn_ = (((KT) + 1) & 3) * STAGE;                                                                   \
      RD4(a_base + sn_, N0, N1, N2, N3)                                                                                \
      RD_B(b_base + sn_, bl0, bl1, bl2, bl3)                                                                           \
    }                                                                                                                  \
    __builtin_amdgcn_sched_barrier(0);                                                                                 \
    MM_REST(A0, A1, A2, A3, bh0, bh1, bh2, bh3, NH)                                                                    \
    __builtin_amdgcn_sched_barrier(0);                                                                                 \
  }
#define MM_PART(A0, A1, A2, A3, B0, B1, NB)                                                                            \
  acc[0][(NB)] = MF16(A0, B0, acc[0][(NB)]); acc[1][(NB)] = MF16(A1, B0, acc[1][(NB)]);                                \
  acc[2][(NB)] = MF16(A2, B0, acc[2][(NB)]); acc[3][(NB)] = MF16(A3, B0, acc[3][(NB)]);                                \
  if (NH == 4) {                                                                                                       \
    acc[0][(NB) + 1] = MF16(A0, B1, acc[0][(NB) + 1]); acc[1][(NB) + 1] = MF16(A1, B1, acc[1][(NB) + 1]);              \
    acc[2][(NB) + 1] = MF16(A2, B1, acc[2][(NB) + 1]); acc[3][(NB) + 1] = MF16(A3, B1, acc[3][(NB) + 1]);              \
  }
#define MM_REST(A0, A1, A2, A3, B0, B1, B2, B3, NB)                                                                    \
  if (NH == 4) {                                                                                                       \
    acc[0][((NB) + 2) % NT] = MF16(A0, B2, acc[0][((NB) + 2) % NT]); acc[1][((NB) + 2) % NT] = MF16(A1, B2, acc[1][((NB) + 2) % NT]); \
    acc[2][((NB) + 2) % NT] = MF16(A2, B2, acc[2][((NB) + 2) % NT]); acc[3][((NB) + 2) % NT] = MF16(A3, B2, acc[3][((NB) + 2) % NT]); \
    acc[0][((NB) + 3) % NT] = MF16(A0, B3, acc[0][((NB) + 3) % NT]); acc[1][((NB) + 3) % NT] = MF16(A1, B3, acc[1][((NB) + 3) % NT]); \
    acc[2][((NB) + 3) % NT] = MF16(A2, B3, acc[2][((NB) + 3) % NT]); acc[3][((NB) + 3) % NT] = MF16(A3, B3, acc[3][((NB) + 3) % NT]); \
  } else {                                                                                                             \
    acc[0][(NB) + 1] = MF16(A0, B1, acc[0][(NB) + 1]); acc[1][(NB) + 1] = MF16(A1, B1, acc[1][(NB) + 1]);              \
    acc[2][(NB) + 1] = MF16(A2, B1, acc[2][(NB) + 1]); acc[3][(NB) + 1] = MF16(A3, B1, acc[3][(NB) + 1]);              \
  }
#ifndef PIPE_BN
#define PIPE_BN 256
#endif
#define SIMPLE_STEP(KT)                                                                                                \
  {                                                                                                                    \
    if ((KT) + 2 < nk) { if (NI == 4) asm volatile("s_waitcnt vmcnt(8)" ::: "memory"); else asm volatile("s_waitcnt vmcnt(6)" ::: "memory"); } \
    else if ((KT) + 1 < nk) { if (NI == 4) asm volatile("s_waitcnt vmcnt(4)" ::: "memory"); else asm volatile("s_waitcnt vmcnt(3)" ::: "memory"); } \
    else asm volatile("s_waitcnt vmcnt(0)" ::: "memory");                                                              \
    RAW_BARRIER();                                                                                                     \
    G2_PREFETCH(KT)                                                                                                    \
    if ((KT) + 3 < nk) DMA_SLICE((KT) + 3)                                                                             \
    const unsigned so_ = ((KT) & 3) * STAGE;                                                                           \
    RD4(a_base + so_, a0, a1, a2, a3)                                                                                  \
    RD_B(b_base + so_, bl0, bl1, bl2, bl3)                                                                             \
    RD_B(b_base + so_ + NH * 1024, bh0, bh1, bh2, bh3)                                                                 \
    WT8(a0, a1, a2, a3, bl0, bl1, bl2, bl3)                                                                            \
    WT4(bh0, bh1, bh2, bh3)                                                                                            \
    MM_HALF(a0, a1, a2, a3, bl0, bl1, bl2, bl3, 0)                                                                     \
    MM_HALF(a0, a1, a2, a3, bh0, bh1, bh2, bh3, NH)                                                                    \
  }
  u32x2 gqr[4][NT];
#pragma unroll
  for (int a = 0; a < 4; ++a)
#pragma unroll
    for (int b = 0; b < NT; ++b) gqr[a][b] = (u32x2){0u, 0u};
#define G2_PREFETCH(KT)                                                                                                \
  if (EPI == EPI_G2 && (((KT) & 15) == 15)) {                                                                          \
    const int seg_ = (KT) >> 4;                                                                                        \
    _Pragma("unroll") for (int a = 0; a < 4; ++a) _Pragma("unroll") for (int b = 0; b < NT; ++b) {                     \
      const int r16 = (m0 + wm * 64 + a * 16) >> 4, c16 = (seg_ * 1024 + n0 + wn * (BN / 2) + b * 16) >> 4;           \
      gqr[a][b] = __builtin_nontemporal_load((const u32x2*)((const u16*)(p.ws + OFF_GH) + ((size_t)(r16 * 192 + c16) * 64 + lane) * 4)); \
    }                                                                                                                  \
  }
  constexpr bool PIPE = true;
  c0 = c1 = c2 = c3 = a0 = a1 = a2 = a3 = bl0 = bl1 = bl2 = bl3 = bh0 = bh1 = bh2 = bh3 = (bf16x8)(0);
  if (PIPE) {
    if (NI == 4) asm volatile("s_waitcnt vmcnt(8)" ::: "memory"); else asm volatile("s_waitcnt vmcnt(6)" ::: "memory");
    RAW_BARRIER();
    RD4(a_base, a0, a1, a2, a3)
    RD_B(b_base, bl0, bl1, bl2, bl3)
    if (w >= 4) __builtin_amdgcn_s_barrier();
  }
  for (int kt = 0; kt < nk; kt += 2) {
    if (PIPE) {
      SLICE_STEP(kt, a0, a1, a2, a3, c0, c1, c2, c3)
      SLICE_STEP(kt + 1, c0, c1, c2, c3, a0, a1, a2, a3)
    } else {
      SIMPLE_STEP(kt)
      SIMPLE_STEP(kt + 1)
    }
    if (EPI == EPI_G2) {
      if (((kt + 1) & 15) == 15) {
        const int seg = (kt + 1) >> 4;
        if (PIPE) {
#pragma unroll
          for (int a = 0; a < 4; ++a)
#pragma unroll
            for (int b = 0; b < NT; ++b) {
              const int r16 = (m0 + wm * 64 + a * 16) >> 4, c16 = (seg * 1024 + n0 + wn * (BN / 2) + b * 16) >> 4;
              gqr[a][b] = __builtin_nontemporal_load((const u32x2*)((const u16*)(p.ws + OFF_GH) + ((size_t)(r16 * 192 + c16) * 64 + lane) * 4));
            }
          WT8(a0, a1, a2, a3, bl0, bl1, bl2, bl3)
        }
#pragma unroll
        for (int a = 0; a < 4; ++a)
#pragma unroll
          for (int b = 0; b < NT; ++b) {
            const int r16 = (m0 + wm * 64 + a * 16) >> 4, c16 = (seg * 1024 + n0 + wn * (BN / 2) + b * 16) >> 4;
            const u32x2 gq_ = gqr[a][b];
            const uint2 gq = make_uint2(gq_[0], gq_[1]);
            tot[a][b][0] += __uint_as_float(gq.x << 16) * acc[a][b][0];
            tot[a][b][1] += __uint_as_float(gq.x & 0xffff0000u) * acc[a][b][1];
            tot[a][b][2] += __uint_as_float(gq.y << 16) * acc[a][b][2];
            tot[a][b][3] += __uint_as_float(gq.y & 0xffff0000u) * acc[a][b][3];
            acc[a][b][0] = 0.f; acc[a][b][1] = 0.f; acc[a][b][2] = 0.f; acc[a][b][3] = 0.f;
          }
      }
    }
  }
  if (PIPE && w < 4) __builtin_amdgcn_s_barrier();
  __syncthreads();

  const int rbase = m0 + wm * 64, cbase = n0 + wn * (BN / 2);
  if (EPI == EPI_G1) {
    if (n0 >= 3072) {
#pragma unroll
      for (int a = 0; a < 4; ++a)
#pragma unroll
        for (int b = 0; b < NT; ++b) {
          const int r16 = (rbase + a * 16) >> 4, c16 = (cbase - 3072 + b * 16) >> 4;
          u16* gp = (u16*)(p.ws + OFF_GH) + ((size_t)(r16 * 192 + c16) * 64 + lane) * 4;
          *(uint2*)gp = make_uint2(pack2(sigmoidf_(acc[a][b][0]), sigmoidf_(acc[a][b][1])), pack2(sigmoidf_(acc[a][b][2]), sigmoidf_(acc[a][b][3])));
        }
    } else {
      float* ct = (float*)smem + w * (64 * 68);
#pragma unroll
      for (int hf = 0; hf < NT / 4; ++hf) {
#pragma unroll
        for (int a = 0; a < 4; ++a)
#pragma unroll
          for (int b = 0; b < 4; ++b)
#pragma unroll
            for (int i = 0; i < 4; ++i)
              ct[(a * 16 + 4 * lq + i) * 68 + b * 16 + lc] = acc[a][(hf * 4 + b) % NT][i];
        g1_epilogue_wave(p, g.l, rbase, cbase + hf * 64, ct, lane);
      }
    }
  } else if (EPI == EPI_G2) {
    u16* o = (u16*)(p.ws + OFF_HM);
    float* ct = (float*)smem + w * (64 * 68);
#pragma unroll
    for (int a = 0; a < 4; ++a)
#pragma unroll
      for (int b = 0; b < NT; ++b)
#pragma unroll
        for (int i = 0; i < 4; ++i) ct[(a * 16 + 4 * lq + i) * 68 + b * 16 + lc] = tot[a][b][i];
#pragma unroll 8
    for (int it = lane; it < 512; it += 64) {
      const int rl = it >> 3, c8 = (it & 7) * 8;
      float4 v0 = *(const float4*)(ct + rl * 68 + c8), v1 = *(const float4*)(ct + rl * 68 + c8 + 4);
      *(uint4*)(o + (size_t)(rbase + rl) * DM + cbase + c8) = make_uint4(pack2(v0.x, v0.y), pack2(v0.z, v0.w), pack2(v1.x, v1.y), pack2(v1.z, v1.w));
    }
  } else if (EPI == EPI_RES) {
    u16* xo = (u16*)(p.ws + OFF_X);
    const bool from_input = (g.res_chunk == 2) && g.l == 0;
    float* ct = (float*)smem + w * (64 * 68);
#pragma unroll
    for (int a = 0; a < 4; ++a)
#pragma unroll
      for (int b = 0; b < NT; ++b)
#pragma unroll
        for (int i = 0; i < 4; ++i) ct[(a * 16 + 4 * lq + i) * 68 + b * 16 + lc] = acc[a][b][i];
#pragma unroll 8
    for (int it = lane; it < 512; it += 64) {
      const int rl = it >> 3, c8 = (it & 7) * 8;
      const int row = rbase + rl, col = cbase + c8;
      float4 v0 = *(const float4*)(ct + rl * 68 + c8), v1 = *(const float4*)(ct + rl * 68 + c8 + 4);
      const float* gate = mod_vec(p, g.l, row, g.res_chunk) + col;
      float4 g0 = *(const float4*)gate, g1 = *(const float4*)(gate + 4);
      float x[8];
      if (from_input) {
        const float* xin = (row < NCTX ? p.in[0] + (size_t)row * DM : p.in[1] + (size_t)(row - NCTX) * DM) + col;
        float4 a0 = ld_nt4(xin), a1 = ld_nt4(xin + 4);
        x[0] = a0.x; x[1] = a0.y; x[2] = a0.z; x[3] = a0.w; x[4] = a1.x; x[5] = a1.y; x[6] = a1.z; x[7] = a1.w;
      } else {
        uint4 xb = *(const uint4*)(xo + (size_t)row * DM + col);
        x[0] = __uint_as_float(xb.x << 16); x[1] = __uint_as_float(xb.x & 0xffff0000u);
        x[2] = __uint_as_float(xb.y << 16); x[3] = __uint_as_float(xb.y & 0xffff0000u);
        x[4] = __uint_as_float(xb.z << 16); x[5] = __uint_as_float(xb.z & 0xffff0000u);
        x[6] = __uint_as_float(xb.w << 16); x[7] = __uint_as_float(xb.w & 0xffff0000u);
      }
      x[0] += g0.x * v0.x; x[1] += g0.y * v0.y; x[2] += g0.z * v0.z; x[3] += g0.w * v0.w;
      x[4] += g1.x * v1.x; x[5] += g1.y * v1.y; x[6] += g1.z * v1.z; x[7] += g1.w * v1.w;
      *(uint4*)(xo + (size_t)row * DM + col) = make_uint4(pack2(x[0], x[1]), pack2(x[2], x[3]), pack2(x[4], x[5]), pack2(x[6], x[7]));
    }
  } else if (EPI == EPI_SWIGLU) {
    u16* o = (u16*)(p.ws + OFF_GH);
    float* ct = (float*)smem + w * (64 * 68);
#pragma unroll
    for (int a = 0; a < 4; ++a)
#pragma unroll
      for (int b = 0; b < NT / 2; ++b)
#pragma unroll
        for (int i = 0; i < 4; ++i) ct[(a * 16 + 4 * lq + i) * 68 + b * 16 + lc] = siluf_(acc[a][b][i]) * acc[a][(b + NT / 2) % NT][i];
    const int colb0 = (n0 >> 8) * 128 + wn * 64;
#pragma unroll 8
    for (int it = lane; it < 512; it += 64) {
      const int rl = it >> 3, c8 = (it & 7) * 8;
      float4 v0 = *(const float4*)(ct + rl * 68 + c8), v1 = *(const float4*)(ct + rl * 68 + c8 + 4);
      *(uint4*)(o + (size_t)(rbase + rl) * DFF + colb0 + c8) = make_uint4(pack2(v0.x, v0.y), pack2(v0.z, v0.w), pack2(v1.x, v1.y), pack2(v1.z, v1.w));
    }
  }
}

DI void g1_epilogue_wave(const Params& p, int l, int mrow0, int ncol0, const float* ct, int lane) {
  const bool ctx = mrow0 < NCTX;
  int kind;
  int br;
  int nrel;
  const int n0 = ncol0;
  if (n0 < 512) { kind = 0; br = 0; nrel = n0; }
  else if (n0 < 1024) { kind = 1; br = 0; nrel = n0 - 512; }
  else if (n0 < 1536) { kind = 2; br = 0; nrel = n0 - 1024; }
  else if (n0 < 2048) { kind = 0; br = 1; nrel = n0 - 1536; }
  else if (n0 < 2176) { kind = 1; br = 1; nrel = n0 - 2048; }
  else if (n0 < 2304) { kind = 2; br = 1; nrel = n0 - 2176; }
  else if (n0 < 2816) { kind = 0; br = 2; nrel = n0 - 2304; }
  else if (n0 < 2944) { kind = 1; br = 2; nrel = n0 - 2816; }
  else { kind = 2; br = 2; nrel = n0 - 2944; }

  if (kind < 2) {
    const int j = lane & 7, grp = lane >> 3;
    const float* cosT = (const float*)(p.ws + OFF_ROPE);
    const float* sinT = cosT + 1024 * 32;
    const float* gn = (kind == 0 ? p.in[20] : p.in[21]) + l * 64;
    for (int rl = grp; rl < 64; rl += 8) {
      const int row = mrow0 + rl;
      const float* cp = ct + rl * 68;
      float4 lo = *(const float4*)(cp + 4 * j), hi = *(const float4*)(cp + 32 + 4 * j);
      if (br == 1) {
        float ss = lo.x * lo.x + lo.y * lo.y + lo.z * lo.z + lo.w * lo.w + hi.x * hi.x + hi.y * hi.y + hi.z * hi.z + hi.w * hi.w;
        ss += __shfl_xor(ss, 1); ss += __shfl_xor(ss, 2); ss += __shfl_xor(ss, 4);
        float rs = rsqrtf(ss * (1.f / 64.f) + 1e-6f);
        float4 g0 = *(const float4*)(gn + 4 * j), g1 = *(const float4*)(gn + 32 + 4 * j);
        lo.x *= rs * g0.x; lo.y *= rs * g0.y; lo.z *= rs * g0.z; lo.w *= rs * g0.w;
        hi.x *= rs * g1.x; hi.y *= rs * g1.y; hi.z *= rs * g1.z; hi.w *= rs * g1.w;
      }
      if (!ctx) {
        const int pos = (row - NCTX) & 1023;
        float4 c = *(const float4*)(cosT + pos * 32 + 4 * j), sn = *(const float4*)(sinT + pos * 32 + 4 * j);
        float4 nlo = make_float4(lo.x * c.x - hi.x * sn.x, lo.y * c.y - hi.y * sn.y, lo.z * c.z - hi.z * sn.z, lo.w * c.w - hi.w * sn.w);
        float4 nhi = make_float4(hi.x * c.x + lo.x * sn.x, hi.y * c.y + lo.y * sn.y, hi.z * c.z + lo.z * sn.z, hi.w * c.w + lo.w * sn.w);
        lo = nlo; hi = nhi;
      }
      const int nc = nrel;
      if (kind == 0) {
        u16* q = (u16*)(p.ws + OFF_Q) + (size_t)row * 1536 + br * 512 + nc;
        *(uint2*)(q + 4 * j) = make_uint2(pack2(lo.x * 0.125f, lo.y * 0.125f), pack2(lo.z * 0.125f, lo.w * 0.125f));
        *(uint2*)(q + 32 + 4 * j) = make_uint2(pack2(hi.x * 0.125f, hi.y * 0.125f), pack2(hi.z * 0.125f, hi.w * 0.125f));
      } else {
        const int hd = (br == 0) ? 128 : 64, nh = (br == 0) ? 4 : 2;
        const int head = nc / hd, d = nc % hd;
        u16* kd;
        if (ctx) {
          const int b = row >> 8, key = row & 255;
          kd = KVC(p.ws, br) + ((size_t)(b * nh + head) * 256 + key) * hd + d;
          float* od = p.out + (br == 0 ? O_AK : (br == 1 ? O_BK : O_CK)) + ((size_t)((b * 4 + l) * 256 + key) * nh + head) * hd + d;
          st_nt4(od + 4 * j, lo);
          st_nt4(od + 32 + 4 * j, hi);
        } else {
          const int b = (row - NCTX) >> 10, pos = (row - NCTX) & 1023;
          kd = KVL(p.ws, l, br) + ((size_t)(b * nh + head) * 1536 + 512 + pos) * hd + d;
        }
        *(uint2*)(kd + 4 * j) = make_uint2(pack2(lo.x, lo.y), pack2(lo.z, lo.w));
        *(uint2*)(kd + 32 + 4 * j) = make_uint2(pack2(hi.x, hi.y), pack2(hi.z, hi.w));
      }
    }
  } else {
    const int nrows = (br == 0) ? 512 : 128;
    for (int it = lane; it < 256; it += 64) {
      const int gq = it & 3, c = it >> 2;
      const int row0 = mrow0 + gq * 16;
      float v[16];
#pragma unroll
      for (int i = 0; i < 16; ++i) v[i] = ct[(gq * 16 + i) * 68 + c];
      u16* vd;
      if (ctx) {
        const int b = row0 >> 8, key = row0 & 255;
        vd = KVC(p.ws, 3 + br) + ((size_t)b * nrows + nrel + c) * 256 + key;
      } else {
        const int b = (row0 - NCTX) >> 10, pos = (row0 - NCTX) & 1023;
        vd = KVL(p.ws, l, 3 + br) + ((size_t)b * nrows + nrel + c) * 1536 + 512 + pos;
      }
      *(uint4*)vd = make_uint4(pack2(v[0], v[1]), pack2(v[2], v[3]), pack2(v[8], v[9]), pack2(v[10], v[11]));
      *(uint4*)(vd + 8) = make_uint4(pack2(v[4], v[5]), pack2(v[6], v[7]), pack2(v[12], v[13]), pack2(v[14], v[15]));
    }
    if (ctx) {
      float* ob = p.out + (br == 0 ? O_AV : (br == 1 ? O_BV : O_CV));
      for (int it = lane; it < 1024; it += 64) {
        const int rl = it >> 4, c4 = (it & 15) * 4;
        const int row = mrow0 + rl, b = row >> 8, key = row & 255;
        float4 v = *(const float4*)(ct + rl * 68 + c4);
        st_nt4(ob + (size_t)((b * 4 + l) * 256 + key) * nrows + nrel + c4, v);
      }
    }
  }
}

template <int EPI, int BN>
DI void gemm_phase(const Params& p, const GemmArgs& g, int ntn, unsigned char* smem) {
  if (gridDim.x == 256) {
    const int xcd = blockIdx.x & 7, j = blockIdx.x >> 3;
    for (int il = j; il < 4 * ntn; il += 32) {
      const int mt = 4 * xcd + (il & 3), nt = il >> 2;
      gemm_tile<EPI, BN>(p, g, mt * 256, nt * BN, smem);
    }
  } else {
    const int ntiles = 32 * ntn;
    for (int tile = blockIdx.x; tile < ntiles; tile += gridDim.x) {
      const int mt = tile / ntn, nt = tile % ntn;
      gemm_tile<EPI, BN>(p, g, mt * 256, nt * BN, smem);
    }
  }
}

constexpr float LOG2E = 1.4426950408889634f;
constexpr int N_ATT_ITEMS = 768;
constexpr int VT_PITCH = 144;

DI void load_q(bf16x8 (&qf)[4], const u16* Q, int row, int coloff, int h) {
  const u16* qp = Q + (size_t)row * 1536 + coloff + 8 * h;
#pragma unroll
  for (int s = 0; s < 4; ++s) qf[s] = __builtin_nontemporal_load((const bf16x8*)(qp + 16 * s));
}

template <int DV, int KD>
DI void attn_item(f32x16 (&o)[DV / 32], unsigned char* smem, const u16* __restrict__ Kg, const u16* __restrict__ Vg, int nkeys,
                  int n_tiles, int band_t0, const bf16x8 (&qf)[4], int koff, bool has_band, int qpos, float m_init, float l_init) {
  constexpr int KPITCH = KD * 2 + 16;
  constexpr int KBYTES = 64 * KPITCH;
  constexpr int VBYTES = DV * VT_PITCH;
  constexpr int BUF = KBYTES + VBYTES;
  constexpr int KCH = KD / 8;
  constexpr int NK = KD / 64;
  constexpr int NV = DV / 64;
  const int t = tid_(), lane = t & 63, r = lane & 31, h = lane >> 5;
  const int krow = t / KCH, kkc = t % KCH;
  const int vrow = t >> 3, vkc = t & 7;
  const u16* kgp = Kg + (size_t)krow * KD + kkc * 8;
  const u16* vgp = Vg + (size_t)vrow * nkeys + vkc * 8;
  const int klds = krow * KPITCH + kkc * 16;
  const int vlds = KBYTES + vrow * VT_PITCH + vkc * 16;
  uint4 k0, k1, v0, v1;
  k1 = v1 = make_uint4(0, 0, 0, 0);
#define ATT_TILE(i) ((i) < 8 || !has_band ? (i) : 8 + band_t0 + (i) - 8)
#define ATT_GLOAD(TI)                                                                   \
  {                                                                                     \
    const size_t key0_ = (size_t)(TI) * 64;                                             \
    k0 = *(const uint4*)(kgp + key0_ * KD);                                             \
    if (NK == 2) k1 = *(const uint4*)(kgp + (key0_ + 32) * KD);                         \
    v0 = *(const uint4*)(vgp + key0_);                                                  \
    if (NV == 2) v1 = *(const uint4*)(vgp + key0_ + (size_t)64 * nkeys);                \
  }
#define ATT_LSTORE(DST)                                                                 \
  {                                                                                     \
    *(uint4*)((DST) + klds) = k0;                                                       \
    if (NK == 2) *(uint4*)((DST) + klds + 32 * KPITCH) = k1;                            \
    *(uint4*)((DST) + vlds) = v0;                                                       \
    if (NV == 2) *(uint4*)((DST) + vlds + 64 * VT_PITCH) = v1;                          \
  }
  float m = m_init, l = l_init;
#pragma unroll
  for (int dt = 0; dt < DV / 32; ++dt)
#pragma unroll
    for (int i = 0; i < 16; ++i) o[dt][i] = 0.f;

  ATT_GLOAD(ATT_TILE(0))
  __syncthreads();
  ATT_LSTORE(smem)
  __syncthreads();
  for (int it = 0; it < n_tiles; ++it) {
    const int cur = it & 1;
    const int tile = ATT_TILE(it);
    if (it + 1 < n_tiles) ATT_GLOAD(ATT_TILE(it + 1))
    const unsigned char* kb = smem + cur * BUF + r * KPITCH + (koff + 8 * h) * 2;
    const unsigned char* vb = smem + cur * BUF + KBYTES + r * VT_PITCH + 16 * h;
    f32x16 S0, S1;
#pragma unroll
    for (int i = 0; i < 16; ++i) { S0[i] = 0.f; S1[i] = 0.f; }
#pragma unroll
    for (int s = 0; s < 4; ++s) {
      bf16x8 ka = *(const bf16x8*)(kb + 32 * s);
      bf16x8 kc = *(const bf16x8*)(kb + 32 * KPITCH + 32 * s);
      S0 = MFMA32(ka, qf[s], S0);
      S1 = MFMA32(kc, qf[s], S1);
    }
    if (has_band && it >= 8) {
      const int kbase = (tile - 8) * 64 - qpos;
#pragma unroll
      for (int i = 0; i < 16; ++i) {
        int d0 = kbase + crow(i, h), d1 = d0 + 32;
        if (d0 < -128 || d0 > 128) S0[i] = -1e30f;
        if (d1 < -128 || d1 > 128) S1[i] = -1e30f;
      }
    }
    float mx = fmaxf(S0[0], S1[0]);
#pragma unroll
    for (int i = 1; i < 16; ++i) mx = __builtin_fmaxf(__builtin_fmaxf(mx, S0[i]), S1[i]);
    mx = fmaxf(mx, __shfl_xor(mx, 32));
    const float mn = fmaxf(m, mx);
    const float mb = mn * LOG2E;
    float ps;
    {
      const f2_t sc2 = {LOG2E, LOG2E}, nb2 = {-mb, -mb};
      f2_t ps2 = {0.f, 0.f};
#pragma unroll
      for (int i = 0; i < 8; ++i) {
        f2_t a = {S0[2 * i], S0[2 * i + 1]}, b = {S1[2 * i], S1[2 * i + 1]};
        a = __builtin_elementwise_fma(a, sc2, nb2);
        b = __builtin_elementwise_fma(b, sc2, nb2);
        a.x = __builtin_amdgcn_exp2f(a.x); a.y = __builtin_amdgcn_exp2f(a.y);
        b.x = __builtin_amdgcn_exp2f(b.x); b.y = __builtin_amdgcn_exp2f(b.y);
        S0[2 * i] = a.x; S0[2 * i + 1] = a.y; S1[2 * i] = b.x; S1[2 * i + 1] = b.y;
        ps2 += a; ps2 += b;
      }
      ps = ps2.x + ps2.y;
    }
    if (__any(mn != m)) {
      const float alpha = __builtin_amdgcn_exp2f((m - mn) * LOG2E);
      l *= alpha;
#pragma unroll
      for (int dt = 0; dt < DV / 32; ++dt)
#pragma unroll
        for (int i = 0; i < 16; ++i) o[dt][i] *= alpha;
      m = mn;
    }
    l += ps;
    bf16x8 pf0, pf1, pf2, pf3;
    {
      uint4 u;
      u = make_uint4(pack2(S0[0], S0[1]), pack2(S0[2], S0[3]), pack2(S0[4], S0[5]), pack2(S0[6], S0[7])); pf0 = __builtin_bit_cast(bf16x8, u);
      u = make_uint4(pack2(S0[8], S0[9]), pack2(S0[10], S0[11]), pack2(S0[12], S0[13]), pack2(S0[14], S0[15])); pf1 = __builtin_bit_cast(bf16x8, u);
      u = make_uint4(pack2(S1[0], S1[1]), pack2(S1[2], S1[3]), pack2(S1[4], S1[5]), pack2(S1[6], S1[7])); pf2 = __builtin_bit_cast(bf16x8, u);
      u = make_uint4(pack2(S1[8], S1[9]), pack2(S1[10], S1[11]), pack2(S1[12], S1[13]), pack2(S1[14], S1[15])); pf3 = __builtin_bit_cast(bf16x8, u);
    }
#pragma unroll
    for (int dt = 0; dt < DV / 32; ++dt) {
      const unsigned char* vp = vb + dt * 32 * VT_PITCH;
      o[dt] = MFMA32(*(const bf16x8*)(vp), pf0, o[dt]);
      o[dt] = MFMA32(*(const bf16x8*)(vp + 32), pf1, o[dt]);
      o[dt] = MFMA32(*(const bf16x8*)(vp + 64), pf2, o[dt]);
      o[dt] = MFMA32(*(const bf16x8*)(vp + 96), pf3, o[dt]);
    }
    if (it + 1 < n_tiles) {
      unsigned char* dst = smem + (cur ^ 1) * BUF;
      ATT_LSTORE(dst)
    }
    __syncthreads();
  }
  const float lt = l + __shfl_xor(l, 32);
  const float inv = 1.f / lt;
#pragma unroll
  for (int dt = 0; dt < DV / 32; ++dt)
#pragma unroll
    for (int i = 0; i < 16; ++i) o[dt][i] *= inv;
}

DI void attn_phase(const Params& p, int l, int ph, unsigned char* smem) {
  __shared__ int s_item;
  const int t = tid_(), lane = t & 63, wv = t >> 6, r = lane & 31, h = lane >> 5;
  const u16* Q = (const u16*)(p.ws + OFF_Q);
  u16* AO = (u16*)(p.ws + OFF_ATT);
  unsigned* ctr = (unsigned*)(p.ws + OFF_BAR + 14336) + ph;
  float lam;
  {
    float a = p.in[15][l * 64 + lane] * p.in[16][l * 64 + lane];
    float b = p.in[17][l * 64 + lane] * p.in[18][l * 64 + lane];
    a = wave_sum(a); b = wave_sum(b);
    lam = __expf(a) - __expf(b) + p.lam_init[l];
  }
  const float one_m_li = 1.f - p.lam_init[l];
  const bool static_first = gridDim.x == 256;
  int round = 0;
  for (;;) {
    __syncthreads();
    if (t == 0) {
      const int xcd = blockIdx.x & 7, j = blockIdx.x >> 3;
      if (round == 0 && static_first) {
        if (j < 16) { const int g = 2 * xcd + (j >> 3); s_item = (g >> 2) * 32 + (g & 3) * 8 + (j & 7); }
        else s_item = 128 + (xcd >> 1) * 32 + (xcd & 1) * 16 + (j - 16);
      } else if (round == 1 && static_first && j >= 16) {
        s_item = 256 + (xcd >> 1) * 32 + (xcd & 1) * 16 + (j - 16);
      } else if (round == 1 && static_first) {
        s_item = 384 + (2 * xcd + (j >> 3)) * 8 + (j & 7);
      } else {
        s_item = (static_first ? 512 : 0) + (int)atomicAdd(ctr, 1u);
      }
    }
    ++round;
    __syncthreads();
    const int it = s_item;
    if (it >= N_ATT_ITEMS) break;
    const int cls = it >> 7, i = it & 127;
    const int lat = cls < 3, br = cls % 3;
    const int nkeys = lat ? 1536 : 256;
    if (br == 0) {
      int b, hd, qb;
      if (lat) { b = i >> 5; hd = (i >> 3) & 3; qb = i & 7; } else { b = i >> 3; hd = (i >> 1) & 3; qb = i & 1; }
      const int pass = wv >> 2;
      const int row = (lat ? NCTX + b * 1024 : b * 256) + qb * 128 + (wv & 3) * 32 + r;
      const u16* Kb = (lat ? KVL(p.ws, l, 0) : KVC(p.ws, 0)) + (size_t)(b * 4 + hd) * nkeys * 128;
      const u16* Vb = (lat ? KVL(p.ws, l, 3) : KVC(p.ws, 3)) + (size_t)(b * 4 + hd) * 128 * nkeys;
      bf16x8 qf[4];
      load_q(qf, Q, row, hd * 128 + pass * 64, h);
      f32x16 o[4];
      attn_item<128, 128>(o, smem, Kb, Vb, nkeys, nkeys / 64, 0, qf, pass * 64, false, 0, -1e30f, 0.f);
      float* stash = (float*)smem + (wv & 3) * 4096;
      if (pass == 1) {
#pragma unroll
        for (int dt = 0; dt < 4; ++dt)
#pragma unroll
          for (int q = 0; q < 16; ++q) stash[(dt * 16 + q) * 64 + lane] = o[dt][q];
      }
      __syncthreads();
      if (pass == 0) {
        float ss = 0.f;
#pragma unroll
        for (int dt = 0; dt < 4; ++dt)
#pragma unroll
          for (int q = 0; q < 16; ++q) {
            float v = o[dt][q] - lam * stash[(dt * 16 + q) * 64 + lane];
            o[dt][q] = v;
            ss += v * v;
          }
        ss += __shfl_xor(ss, 32);
        const float rs = rsqrtf(ss * (1.f / 128.f) + 1e-6f) * one_m_li;
        const float* sg = p.in[19] + l * 128;
        u16* tl = (u16*)(smem + 65536 + wv * 8704);
#pragma unroll
        for (int dt = 0; dt < 4; ++dt)
#pragma unroll
          for (int g4 = 0; g4 < 4; ++g4) {
            const int d = dt * 32 + 8 * g4 + 4 * h;
            float4 gg = *(const float4*)(sg + d);
            unsigned w0 = pack2(o[dt][4 * g4] * rs * gg.x, o[dt][4 * g4 + 1] * rs * gg.y);
            unsigned w1 = pack2(o[dt][4 * g4 + 2] * rs * gg.z, o[dt][4 * g4 + 3] * rs * gg.w);
            *(uint2*)(tl + r * 136 + d) = make_uint2(w0, w1);
          }
        u16* ob = AO + (size_t)(row - r) * 1536 + hd * 128;
#pragma unroll
        for (int q = 0; q < 8; ++q) {
          const int itx = lane + 64 * q, rr = itx >> 4, c8 = (itx & 15) * 8;
          *(uint4*)(ob + (size_t)rr * 1536 + c8) = *(const uint4*)(tl + rr * 136 + c8);
        }
      }
    } else {
      int b, kvh, qg;
      if (lat) { b = i >> 5; kvh = (i >> 4) & 1; qg = i & 15; } else { b = i >> 3; kvh = (i >> 2) & 1; qg = i & 3; }
      const int hd = kvh * 4 + (wv & 3), qsub = wv >> 2;
      const int row = (lat ? NCTX + b * 1024 : b * 256) + qg * 64 + qsub * 32 + r;
      const u16* Kb = (lat ? KVL(p.ws, l, br) : KVC(p.ws, br)) + (size_t)(b * 2 + kvh) * nkeys * 64;
      const u16* Vb = (lat ? KVL(p.ws, l, 3 + br) : KVC(p.ws, 3 + br)) + (size_t)(b * 2 + kvh) * 64 * nkeys;
      bf16x8 qf[4];
      load_q(qf, Q, row, br * 512 + hd * 64, h);
      f32x16 o[2];
      const bool band = (br == 2) && lat;
      int n_tiles = nkeys / 64, t0 = 0;
      if (band) {
        const int q0 = qg * 64;
        t0 = (q0 - 128) < 0 ? 0 : (q0 - 128) >> 6;
        int t1 = (q0 + 191) >> 6; if (t1 > 15) t1 = 15;
        n_tiles = 8 + (t1 - t0 + 1);
      }
      const float m0 = (br == 2) ? p.in[22][l * 8 + hd] : -1e30f;
      const float l0 = (br == 2 && h == 0) ? 1.f : 0.f;
      attn_item<64, 64>(o, smem, Kb, Vb, nkeys, n_tiles, t0, qf, 0, band, qg * 64 + qsub * 32 + r, m0, l0);
      u16* tl = (u16*)(smem + 65536 + wv * 8704);
#pragma unroll
      for (int dt = 0; dt < 2; ++dt)
#pragma unroll
        for (int g4 = 0; g4 < 4; ++g4) {
          const int d = dt * 32 + 8 * g4 + 4 * h;
          unsigned w0 = pack2(o[dt][4 * g4], o[dt][4 * g4 + 1]);
          unsigned w1 = pack2(o[dt][4 * g4 + 2], o[dt][4 * g4 + 3]);
          *(uint2*)(tl + r * 72 + d) = make_uint2(w0, w1);
        }
      u16* ob = AO + (size_t)(row - r) * 1536 + br * 512 + hd * 64;
#pragma unroll
      for (int q = 0; q < 4; ++q) {
        const int itx = lane + 64 * q, rr = itx >> 3, c8 = (itx & 7) * 8;
        *(uint4*)(ob + (size_t)rr * 1536 + c8) = *(const uint4*)(tl + rr * 72 + c8);
      }
    }
  }
}

#define XB_TMO      128
#define XB_XCNT(j)  (256  + 64 * (j))
#define XB_XSUB(j)  (1280 + 64 * (j))
#define XB_XGEN(j)  (2304 + 64 * (j))
#define XB_TOP      3328
#define XB_TOPGEN   3392
#define XCD_BAR_WORDS 3456
#define XB_SPIN_CAP (1u << 22)
DI unsigned xb_ld(unsigned* p) { return __hip_atomic_load(p, __ATOMIC_RELAXED, __HIP_MEMORY_SCOPE_AGENT); }
DI unsigned xb_add(unsigned* p, unsigned v) { return __hip_atomic_fetch_add(p, v, __ATOMIC_RELAXED, __HIP_MEMORY_SCOPE_AGENT); }
DI unsigned xb_xcc_id() { return (unsigned)__builtin_amdgcn_s_getreg((3 << 11) | 20) & 0xFu; }
#define XB_SPIN(cond, bar) do { unsigned _sp = 0; while (cond) { __builtin_amdgcn_s_sleep(1); \
    if ((++_sp & 255u) == 0u) { if (xb_ld(&(bar)[XB_TMO])) break; if (_sp > XB_SPIN_CAP) { atomicAdd(&(bar)[XB_TMO], 1u); break; } } } } while (0)
struct XcdBarrier { unsigned* bar; unsigned x; volatile LAS unsigned* st; };
DI XcdBarrier xcd_barrier_post(unsigned* bar, volatile LAS unsigned* st) {
  XcdBarrier b; b.bar = bar; b.x = xb_xcc_id(); b.st = st;
  if (threadIdx.x == 0) (void)xb_add(&bar[XB_XCNT(b.x)], 1u);
  return b;
}
DI void xcd_barrier_complete(unsigned* bar, unsigned x, unsigned& nloc, unsigned& nx) {
  const unsigned G = gridDim.x * gridDim.y * gridDim.z;
  unsigned sum, cnt, mine, sp = 0u;
  for (;;) {
    sum = 0u; cnt = 0u; mine = 0u;
#pragma unroll
    for (unsigned j = 0; j < 16; ++j) { const unsigned c = xb_ld(&bar[XB_XCNT(j)]); sum += c; cnt += (c > 0u) ? 1u : 0u; mine = (j == x) ? c : mine; }
    if (sum == G) break;
    __builtin_amdgcn_s_sleep(1);
    if ((++sp & 255u) == 0u) { if (xb_ld(&bar[XB_TMO])) break; if (sp > XB_SPIN_CAP) { atomicAdd(&bar[XB_TMO], 1u); break; } }
  }
  nloc = mine > 0u ? mine : 1u; nx = cnt > 0u ? cnt : 1u;
}
DI void xcd_barrier(const XcdBarrier& b) {
  asm volatile("s_waitcnt vmcnt(0)" ::: "memory");
  __syncthreads();
  if (threadIdx.x == 0) {
    unsigned* bar = b.bar;
    __builtin_amdgcn_s_waitcnt(0);
    unsigned nloc = b.st[0], nx = b.st[1];
    if (nloc == 0u) { xcd_barrier_complete(bar, b.x, nloc, nx); b.st[0] = nloc; b.st[1] = nx; }
    const unsigned old = xb_add(&bar[XB_XSUB(b.x)], 1u);
    const unsigned gen = old / nloc;
    if (old + 1u == (gen + 1u) * nloc) {
      __builtin_amdgcn_fence(__ATOMIC_RELEASE, "agent");
      asm volatile("s_waitcnt vmcnt(0)" ::: "memory");
      const unsigned og = xb_add(&bar[XB_TOP], 1u);
      const unsigned tg = og / nx;
      if (og + 1u == (tg + 1u) * nx) xb_add(&bar[XB_TOPGEN], 1u);
      else XB_SPIN(xb_ld(&bar[XB_TOPGEN]) == tg, bar);
      __builtin_amdgcn_fence(__ATOMIC_ACQUIRE, "agent");
      xb_add(&bar[XB_XGEN(b.x)], 1u);
      asm volatile("s_waitcnt vmcnt(0)" ::: "memory");
    } else {
      XB_SPIN(xb_ld(&bar[XB_XGEN(b.x)]) == gen, bar);
      __builtin_amdgcn_fence(__ATOMIC_ACQUIRE, "agent");
      asm volatile("s_waitcnt vmcnt(0)" ::: "memory");
    }
  }
  __syncthreads();
}

__global__ void __launch_bounds__(512, 2) fwd_megakernel(Params p) {
  __shared__ __attribute__((aligned(16))) unsigned char smem[SMEM_BYTES];
  __shared__ uint4 xb_words;
  cg::grid_group grid = cg::this_grid();
  if (threadIdx.x == 0) xb_words = make_uint4(0u, 0u, 0u, 0u);
  __syncthreads();
  XcdBarrier xb = xcd_barrier_post((unsigned*)(p.ws + OFF_BAR), (volatile LAS unsigned*)&xb_words);
  for (int ph = p.ph_lo; ph < p.ph_hi; ++ph) {
    if (ph > p.ph_lo) {
      if (p.ph_hi > 4096) grid.sync();
      xcd_barrier(xb);
    }
    if (ph == 0) { pre_phase(p, (float*)smem); continue; }
    if (ph == NPH - 1) { norm_phase(p, 0, 2); continue; }
    const int l = (ph - 1) / SEQ_N, sub = (int)((SEQ_PACK >> (4 * ((ph - 1) % SEQ_N))) & 15ull);
    GemmArgs g;
    g.l = l; g.res_chunk = 0;
    switch (sub) {
      case 0: norm_phase(p, l, 0); break;
#ifndef DIS1
      case 1:
        g.A = (const u16*)(p.ws + OFF_HM); g.lda = DM; g.Bt = Wt_in(p.ws, l); g.ldb = DM; g.K = DM;
        gemm_phase<EPI_G1, 256>(p, g, DIN / 256, smem);
        break;
#endif
#ifndef DIS2
      case 2: attn_phase(p, l, ph, smem); break;
#endif
#ifndef DIS3
      case 3:
        g.A = (const u16*)(p.ws + OFF_ATT); g.lda = 1536; g.Bt = Wt_br(p.ws, l); g.ldb = 1536; g.K = 1536;
        gemm_phase<EPI_G2, 128>(p, g, DM / 128, smem);
        break;
#endif
      case 4:
        g.A = (const u16*)(p.ws + OFF_HM); g.lda = DM; g.Bt = Wt_out(p.ws, l); g.ldb = DM; g.K = DM; g.res_chunk = 2;
        gemm_phase<EPI_RES, 128>(p, g, DM / 128, smem);
        break;
      case 5: norm_phase(p, l, 1); break;
      case 6:
        g.A = (const u16*)(p.ws + OFF_HM); g.lda = DM; g.Bt = Wt_f1(p.ws, l); g.ldb = DM; g.K = DM;
        gemm_phase<EPI_SWIGLU, 256>(p, g, 2 * DFF / 256, smem);
        break;
      default:
        g.A = (const u16*)(p.ws + OFF_GH); g.lda = DFF; g.Bt = Wt_f2(p.ws, l); g.ldb = DFF; g.K = DFF; g.res_chunk = 5;
        gemm_phase<EPI_RES, 128>(p, g, DM / 128, smem);
        break;
    }
  }
}

extern "C" void kernel_launch(void* const* d_in, const int* in_sizes, int n_in, void* d_out, int out_size, void* d_ws, size_t ws_size,
                              hipStream_t stream) {
  static int grid_blocks = 0;
  if (!grid_blocks) {
    int dev = 0, cus = 0, per_cu = 0;
    hipGetDevice(&dev);
    hipDeviceGetAttribute(&cus, hipDeviceAttributeMultiprocessorCount, dev);
    hipOccupancyMaxActiveBlocksPerMultiprocessor(&per_cu, fwd_megakernel, 512, 0);
    if (per_cu < 1) per_cu = 1;
    if (per_cu > 1) per_cu = 1;
    grid_blocks = cus * per_cu;
    if (ws_size < WS_END) fprintf(stderr, "kernel_launch: workspace too small: %zu < %zu\n", ws_size, (size_t)WS_END);
  }
  Params p{};
  for (int i = 0; i < 30; ++i) p.in[i] = (const float*)d_in[i];
  p.out = (float*)d_out;
  p.ws = (unsigned char*)d_ws;
  for (int l = 0; l < 4; ++l) p.lam_init[l] = (float)(0.8 - 0.6 * exp(-0.3 * l));
  hipMemsetAsync((unsigned char*)d_ws + OFF_BAR, 0, 16384, stream);
#if ONE_LAUNCH
  p.ph_lo = 0; p.ph_hi = NPH;
  void* args[] = {&p};
  hipError_t e = hipLaunchCooperativeKernel((void*)fwd_megakernel, dim3(grid_blocks), dim3(512), args, 0, stream);
  if (e != hipSuccess) fprintf(stderr, "cooperative launch failed: %s (grid %d)\n", hipGetErrorString(e), grid_blocks);
#else
  for (int ph = 0; ph < NPH; ++ph) {
    p.ph_lo = ph; p.ph_hi = ph + 1;
    hipLaunchKernelGGL(fwd_megakernel, dim3(grid_blocks), dim3(512), 0, stream, p);
  }
#endif
}
```
